# Optimizing an MI355X kernel written in HIP

```python
import math
import jax, jax.numpy as jnp
from jax import lax
import numpy as np

D_MODEL = 2048
BATCH = 2
SEQ = 8192
DEPTH = 1

CHUNK = 64
N_META = 16

MIX_W = D_MODEL
SSM_W = MIX_W // 2
SSM_GROUP_CH = 16
SSM_GROUPS = SSM_W // SSM_GROUP_CH
SSM_STATE = 64
DT_MIN = 1e-3
DT_MAX = 1e-1

ATT_W = MIX_W - SSM_W
ATT_HEAD_DIM = 128
ATT_HEADS = ATT_W // ATT_HEAD_DIM
Q_BLOCK = 128
FORGET_BIAS_MIN = 1.0
FORGET_BIAS_MAX = 4.0

IN_PROJ_W = SSM_W + 3 * ATT_W + ATT_HEADS

N_EXPERTS = 64
TOP_K = 8
N_EXPERT_GROUPS = 8
TOPK_GROUPS = 4
EXPERT_FF = 512
SHARED_FF = 512
ROUTED_SCALE = 2.5
EXPERT_BLOCK = 128

LN_EPS = 1e-5
DEEPNORM_ALPHA = (2 * DEPTH) ** 0.25
DEEPNORM_BETA = (8 * DEPTH) ** -0.25

kernel_name = "hymba_s5_fox_deepnorm_moe"


def layer_norm(x, g, b):
    xf = x.astype(jnp.float32)
    mu = jnp.mean(xf, axis=-1, keepdims=True)
    xc = xf - mu
    var = jnp.mean(jnp.square(xc), axis=-1, keepdims=True)
    y = xc * lax.rsqrt(var + LN_EPS)
    return (y * g.astype(jnp.float32) + b.astype(jnp.float32)).astype(x.dtype)


def _linear_recurrence(e1, e2):
    a1, b1 = e1
    a2, b2 = e2
    return a1 * a2, a2 * b1 + b2


def s5_branch(u, a_re, a_im, log_dt, b_re, b_im, c_re, c_im, d_skip, w_glu, b_glu):
    bsz, L, _ = u.shape
    f32 = jnp.float32
    ug = u.reshape(bsz, L, SSM_GROUPS, SSM_GROUP_CH).astype(f32)
    lam = lax.complex(a_re.astype(f32), a_im.astype(f32))
    dt = jnp.exp(log_dt.astype(f32))[:, None]
    a_bar = jnp.exp(lam * dt)
    b_cplx = lax.complex(b_re.astype(f32), b_im.astype(f32))
    b_bar = ((a_bar - 1.0) / lam)[..., None] * b_cplx
    bu = jnp.einsum('blgh,gph->blgp', ug.astype(jnp.complex64), b_bar)
    a_seq = jnp.broadcast_to(a_bar, bu.shape)
    _, states = lax.associative_scan(_linear_recurrence, (a_seq, bu), axis=1)
    c_cplx = lax.complex(c_re.astype(f32), c_im.astype(f32))
    y = jnp.einsum('blgp,ghp->blgh', states, c_cplx).real + d_skip.astype(f32) * ug
    y = jax.nn.gelu(y.reshape(bsz, L, SSM_W))
    y = y * jax.nn.sigmoid(y @ w_glu.astype(f32) + b_glu.astype(f32))
    return y.astype(u.dtype)


def fox_branch(q, k, v, f_logit):
    bsz, L, _ = q.shape
    Lp = -(-L // Q_BLOCK) * Q_BLOCK
    pad = Lp - L
    shp = (bsz, L, ATT_HEADS, ATT_HEAD_DIM)
    padw = ((0, 0), (0, pad), (0, 0), (0, 0))
    q = jnp.pad(q.reshape(shp), padw)
    k = jnp.pad(k.reshape(shp), padw)
    v = jnp.pad(v.reshape(shp), padw)
    log_f = jnp.pad(jax.nn.log_sigmoid(f_logit.astype(jnp.float32)), ((0, 0), (0, pad), (0, 0)))
    cum = jnp.transpose(jnp.cumsum(log_f, axis=1), (0, 2, 1))
    scale = ATT_HEAD_DIM ** -0.5
    key_pos = jnp.arange(Lp)

    def block(i):
        s = i * Q_BLOCK
        qb = lax.dynamic_slice_in_dim(q, s, Q_BLOCK, axis=1)
        cq = lax.dynamic_slice_in_dim(cum, s, Q_BLOCK, axis=2)
        logits = jnp.einsum('bqhd,bkhd->bhqk', qb, k).astype(jnp.float32) * scale
        logits = logits + cq[..., None] - cum[:, :, None, :]
        q_pos = s + jnp.arange(Q_BLOCK)
        mask = key_pos[None, :] <= q_pos[:, None]
        logits = jnp.where(mask, logits, -jnp.inf)
        p = jax.nn.softmax(logits, axis=-1)
        return jnp.einsum('bhqk,bkhd->bqhd', p.astype(v.dtype), v)

    out = lax.map(block, jnp.arange(Lp // Q_BLOCK))
    out = jnp.transpose(out, (1, 0, 2, 3, 4)).reshape(bsz, Lp, ATT_W)
    return out[:, :L]


def hybrid_mixer(h, w_in, b_forget, a_re, a_im, log_dt, b_re, b_im, c_re, c_im, d_skip,
                 w_glu, b_glu, w_out):
    proj = h @ w_in
    u, q, k, v, f_logit = jnp.split(
        proj, [SSM_W, SSM_W + ATT_W, SSM_W + 2 * ATT_W, SSM_W + 3 * ATT_W], axis=-1)
    y_ssm = s5_branch(u, a_re, a_im, log_dt, b_re, b_im, c_re, c_im, d_skip, w_glu, b_glu)
    y_att = fox_branch(q, k, v, f_logit + b_forget)
    y = jnp.concatenate([y_ssm, y_att.astype(y_ssm.dtype)], axis=-1)
    return (y @ w_out).astype(h.dtype)


def moe_ffn(h2d, w_router, router_bias, w_gate_exp, w_up_exp, w_down_exp,
            w_gate_sh, w_up_sh, w_down_sh):
    T, D = h2d.shape
    scores = jax.nn.sigmoid((h2d @ w_router).astype(jnp.float32))
    sel = scores + router_bias.astype(jnp.float32)
    grouped = sel.reshape(T, N_EXPERT_GROUPS, N_EXPERTS // N_EXPERT_GROUPS)
    group_score = jnp.sum(lax.top_k(grouped, 2)[0], axis=-1)
    _, top_groups = lax.top_k(group_score, TOPK_GROUPS)
    group_mask = jnp.sum(jax.nn.one_hot(top_groups, N_EXPERT_GROUPS), axis=1) > 0
    expert_mask = jnp.repeat(group_mask, N_EXPERTS // N_EXPERT_GROUPS, axis=1)
    _, idx = lax.top_k(jnp.where(expert_mask, sel, -jnp.inf), TOP_K)
    gate = jnp.take_along_axis(scores, idx, axis=1)
    gate = gate / jnp.sum(gate, axis=-1, keepdims=True) * ROUTED_SCALE

    n_assign = T * TOP_K
    flat_e = idx.reshape(-1)
    flat_t = jnp.arange(n_assign, dtype=jnp.int32) // TOP_K
    flat_w = gate.reshape(-1)
    order = jnp.argsort(flat_e)
    se, st, sw = flat_e[order], flat_t[order], flat_w[order]
    counts = jnp.bincount(flat_e, length=N_EXPERTS)
    starts = jnp.cumsum(counts) - counts
    pcounts = (counts + EXPERT_BLOCK - 1) // EXPERT_BLOCK * EXPERT_BLOCK
    pends = jnp.cumsum(pcounts)
    pstarts = pends - pcounts
    dest = pstarts[se] + (jnp.arange(n_assign) - starts[se])
    n_blocks = -(-n_assign // EXPERT_BLOCK) + N_EXPERTS
    buf_tok = jnp.full((n_blocks * EXPERT_BLOCK,), T, jnp.int32).at[dest].set(st)
    buf_w = jnp.zeros((n_blocks * EXPERT_BLOCK,), jnp.float32).at[dest].set(sw)
    block_e = jnp.minimum(
        jnp.searchsorted(pends, jnp.arange(n_blocks) * EXPERT_BLOCK, side='right'), N_EXPERTS - 1)
    x_pad = jnp.concatenate([h2d, jnp.zeros((1, D), h2d.dtype)], axis=0)

    def body(b, acc):
        tok = lax.dynamic_slice(buf_tok, (b * EXPERT_BLOCK,), (EXPERT_BLOCK,))
        wt = lax.dynamic_slice(buf_w, (b * EXPERT_BLOCK,), (EXPERT_BLOCK,))
        e = block_e[b]
        xb = x_pad[tok]
        hid = jax.nn.silu(xb @ w_gate_exp[e]) * (xb @ w_up_exp[e])
        yb = (hid @ w_down_exp[e]) * wt[:, None]
        return acc.at[tok].add(yb.astype(acc.dtype))

    acc = lax.fori_loop(0, n_blocks, body, jnp.zeros((T + 1, D), h2d.dtype))
    shared = (jax.nn.silu(h2d @ w_gate_sh) * (h2d @ w_up_sh)) @ w_down_sh
    return (acc[:T] + shared).astype(h2d.dtype)


def setup_inputs(seed: int = 0) -> dict:
    key = jax.random.key(seed)
    ks = iter(jax.random.split(key, 40))
    f32 = jnp.float32

    def nrm(shape, std):
        return std * jax.random.normal(next(ks), shape, f32)

    def uni(shape, lo, hi):
        return jax.random.uniform(next(ks), shape, f32, minval=lo, maxval=hi)

    Ld, D, G, P, Hc = DEPTH, D_MODEL, SSM_GROUPS, SSM_STATE, SSM_GROUP_CH
    n = jnp.arange(P, dtype=f32)
    return {
        "x": nrm((BATCH, SEQ, D), 1.0),
        "meta_tokens": nrm((N_META, D), 1.0),
        "ln_in_g": 1.0 + nrm((D,), 0.02),
        "ln_in_b": nrm((D,), 0.02),
        "w_in": nrm((Ld, D, IN_PROJ_W), D ** -0.5),
        "b_forget": uni((Ld, ATT_HEADS), FORGET_BIAS_MIN, FORGET_BIAS_MAX),
        "ssm_a_re": -0.5 + nrm((Ld, G, P), 0.01),
        "ssm_a_im": math.pi * n + nrm((Ld, G, P), 0.01),
        "ssm_log_dt": uni((Ld, G), math.log(DT_MIN), math.log(DT_MAX)),
        "ssm_b_re": nrm((Ld, G, P, Hc), (2 * Hc) ** -0.5),
        "ssm_b_im": nrm((Ld, G, P, Hc), (2 * Hc) ** -0.5),
        "ssm_c_re": nrm((Ld, G, Hc, P), 0.5),
        "ssm_c_im": nrm((Ld, G, Hc, P), 0.5),
        "ssm_d": nrm((Ld, G, Hc), 1.0),
        "w_glu": nrm((Ld, SSM_W, SSM_W), SSM_W ** -0.5),
        "b_glu": nrm((Ld, SSM_W), 0.02),
        "w_out": nrm((Ld, MIX_W, D), MIX_W ** -0.5 * DEEPNORM_BETA),
        "ln_mix_g": 1.0 + nrm((Ld, D), 0.02),
        "ln_mix_b": nrm((Ld, D), 0.02),
        "w_router": nrm((Ld, D, N_EXPERTS), D ** -0.5),
        "router_bias": nrm((Ld, N_EXPERTS), 0.01),
        "w_gate_exp": nrm((Ld, N_EXPERTS, D, EXPERT_FF), D ** -0.5),
        "w_up_exp": nrm((Ld, N_EXPERTS, D, EXPERT_FF), D ** -0.5),
        "w_down_exp": nrm((Ld, N_EXPERTS, EXPERT_FF, D), EXPERT_FF ** -0.5 * DEEPNORM_BETA),
        "w_gate_sh": nrm((Ld, D, SHARED_FF), D ** -0.5),
        "w_up_sh": nrm((Ld, D, SHARED_FF), D ** -0.5),
        "w_down_sh": nrm((Ld, SHARED_FF, D), SHARED_FF ** -0.5 * DEEPNORM_BETA),
        "ln_ffn_g": 1.0 + nrm((Ld, D), 0.02),
        "ln_ffn_b": nrm((Ld, D), 0.02),
    }


def reference(x, meta_tokens, ln_in_g, ln_in_b, w_in, b_forget, ssm_a_re, ssm_a_im,
              ssm_log_dt, ssm_b_re, ssm_b_im, ssm_c_re, ssm_c_im, ssm_d, w_glu, b_glu,
              w_out, ln_mix_g, ln_mix_b, w_router, router_bias, w_gate_exp, w_up_exp,
              w_down_exp, w_gate_sh, w_up_sh, w_down_sh, ln_ffn_g, ln_ffn_b):
    bsz = x.shape[0]
    meta = jnp.broadcast_to(meta_tokens[None].astype(x.dtype), (bsz, N_META, D_MODEL))
    h = layer_norm(jnp.concatenate([meta, x], axis=1), ln_in_g, ln_in_b)
    for i in range(DEPTH):
        mix = hybrid_mixer(h, w_in[i], b_forget[i], ssm_a_re[i], ssm_a_im[i], ssm_log_dt[i],
                           ssm_b_re[i], ssm_b_im[i], ssm_c_re[i], ssm_c_im[i], ssm_d[i],
                           w_glu[i], b_glu[i], w_out[i])
        h = layer_norm(DEEPNORM_ALPHA * h + mix, ln_mix_g[i], ln_mix_b[i])
        ffn = moe_ffn(h.reshape(-1, D_MODEL), w_router[i], router_bias[i], w_gate_exp[i],
                      w_up_exp[i], w_down_exp[i], w_gate_sh[i], w_up_sh[i],
                      w_down_sh[i]).reshape(h.shape)
        h = layer_norm(DEEPNORM_ALPHA * h + ffn, ln_ffn_g[i], ln_ffn_b[i])
    return h[:, N_META:]
```

```cpp
#include <hip/hip_runtime.h>
#include <cstdio>
#include <cstdint>

#ifndef MK_N_LAUNCHES
#define MK_N_LAUNCHES 1
#endif

#define LAS __attribute__((address_space(3)))
#define GAS __attribute__((address_space(1)))
typedef unsigned short bf16_t;
typedef short bf16x8 __attribute__((ext_vector_type(8)));
typedef short s16x4 __attribute__((ext_vector_type(4)));
typedef float f32x2 __attribute__((ext_vector_type(2)));
typedef float f32x4 __attribute__((ext_vector_type(4)));
typedef float f32x16 __attribute__((ext_vector_type(16)));
typedef unsigned u32x2 __attribute__((ext_vector_type(2)));
typedef unsigned u32x4 __attribute__((ext_vector_type(4)));
typedef int i32x4 __attribute__((ext_vector_type(4)));

constexpr int BATCH = 2, SEQ = 8192, DM = 2048, NMETA = 16;
constexpr int MX = BATCH * SEQ;
constexpr int MIN_ROWS = MX + 256;
constexpr int NHEAD = 8, HD = 128, NGRP = 64, NST = 64;
constexpr int KVR = 64 + SEQ;
constexpr int NCHK = KVR / 32;
constexpr int UGK = 640;
constexpr int NEXP = 64, TOPK = 8, EFF = 512;
constexpr float LN_EPS = 1e-5f;
constexpr float ALPHA = 1.189207115002721f;
constexpr float ROUTED_SCALE = 2.5f;
constexpr float LOG2E = 1.4426950408889634f;
constexpr float QSCALE = 0.08838834764831845f * 1.4426950408889634f;

constexpr size_t MiB = 1u << 20;
constexpr size_t WS_CTL = 0, CTL_ZERO_BYTES = 1 * MiB;
constexpr size_t WS_LOGF = 1 * MiB;
constexpr size_t WS_CUM = 2 * MiB;
constexpr size_t WS_IDX = 3 * MiB;
constexpr size_t WS_GW = 3 * MiB + 512 * 1024;
constexpr size_t WS_RK = 4 * MiB;
constexpr size_t WS_WR = 4 * MiB + 512 * 1024;
constexpr size_t WS_TOK = 5 * MiB;
constexpr size_t WS_ST = 9 * MiB;
constexpr size_t WS_XN = 16 * MiB;
constexpr size_t WS_WED = 81 * MiB;
constexpr size_t WS_WSD = 209 * MiB;
constexpr size_t WS_WSGU = 211 * MiB;
constexpr size_t WS_WGLU = 215 * MiB;
constexpr size_t WS_WOUT = 217 * MiB;
constexpr size_t WS_WIN = 225 * MiB;
constexpr size_t WS_HID = 241 * MiB;
constexpr size_t WS_YC = 241 * MiB;
constexpr size_t WS_YB = 305 * MiB;
constexpr size_t WS_Q = 337 * MiB;
constexpr size_t WS_HIDS = 370 * MiB;
constexpr size_t WS_CS = 386 * MiB;
constexpr size_t WS_C = 450 * MiB;
constexpr size_t WS_WEGU = 450 * MiB;
constexpr size_t WS_Z = 706 * MiB;
constexpr size_t WS_K = 834 * MiB;
constexpr size_t WS_V = 867 * MiB;
constexpr size_t WS_UG = 900 * MiB;
constexpr size_t WS_OPY = 941 * MiB;
constexpr size_t WS_OPE = 981 * MiB;
constexpr size_t WS_E = 997 * MiB;
constexpr size_t WS_END = 1013 * MiB;
static_assert(WS_HID + (size_t)(131072 + 256) * 512 * 2 <= WS_HIDS && WS_Q + (size_t)MX * 1024 * 2 <= WS_HIDS, "map");
static_assert(WS_K + (size_t)2 * KVR * 1024 * 2 <= WS_V && WS_V + (size_t)2 * KVR * 1024 * 2 <= WS_UG, "map");
static_assert(WS_UG + (size_t)64 * 2 * NCHK * UGK * 2 <= WS_OPY && WS_C + (size_t)131072 * 2048 * 2 <= WS_END, "map");
static_assert(WS_XN + (size_t)MIN_ROWS * 2048 * 2 <= WS_WED, "map");
constexpr int CW_TMO = 0, CW_CODE = 1;
constexpr int CW_CNT = 1024;
constexpr int CW_BAR = 8192;

constexpr int RING_BYTES = 139264;
constexpr int LDSCTL_OFF = RING_BYTES;
constexpr int MISC_OFF = LDSCTL_OFF + 64;
constexpr int TB_OFF = LDSCTL_OFF + 1024;
constexpr int LDS_BYTES = 147456;

__device__ __forceinline__ unsigned cvt_pk_bf16(float lo, float hi) { unsigned r; asm volatile("v_cvt_pk_bf16_f32 %0, %1, %2" : "=v"(r) : "v"(lo), "v"(hi)); return r; }
__device__ __forceinline__ float bf_lo(unsigned w) { return __uint_as_float(w << 16); }
__device__ __forceinline__ float bf_hi(unsigned w) { return __uint_as_float(w & 0xffff0000u); }
__device__ __forceinline__ float fast_sigmoid(float x) { return __builtin_amdgcn_rcpf(1.f + __builtin_amdgcn_exp2f(-x * LOG2E)); }
__device__ __forceinline__ float wave_sum(float v) {
#pragma unroll
    for (int o = 1; o < 64; o <<= 1) v += __shfl_xor(v, o);
    return v;
}
#define LDS_WAIT() asm volatile("s_waitcnt lgkmcnt(0)" ::: "memory")
#define VM_WAIT() asm volatile("s_waitcnt vmcnt(0)" ::: "memory")

namespace pg8 {
constexpr int BM = 256, BK = 64, HALF = 128, HTB = HALF * BK * 2, STAGE_BYTES = 8 * HTB, NXCD = 8, WGM = 8;
__host__ __device__ __forceinline__ int lds_byte(int r, int c) { const int st = (r >> 4) * 2 + (c >> 5), rr = r & 15, cc = c & 31, ob = rr * 64 + cc * 2; return st * 1024 + (ob ^ (((ob >> 9) & 1) << 5)); }
__host__ __device__ __forceinline__ void stage_rc(int b, int& R, int& C) { const int st = b / 1024, sb = b % 1024, swz = sb ^ (((sb >> 9) & 1) << 5); R = (st >> 1) * 16 + swz / 64; C = (st & 1) * 32 + (swz % 64) / 2; }
__host__ __device__ __forceinline__ int perm32(int rho) { const int n = rho >> 4, i = rho & 15; return 8 * (i >> 2) + 4 * n + (i & 3); }

struct Unit { const char* A; const char* B; const int* rows; int r0, c0, valid, aux; };
struct GemmK { int K, lda, ldb; };

template <class Epi, class Sched, bool ALIGN_EPI>
__device__ __forceinline__ void gemm_phase(LAS unsigned char* lds, const GemmK g, const Sched& S, const Epi& E) {
    const int tid = threadIdx.x, wid = __builtin_amdgcn_readfirstlane(tid >> 6), lane = tid & 63, wr = wid >> 2, wc = wid & 3, fr = lane & 15, fq = lane >> 4;
    const int K = g.K, nt = K / BK;
    int Rs[2], Cs[2]; unsigned voffB[2];
#pragma unroll
    for (int i = 0; i < 2; ++i) { int R, C; stage_rc(tid * 16 + i * 8192, R, C); const int Rb = Epi::PERM ? ((R & ~31) + perm32(R & 31)) : R;
        Rs[i] = R; Cs[i] = C; voffB[i] = (unsigned)(Rb * g.ldb + C) * 2u; }
    const size_t kstep = (size_t)(BK * 2);
    const size_t hstepB = (size_t)HALF * g.ldb * 2;
    const unsigned ldsw = (unsigned)wid * 1024u;
    const int aoff = lds_byte(wr * 64 + fr, fq * 8), boff = lds_byte(wc * 32 + fr, fq * 8);
#define PG8_SA(b, h) (((b) * 2 + (h)) * HTB)
#define PG8_SB(b, h) ((4 + (b) * 2 + (h)) * HTB)
#define PG8_STAGE(bufoff, gbase, voff) do { _Pragma("unroll") for (int _i = 0; _i < 2; ++_i) \
        __builtin_amdgcn_global_load_lds((const unsigned*)((const char*)(gbase) + (voff)[_i]), (LAS unsigned*)(lds + (bufoff) + ldsw + _i * 8192), 16, 0, 0); } while (0)
#define PG8_LDA(dst, b, h) do { _Pragma("unroll") for (int m = 0; m < 4; ++m) _Pragma("unroll") for (int k = 0; k < 2; ++k) dst[m][k] = *(const LAS bf16x8*)(lds + PG8_SA(b, h) + aoff + m * 2048 + k * 1024); } while (0)
#define PG8_LDB(dst, b, h) do { _Pragma("unroll") for (int n = 0; n < 2; ++n) _Pragma("unroll") for (int k = 0; k < 2; ++k) dst[n][k] = *(const LAS bf16x8*)(lds + PG8_SB(b, h) + boff + n * 2048 + k * 1024); } while (0)
#define PG8_MMA(ai, bj, At, Bt) do { __builtin_amdgcn_s_setprio(1); _Pragma("unroll") for (int m = 0; m < 4; ++m) _Pragma("unroll") for (int n = 0; n < 2; ++n) _Pragma("unroll") for (int k = 0; k < 2; ++k) \
        acc[ai][bj][m][n] = __builtin_amdgcn_mfma_f32_16x16x32_bf16(Bt[n][k], At[m][k], acc[ai][bj][m][n], 0, 0, 0); __builtin_amdgcn_s_setprio(0); } while (0)
#define PG8_WAIT_V(n) asm volatile("s_waitcnt vmcnt(" #n ")" ::: "memory")
#define PG8_WAIT_L(n) asm volatile("s_waitcnt lgkmcnt(" #n ")" ::: "memory")
#define PG8_BAR __builtin_amdgcn_s_barrier()
#define PG8_SCHED __builtin_amdgcn_sched_barrier(0)
#define PG8_VOFFA(u, v0, v1) do { _Pragma("unroll") for (int _i = 0; _i < 2; ++_i) { v0[_i] = S.a_off(u, Rs[_i]) + (unsigned)Cs[_i] * 2u; v1[_i] = S.a_off(u, Rs[_i] + HALF) + (unsigned)Cs[_i] * 2u; } } while (0)
    Unit cur, nxt; int ui = 0;
    if (!S.next(0, cur)) return;
    f32x4 acc[2][2][4][2];
#pragma unroll
    for (int a = 0; a < 2; ++a)
#pragma unroll
        for (int b = 0; b < 2; ++b)
#pragma unroll
            for (int m = 0; m < 4; ++m)
#pragma unroll
                for (int n = 0; n < 2; ++n) acc[a][b][m][n] = (f32x4){0.f, 0.f, 0.f, 0.f};
    bf16x8 At[4][2], B0[2][2], B1[2][2];
    const char* cA = cur.A; const char* cB = cur.B;
    unsigned vA0[2], vA1[2], nA0[2], nA1[2];
    PG8_VOFFA(cur, vA0, vA1);
    PG8_STAGE(PG8_SB(0, 0), cB, voffB); PG8_STAGE(PG8_SB(0, 1), cB + hstepB, voffB); PG8_STAGE(PG8_SA(0, 0), cA, vA0); PG8_STAGE(PG8_SA(0, 1), cA, vA1);
    if (wr == 1) PG8_BAR;
    PG8_WAIT_V(2); PG8_BAR;
    PG8_STAGE(PG8_SB(1, 0), cB + kstep, voffB); PG8_STAGE(PG8_SA(1, 0), cA + kstep, vA0); PG8_STAGE(PG8_SB(1, 1), cB + hstepB + kstep, voffB);
    PG8_WAIT_V(6); PG8_BAR;
    for (;;) {
        const bool has_next = S.next(ui + 1, nxt);
        const char* nA = has_next ? nxt.A : cA; const char* nB = has_next ? nxt.B : cB;
        if (has_next) { PG8_VOFFA(nxt, nA0, nA1); } else { nA0[0] = vA0[0]; nA0[1] = vA0[1]; nA1[0] = vA1[0]; nA1[1] = vA1[1]; }
        for (int t = 0; t < nt; t += 2) {
            const bool last = (t == nt - 2);
            const char* a1 = cA + (size_t)(t + 1) * kstep;
            const char* a2 = last ? nA : cA + (size_t)(t + 2) * kstep; const char* b2 = last ? nB : cB + (size_t)(t + 2) * kstep;
            const char* a3 = a2 + kstep; const char* b3 = b2 + kstep;
            unsigned w0[2], w1[2];
            w0[0] = last ? nA0[0] : vA0[0]; w0[1] = last ? nA0[1] : vA0[1]; w1[0] = last ? nA1[0] : vA1[0]; w1[1] = last ? nA1[1] : vA1[1];
            PG8_LDB(B0, 0, 0); PG8_LDB(B1, 0, 1); PG8_SCHED; PG8_LDA(At, 0, 0); PG8_STAGE(PG8_SA(1, 1), a1, vA1);
            PG8_WAIT_V(8); PG8_WAIT_L(0); PG8_BAR; PG8_MMA(0, 0, At, B0); PG8_MMA(0, 1, At, B1); PG8_BAR; PG8_SCHED;
            PG8_LDA(At, 0, 1); PG8_STAGE(PG8_SB(0, 0), b2, voffB); PG8_STAGE(PG8_SB(0, 1), b2 + hstepB, voffB); PG8_STAGE(PG8_SA(0, 0), a2, w0);
            PG8_WAIT_V(8); PG8_WAIT_L(0); PG8_BAR; PG8_MMA(1, 0, At, B0); PG8_MMA(1, 1, At, B1); PG8_BAR; PG8_SCHED;
            PG8_LDB(B0, 1, 0); PG8_LDB(B1, 1, 1); PG8_SCHED; PG8_LDA(At, 1, 0); PG8_STAGE(PG8_SA(0, 1), a2, w1);
            PG8_WAIT_V(8); PG8_WAIT_L(0); PG8_BAR; PG8_MMA(0, 0, At, B0); PG8_MMA(0, 1, At, B1); PG8_BAR; PG8_SCHED;
            PG8_LDA(At, 1, 1); PG8_STAGE(PG8_SB(1, 0), b3, voffB); PG8_STAGE(PG8_SB(1, 1), b3 + hstepB, voffB); PG8_STAGE(PG8_SA(1, 0), a3, w0);
            PG8_WAIT_V(8); PG8_WAIT_L(0); PG8_BAR; PG8_MMA(1, 0, At, B0); PG8_MMA(1, 1, At, B1); PG8_BAR; PG8_SCHED;
        }
        if constexpr (ALIGN_EPI) { if (wr == 0) PG8_BAR; }
        E(acc, cur, wr, wc, fr, fq);
        if (!has_next) break;
#pragma unroll
        for (int a = 0; a < 2; ++a)
#pragma unroll
            for (int b = 0; b < 2; ++b)
#pragma unroll
                for (int m = 0; m < 4; ++m)
#pragma unroll
                    for (int n = 0; n < 2; ++n) acc[a][b][m][n] = (f32x4){0.f, 0.f, 0.f, 0.f};
        cur = nxt; cA = nA; cB = nB; ++ui;
        vA0[0] = nA0[0]; vA0[1] = nA0[1]; vA1[0] = nA1[0]; vA1[1] = nA1[1];
        if constexpr (ALIGN_EPI) { if (wr == 1) PG8_BAR; }
    }
    PG8_WAIT_V(0);
    if constexpr (!ALIGN_EPI) { if (wr == 0) PG8_BAR; }
    PG8_BAR;
#undef PG8_SA
#undef PG8_SB
#undef PG8_STAGE
#undef PG8_LDA
#undef PG8_LDB
#undef PG8_MMA
#undef PG8_WAIT_V
#undef PG8_WAIT_L
#undef PG8_BAR
#undef PG8_SCHED
#undef PG8_VOFFA
}

__device__ __forceinline__ int xcd_remap(int L, int nwg) { const int q = nwg / NXCD, r = nwg % NXCD, xcd = L % NXCD, off = L / NXCD; return (xcd < r ? xcd * (q + 1) : r * (q + 1) + (xcd - r) * q) + off; }

struct DenseOrder {
    const char* A; const char* B; int lda, ldb, nM, nN, nwg, G, c;
    __device__ __forceinline__ void init(const void* A_, const void* B_, int lda_, int ldb_, int M, int N, int G_, int c_) { A = (const char*)A_; B = (const char*)B_; lda = lda_; ldb = ldb_; nM = M / BM; nN = N / BM; nwg = nM * nN; G = G_; c = c_; }
    __device__ __forceinline__ bool next(int i, Unit& u) const {
        const long L = (long)i * G + c; if (L >= nwg) return false;
        const int wgid = xcd_remap((int)L, nwg);
        const int nig = WGM * nN, gid = wgid / nig, fm = gid * WGM, gsz = (nM - fm) < WGM ? (nM - fm) : WGM;
        const int pm = fm + ((wgid % nig) % gsz), pn = (wgid % nig) / gsz;
        u.A = A + (size_t)pm * BM * lda * 2; u.B = B + (size_t)pn * BM * ldb * 2; u.rows = nullptr; u.r0 = pm * BM; u.c0 = pn; u.valid = BM; u.aux = 0; return true;
    }
    __device__ __forceinline__ unsigned a_off(const Unit&, int R) const { return (unsigned)R * (unsigned)lda * 2u; }
};
struct EOrder {
    const char* UG; const char* OPE; int G, c;
    __device__ __forceinline__ bool next(int i, Unit& u) const {
        const int L = i * G + c; if (L >= 128) return false;
        const int g = L >> 1, b = L & 1;
        u.A = UG + ((size_t)((g * 2 + b) * NCHK + 1)) * UGK * 2; u.B = OPE + (size_t)g * 256 * 512 * 2; u.rows = nullptr; u.r0 = (g * 2 + b) * 256; u.c0 = 0; u.valid = BM; u.aux = g; return true;
    }
    __device__ __forceinline__ unsigned a_off(const Unit&, int R) const { return (unsigned)R * (unsigned)(UGK * 2); }
};
struct YOrder {
    const char* UG; const char* OPY; int G, c;
    __device__ __forceinline__ bool next(int i, Unit& u) const {
        const int L = i * G + c; if (L >= 256) return false;
        const int g = L >> 2, b = (L >> 1) & 1, pn = L & 1;
        u.A = UG + ((size_t)((g * 2 + b) * NCHK + 2)) * UGK * 2; u.B = OPY + ((size_t)g * 512 + pn * 256) * UGK * 2; u.rows = nullptr; u.r0 = b; u.c0 = pn; u.valid = BM; u.aux = g; return true;
    }
    __device__ __forceinline__ unsigned a_off(const Unit&, int R) const { return (unsigned)R * (unsigned)(UGK * 2); }
};
struct MoeOrder {
    const LAS int* tb;
    int TT, NCT, nsh, nwg, G, c, lda, ldb;
    const char* Aexp; const int* tok; const char* Bexp; size_t bstride; const char* Ash; const char* Bsh; bool gather;
    __device__ __forceinline__ bool next(int i, Unit& u) const {
        const long L = (long)i * G + c; if (L >= nwg) return false;
        const int wgid = xcd_remap((int)L, nwg);
        if (wgid < TT * NCT) {
            const int gr = wgid / NCT, ct = wgid - gr * NCT;
            int lo = 0, hi = NEXP;
            while (hi - lo > 1) { const int mid = (lo + hi) >> 1; if (tb[mid] <= gr) lo = mid; else hi = mid; }
            const int e = lo, rt = gr - tb[e], cn = tb[130 + e], cp = tb[65 + e];
            int valid = cn - rt * BM; valid = valid > BM ? BM : valid;
            if (gather) { u.A = Aexp; u.rows = tok + (size_t)e * MX + rt * BM; }
            else { u.A = Aexp + (size_t)(cp + rt * BM) * lda * 2; u.rows = nullptr; }
            u.B = Bexp + (size_t)e * bstride + (size_t)ct * BM * ldb * 2; u.r0 = cp + rt * BM; u.c0 = ct; u.valid = valid; u.aux = 0;
        } else {
            const int s = wgid - TT * NCT, pm = s / NCT, ct = s - pm * NCT;
            u.A = Ash + (size_t)pm * BM * lda * 2; u.rows = nullptr; u.B = Bsh + (size_t)ct * BM * ldb * 2; u.r0 = pm * BM; u.c0 = ct; u.valid = BM; u.aux = 1;
        }
        return true;
    }
    __device__ __forceinline__ unsigned a_off(const Unit& u, int R) const {
        if (u.rows) { const int i = R < u.valid ? R : u.valid - 1; return (unsigned)u.rows[i] * (unsigned)lda * 2u; }
        return (unsigned)R * (unsigned)lda * 2u;
    }
};

#define EPI_LOOP_ROWS for (int ai = 0; ai < 2; ++ai) _Pragma("unroll") for (int m = 0; m < 4; ++m)
__device__ __forceinline__ u32x4 pack8(f32x4 v0, f32x4 v1) { u32x4 w; w.x = cvt_pk_bf16(v0[0], v0[1]); w.y = cvt_pk_bf16(v0[2], v0[3]); w.z = cvt_pk_bf16(v1[0], v1[1]); w.w = cvt_pk_bf16(v1[2], v1[3]); return w; }

struct EpiInProj {
    static constexpr bool PERM = true;
    bf16_t* UG; bf16_t* Q; bf16_t* Kb; bf16_t* Vb;
    __device__ __forceinline__ void operator()(const f32x4 (&acc)[2][2][4][2], const Unit& u, int wr, int wc, int fr, int fq) const {
        const int pn = u.c0, sect = pn >> 2; const bool meta = (u.r0 >= MX);
        if (meta && sect == 1) return;
        const float sc = sect == 1 ? QSCALE : 1.f;
#pragma unroll
        EPI_LOOP_ROWS { const int rt = ai * HALF + wr * 64 + m * 16 + fr;
            if (meta && rt >= NMETA) continue;
#pragma unroll
            for (int bj = 0; bj < 2; ++bj) {
                const int col = (pn & 3) * 256 + bj * HALF + wc * 32 + 8 * fq;
                const u32x4 w = pack8(acc[ai][bj][m][0] * sc, acc[ai][bj][m][1] * sc);
                if (!meta) { const int row = u.r0 + rt, b = row >> 13, s = row & (SEQ - 1);
                    if (sect == 0) { const int gch = col >> 4, half = (col >> 3) & 1;
                        *(u32x4*)(UG + ((size_t)((gch * 2 + b) * NCHK + 2 + (s >> 5)) * UGK + (s & 31) * 16 + 8 * half)) = w; }
                    else if (sect == 1) *(u32x4*)(Q + (size_t)row * 1024 + col) = w;
                    else { bf16_t* dst = sect == 2 ? Kb : Vb; *(u32x4*)(dst + ((size_t)b * KVR + 64 + s) * 1024 + col) = w; }
                } else {
#pragma unroll
                    for (int b = 0; b < 2; ++b) {
                        if (sect == 0) { const int gch = col >> 4, half = (col >> 3) & 1;
                            *(u32x4*)(UG + ((size_t)((gch * 2 + b) * NCHK + 1) * UGK + (16 + rt) * 16 + 8 * half)) = w; }
                        else { bf16_t* dst = sect == 2 ? Kb : Vb; *(u32x4*)(dst + ((size_t)b * KVR + 48 + rt) * 1024 + col) = w; }
                    }
                }
            }
        }
    }
};
struct EpiE {
    static constexpr bool PERM = false;
    float* E;
    __device__ __forceinline__ void operator()(const f32x4 (&acc)[2][2][4][2], const Unit& u, int wr, int wc, int fr, int fq) const {
#pragma unroll
        EPI_LOOP_ROWS { const int rt = ai * HALF + wr * 64 + m * 16 + fr;
#pragma unroll
            for (int n = 0; n < 2; ++n) *(f32x4*)(E + (size_t)(u.r0 + rt) * 128 + wc * 32 + 16 * n + 4 * fq) = acc[ai][0][m][n]; }
    }
};
__device__ __forceinline__ float gelu_tanh(float v) { const float t = 1.5957691216057308f * (v + 0.044715f * v * v * v); return v * fast_sigmoid(t); }
struct EpiY {
    static constexpr bool PERM = true;
    bf16_t* YB;
    __device__ __forceinline__ void operator()(const f32x4 (&acc)[2][2][4][2], const Unit& u, int wr, int wc, int fr, int fq) const {
        const int b = u.r0, g = u.aux;
#pragma unroll
        EPI_LOOP_ROWS { const int rt = ai * HALF + wr * 64 + m * 16 + fr;
#pragma unroll
            for (int bj = 0; bj < 2; ++bj) { const int col = u.c0 * 256 + bj * HALF + wc * 32 + 8 * fq, t = col >> 4, h0 = col & 15;
                f32x4 v0 = acc[ai][bj][m][0], v1 = acc[ai][bj][m][1];
#pragma unroll
                for (int e = 0; e < 4; ++e) { v0[e] = gelu_tanh(v0[e]); v1[e] = gelu_tanh(v1[e]); }
                *(u32x4*)(YB + ((size_t)b * SEQ + 32 * rt + t) * 1024 + g * 16 + h0) = pack8(v0, v1); } }
    }
};
struct EpiGlu {
    static constexpr bool PERM = true;
    const bf16_t* YB; const float* bias; bf16_t* YC;
    __device__ __forceinline__ void operator()(const f32x4 (&acc)[2][2][4][2], const Unit& u, int wr, int wc, int fr, int fq) const {
#pragma unroll
        for (int bj = 0; bj < 2; ++bj) { const int col = u.c0 * 256 + bj * HALF + wc * 32 + 8 * fq;
            const f32x4 b0 = *(const f32x4*)(bias + col), b1 = *(const f32x4*)(bias + col + 4);
#pragma unroll
            EPI_LOOP_ROWS { const int row = u.r0 + ai * HALF + wr * 64 + m * 16 + fr;
                const u32x4 yw = *(const u32x4*)(YB + (size_t)row * 1024 + col);
                f32x4 v0 = acc[ai][bj][m][0] + b0, v1 = acc[ai][bj][m][1] + b1;
                v0[0] = bf_lo(yw.x) * fast_sigmoid(v0[0]); v0[1] = bf_hi(yw.x) * fast_sigmoid(v0[1]); v0[2] = bf_lo(yw.y) * fast_sigmoid(v0[2]); v0[3] = bf_hi(yw.y) * fast_sigmoid(v0[3]);
                v1[0] = bf_lo(yw.z) * fast_sigmoid(v1[0]); v1[1] = bf_hi(yw.z) * fast_sigmoid(v1[1]); v1[2] = bf_lo(yw.w) * fast_sigmoid(v1[2]); v1[3] = bf_hi(yw.w) * fast_sigmoid(v1[3]);
                *(u32x4*)(YC + (size_t)row * 2048 + col) = pack8(v0, v1); } }
    }
};
struct EpiOut {
    static constexpr bool PERM = false;
    const bf16_t* XN; float* Z; float* ST;
    __device__ __forceinline__ void operator()(const f32x4 (&acc)[2][2][4][2], const Unit& u, int wr, int wc, int fr, int fq) const {
#pragma unroll
        EPI_LOOP_ROWS { const int row = u.r0 + ai * HALF + wr * 64 + m * 16 + fr; float s = 0.f, q = 0.f;
#pragma unroll
            for (int bj = 0; bj < 2; ++bj)
#pragma unroll
                for (int n = 0; n < 2; ++n) { const int col = u.c0 * 256 + bj * HALF + wc * 32 + 16 * n + 4 * fq;
                    const u32x2 hw = *(const u32x2*)(XN + (size_t)row * 2048 + col);
                    f32x4 z = acc[ai][bj][m][n];
                    z[0] += ALPHA * bf_lo(hw.x); z[1] += ALPHA * bf_hi(hw.x); z[2] += ALPHA * bf_lo(hw.y); z[3] += ALPHA * bf_hi(hw.y);
                    s += (z[0] + z[1]) + (z[2] + z[3]); q += (z[0] * z[0] + z[1] * z[1]) + (z[2] * z[2] + z[3] * z[3]);
                    *(f32x4*)(Z + (size_t)row * 2048 + col) = z; }
            s += __shfl_xor(s, 16); s += __shfl_xor(s, 32); q += __shfl_xor(q, 16); q += __shfl_xor(q, 32);
            if (fq == 0) *(f32x2*)(ST + ((size_t)row * 32 + u.c0 * 4 + wc) * 2) = (f32x2){s, q}; }
    }
};
struct EpiGU {
    static constexpr bool PERM = true;
    bf16_t* HID; bf16_t* HIDS;
    __device__ __forceinline__ void operator()(const f32x4 (&acc)[2][2][4][2], const Unit& u, int wr, int wc, int fr, int fq) const {
        bf16_t* dst = u.aux ? HIDS : HID;
#pragma unroll
        EPI_LOOP_ROWS { const int rt = ai * HALF + wr * 64 + m * 16 + fr;
            if (rt < u.valid) { f32x4 h0, h1;
#pragma unroll
                for (int e = 0; e < 4; ++e) { const float g0 = acc[ai][0][m][0][e], g1 = acc[ai][0][m][1][e];
                    h0[e] = g0 * fast_sigmoid(g0) * acc[ai][1][m][0][e]; h1[e] = g1 * fast_sigmoid(g1) * acc[ai][1][m][1][e]; }
                *(u32x4*)(dst + (size_t)(u.r0 + rt) * EFF + u.c0 * HALF + wc * 32 + 8 * fq) = pack8(h0, h1); } }
    }
};
struct EpiDown {
    static constexpr bool PERM = true;
    bf16_t* C; bf16_t* CS;
    __device__ __forceinline__ void operator()(const f32x4 (&acc)[2][2][4][2], const Unit& u, int wr, int wc, int fr, int fq) const {
        bf16_t* dst = u.aux ? CS : C;
#pragma unroll
        EPI_LOOP_ROWS { const int rt = ai * HALF + wr * 64 + m * 16 + fr;
            if (rt < u.valid) {
#pragma unroll
                for (int bj = 0; bj < 2; ++bj) *(u32x4*)(dst + (size_t)(u.r0 + rt) * 2048 + u.c0 * 256 + bj * HALF + wc * 32 + 8 * fq) = pack8(acc[ai][bj][m][0], acc[ai][bj][m][1]); } }
    }
};
}

namespace att {
constexpr int D = 128, NW = 8, QBLK = 32, KVBLK = 64, QB = NW * QBLK;
constexpr int PQ = 1024, PKV = 1024, PO = 2048;
constexpr int SHM_V = KVBLK * D * 2, SHM_K = KVBLK * D * 2;
constexpr int OFF_WS = 2 * SHM_V + 2 * SHM_K, OFF_CUM = OFF_WS + NW * 64 * 4, LDS_BYTES = OFF_CUM + 2 * 64 * 4;
constexpr float THR2 = 8.f * 1.4426950408889634f;
constexpr unsigned WINF = 0x7fffffffu;
#define KSWZ(row, colB) ((row) * 256 + ((colB) ^ (((row) & 7) << 4)))
#define SBAR() __builtin_amdgcn_sched_barrier(0)
__device__ __forceinline__ int v_st(int k, int c) { const int kk = (k & ~0xC) | ((k & 4) << 1) | ((k & 8) >> 1); return ((kk >> 3) * 4 + (c >> 5)) * 512 + ((kk & 7) * 32 + (c & 31)) * 2; }
__device__ __forceinline__ int v_rd_base(int lane) { return ((lane & 3) << 3) | (((lane >> 2) & 3) << 6) | (((lane >> 4) & 1) << 5) | (((lane >> 5) & 1) << 8); }
constexpr int v_rd_off(int d0, int ks, int half) { return d0 * 512 + ks * 4096 + half * 2048; }
__device__ __forceinline__ int crow(int r, int hi) { return (r & 3) + 8 * (r >> 2) + 4 * hi; }
__device__ __forceinline__ unsigned cvtpk(float lo, float hi) { unsigned r; asm volatile("v_cvt_pk_bf16_f32 %0, %1, %2" : "=v"(r) : "v"(lo), "v"(hi)); return r; }
__device__ __forceinline__ bf16x8 ld8(const bf16_t* p) { return *reinterpret_cast<const bf16x8*>(p); }
__device__ __forceinline__ void mask_tile(f32x16& p0, f32x16& p1, int dq, unsigned W) {
    const float NEG = -__builtin_inff();
#pragma unroll
    for (int r = 0; r < 16; ++r) { const int c = (r & 3) + 8 * (r >> 2);
        if ((unsigned)(dq - c) >= W) p0[r] = NEG;
        if ((unsigned)(dq - c - 32) >= W) p1[r] = NEG; }
}
__device__ __forceinline__ void partialSM(f32x16& p0, f32x16& p1, float& m_reg, float& mn, float& alpha) {
    float pmax = p0[0];
#pragma unroll
    for (int r = 1; r < 16; ++r) pmax = fmaxf(pmax, p0[r]);
#pragma unroll
    for (int r = 0; r < 16; ++r) pmax = fmaxf(pmax, p1[r]);
    { auto rr = __builtin_amdgcn_permlane32_swap(__float_as_uint(pmax), __float_as_uint(pmax), false, false);
      pmax = fmaxf(__uint_as_float(rr[0]), __uint_as_float(rr[1])); }
    if (__builtin_expect(__all((pmax - m_reg) <= THR2), 1)) { mn = m_reg; alpha = 1.f; }
    else { mn = fmaxf(m_reg, pmax); alpha = __builtin_amdgcn_exp2f(m_reg - mn); m_reg = mn; }
#pragma unroll
    for (int r = 0; r < 16; ++r) p0[r] = p0[r] - mn;
#pragma unroll
    for (int r = 0; r < 16; ++r) p1[r] = p1[r] - mn;
#pragma unroll
    for (int r = 0; r < 16; ++r) p0[r] = __builtin_amdgcn_exp2f(p0[r]);
}
__device__ __forceinline__ void finishSM(f32x16& p0, f32x16& p1, float alpha, float& l_reg, bf16x8& pa0, bf16x8& pa1, bf16x8& pa2, bf16x8& pa3) {
#pragma unroll
    for (int r = 0; r < 16; ++r) p1[r] = __builtin_amdgcn_exp2f(p1[r]);
    float ps = 0;
#pragma unroll
    for (int r = 0; r < 16; ++r) ps += p0[r];
#pragma unroll
    for (int r = 0; r < 16; ++r) ps += p1[r];
    { auto rr = __builtin_amdgcn_permlane32_swap(__float_as_uint(ps), __float_as_uint(ps), false, false);
      ps = __uint_as_float(rr[0]) + __uint_as_float(rr[1]); }
    l_reg = l_reg * alpha + ps;
#define PK4(P, B_, OUT) do { unsigned a0 = cvtpk(P[B_+0], P[B_+1]), a1 = cvtpk(P[B_+2], P[B_+3]);                          \
        unsigned b0 = cvtpk(P[B_+4], P[B_+5]), b1 = cvtpk(P[B_+6], P[B_+7]);                                             \
        auto r0 = __builtin_amdgcn_permlane32_swap(a0, b0, false, false); auto r1 = __builtin_amdgcn_permlane32_swap(a1, b1, false, false); \
        u32x4 w = {r0[0], r1[0], r0[1], r1[1]}; OUT = *reinterpret_cast<bf16x8*>(&w); } while (0)
    PK4(p0, 0, pa0); PK4(p0, 8, pa1); PK4(p1, 0, pa2); PK4(p1, 8, pa3);
#undef PK4
}
template <int KB>
__device__ __forceinline__ void qkt(f32x16& p0, f32x16& p1, const LAS char* K_lds, const LAS float* cumL, int r32, int hi, const bf16x8* qr) {
    { int l_ = r32 + 32 * hi; asm volatile("" : "+v"(l_)); r32 = l_ & 31; hi = l_ >> 5; }
    const LAS float* cb = cumL + KB * 64 + 4 * hi;
#pragma unroll
    for (int g = 0; g < 4; ++g) { const f32x4 a = *(const LAS f32x4*)(cb + 8 * g), b = *(const LAS f32x4*)(cb + 32 + 8 * g);
        p0[4 * g] = a[0]; p0[4 * g + 1] = a[1]; p0[4 * g + 2] = a[2]; p0[4 * g + 3] = a[3];
        p1[4 * g] = b[0]; p1[4 * g + 1] = b[1]; p1[4 * g + 2] = b[2]; p1[4 * g + 3] = b[3]; }
    const LAS char* kb[4];
#pragma unroll
    for (int dd = 0; dd < 4; ++dd) kb[dd] = K_lds + KB * SHM_K + KSWZ(r32, (dd * 16 + hi * 8) * 2);
#pragma unroll
    for (int d0 = 0; d0 < 8; ++d0) { const LAS char* a = kb[d0 & 3] + (d0 >> 2) * 128;
        bf16x8 b0 = *reinterpret_cast<const LAS bf16x8*>(a);
        bf16x8 b1 = *reinterpret_cast<const LAS bf16x8*>(a + 32 * 256);
        p0 = __builtin_amdgcn_mfma_f32_32x32x16_bf16(b0, qr[d0], p0, 0, 0, 0);
        p1 = __builtin_amdgcn_mfma_f32_32x32x16_bf16(b1, qr[d0], p1, 0, 0, 0); }
}
template <int VB>
__device__ __forceinline__ void pv_tile(f32x16* o, int vb0, bf16x8 pa0, bf16x8 pa1, bf16x8 pa2, bf16x8 pa3) {
#define TRRD(dst, off) asm volatile("ds_read_b64_tr_b16 %0, %1 offset:%2" : "=&v"(dst) : "v"(vb0), "i"(off) : "memory")
#define PV_D0(d0) do { s16x4 l0, l1, l2, l3, h0, h1, h2, h3; constexpr int b_ = VB * SHM_V + v_rd_off(d0, 0, 0); \
        TRRD(l0, b_); TRRD(h0, b_ + 2048); TRRD(l1, b_ + 4096); TRRD(h1, b_ + 6144); TRRD(l2, b_ + 8192); TRRD(h2, b_ + 10240); TRRD(l3, b_ + 12288); TRRD(h3, b_ + 14336); \
        asm volatile("s_waitcnt lgkmcnt(0)" ::: "memory"); SBAR();   \
        o[d0] = __builtin_amdgcn_mfma_f32_32x32x16_bf16(pa0, (bf16x8){l0[0], l0[1], l0[2], l0[3], h0[0], h0[1], h0[2], h0[3]}, o[d0], 0, 0, 0);   \
        o[d0] = __builtin_amdgcn_mfma_f32_32x32x16_bf16(pa1, (bf16x8){l1[0], l1[1], l1[2], l1[3], h1[0], h1[1], h1[2], h1[3]}, o[d0], 0, 0, 0);   \
        o[d0] = __builtin_amdgcn_mfma_f32_32x32x16_bf16(pa2, (bf16x8){l2[0], l2[1], l2[2], l2[3], h2[0], h2[1], h2[2], h2[3]}, o[d0], 0, 0, 0);   \
        o[d0] = __builtin_amdgcn_mfma_f32_32x32x16_bf16(pa3, (bf16x8){l3[0], l3[1], l3[2], l3[3], h3[0], h3[1], h3[2], h3[3]}, o[d0], 0, 0, 0); } while (0)
    PV_D0(0); PV_D0(1); PV_D0(2); PV_D0(3);
#undef PV_D0
#undef TRRD
}
struct BlockRef { const bf16_t* Q; const bf16_t* K; const bf16_t* V; bf16_t* O; const float* nck; int P0; int j_lo; };
struct Seam { bf16x8 qr[8]; bf16x8 st_v0, st_v1, st_k0, st_k1; };
#define ROWP(p, k0, rr) ((p) + (size_t)((k0) + (rr)) * PKV + sc)
#define VMW() asm volatile("s_waitcnt vmcnt(0)" ::: "memory")
#define VMWN(n) asm volatile("s_waitcnt vmcnt(%0)" :: "i"(n) : "memory")
#define SLOAD_H(BR, k0, CB) do { S.st_v0 = ld8(ROWP((BR).V, k0, sr)); S.st_v1 = ld8(ROWP((BR).V, k0, 32 + sr));              \
                             S.st_k0 = ld8(ROWP((BR).K, k0, sr)); S.st_k1 = ld8(ROWP((BR).K, k0, 32 + sr)); \
                             if (wid == 0) __builtin_amdgcn_global_load_lds((const unsigned*)((BR).nck + (k0) + lane), (LAS unsigned*)(cumL + (CB) * 64), 4, 0, 0); } while (0)
#define SWRITE_HK(bf) do { int t_ = tid; asm volatile("" : "+v"(t_)); const int kws_ = KSWZ(t_ >> 4, (t_ & 15) * 16); \
                           *(LAS bf16x8*)(K_lds + (bf) * SHM_K + kws_) = S.st_k0; *(LAS bf16x8*)(K_lds + (bf) * SHM_K + kws_ + 32 * 256) = S.st_k1; } while (0)
#define SWRITE_HV(bf) do { int t_ = tid; asm volatile("" : "+v"(t_)); const int vs0_ = v_st(t_ >> 4, (t_ & 15) * 8), vs1_ = v_st(32 + (t_ >> 4), (t_ & 15) * 8); \
                           *(LAS bf16x8*)(V_lds + (bf) * SHM_V + vs0_) = S.st_v0; *(LAS bf16x8*)(V_lds + (bf) * SHM_V + vs1_) = S.st_v1; } while (0)
__device__ __forceinline__ void fox_prime(const BlockRef& cur, LAS char* lds, Seam& S) {
    const int tid = threadIdx.x, wid = __builtin_amdgcn_readfirstlane(tid >> 6), lane = tid & 63, r32 = lane & 31, hi = lane >> 5;
    const int sr = tid >> 4, sc = (tid & 15) * 8; LAS char* K_lds = lds + 2 * SHM_V; LAS float* cumL = (LAS float*)(lds + OFF_CUM);
    const int kb0 = cur.j_lo * KVBLK;
#pragma unroll
    for (int d0 = 0; d0 < 8; ++d0) S.qr[d0] = ld8(cur.Q + (size_t)(wid * QBLK + r32) * PQ + d0 * 16 + hi * 8);
    SLOAD_H(cur, kb0, 0); VMW(); SWRITE_HK(0);
    __syncthreads();
}
__device__ __forceinline__ void fox_block(const BlockRef& cur, const BlockRef& nxt, int skv, LAS char* lds, Seam& S) {
    const int tid = threadIdx.x, wid = __builtin_amdgcn_readfirstlane(tid >> 6), lane = tid & 63, r32 = lane & 31, hi = lane >> 5;
    const int j_lo = cur.j_lo;
    int j_hi = (cur.P0 + QB - 1) / KVBLK + 1; if (j_hi > skv / KVBLK) j_hi = skv / KVBLK;
    const int NT = j_hi - j_lo;
    const int kbn = nxt.j_lo * KVBLK;
    const int qlo = cur.P0 + wid * QBLK;
    LAS char* V_lds = lds; LAS char* K_lds = lds + 2 * SHM_V; LAS float* cumL = (LAS float*)(lds + OFF_CUM);
    LAS float* ws = (LAS float*)(lds + OFF_WS) + wid * 64; LAS float* li_l = ws; LAS float* al_l = ws + 32;
    float m_reg = -1e30f, l_reg = 0; f32x16 o[4] = {};
    const int sr = tid >> 4, sc = (tid & 15) * 8;
    const int vb0 = (int)(unsigned)(uintptr_t)V_lds + v_rd_base(lane);
#define RESC(a) do { if (__any((a) < 1.f)) { if (hi == 0) al_l[r32] = (a); asm volatile("s_waitcnt lgkmcnt(0)" ::: "memory");              \
                     _Pragma("unroll") for (int d_ = 0; d_ < 4; ++d_) _Pragma("unroll") for (int r = 0; r < 16; ++r) o[d_][r] *= al_l[crow(r, hi)]; } } while (0)
#define KBASE(t) ((j_lo + (t)) * KVBLK)
#define MASKT(P0_, P1_, t) do { const int kb_ = KBASE(t); if (kb_ + KVBLK - 1 > qlo) { int lc_ = lane; asm volatile("" : "+v"(lc_)); mask_tile(P0_, P1_, qlo + (lc_ & 31) - 4 * (lc_ >> 5) - kb_, WINF); } } while (0)
    constexpr int NQL = 8;
#define SEAM_K0() do { VMWN(NQL); SWRITE_HK(0); SBAR(); } while (0)
    f32x16 pA0, pA1, pB0, pB1; float mnA, mnB, alA, alB; bf16x8 pa0, pa1, pa2, pa3;
    SWRITE_HV(0); SBAR();
    if (NT > 1) { SLOAD_H(cur, KBASE(1), 1); }
    SBAR(); qkt<0>(pA0, pA1, K_lds, cumL, r32, hi, S.qr);
    MASKT(pA0, pA1, 0); partialSM(pA0, pA1, m_reg, mnA, alA);
    if (NT > 1) { VMW(); SWRITE_HV(1); SWRITE_HK(1); }
    __syncthreads();
#define HALF_STEP(PX0, PX1, mnX, alX, PY0, PY1, alY, t, KB, VB, SB) do {                                                      \
        SBAR(); qkt<KB>(PX0, PX1, K_lds, cumL, r32, hi, S.qr);                                                                \
        finishSM(PY0, PY1, alY, l_reg, pa0, pa1, pa2, pa3); SBAR();                                                           \
        if ((t) + 1 < NT) { SLOAD_H(cur, KBASE((t) + 1), SB); SBAR(); }                                                           \
        pv_tile<VB>(o, vb0, pa0, pa1, pa2, pa3); MASKT(PX0, PX1, (t)); partialSM(PX0, PX1, m_reg, mnX, alX);                  \
        __syncthreads();                                                                                                      \
        if ((t) + 1 < NT) { VMW(); SWRITE_HV(SB); SWRITE_HK(SB); }                                       \
        RESC(alX); __syncthreads(); } while (0)
    for (int t = 1; t + 1 < NT; t += 2) {
        HALF_STEP(pB0, pB1, mnB, alB, pA0, pA1, alA, t, 1, 0, 0);
        HALF_STEP(pA0, pA1, mnA, alA, pB0, pB1, alB, t + 1, 0, 1, 1);
    }
    const bool even = (NT & 1) == 0;
    if (even) { SBAR(); qkt<1>(pB0, pB1, K_lds, cumL, r32, hi, S.qr); SBAR(); }
    SLOAD_H(nxt, kbn, 0); SBAR();
    { int lc_ = lane; asm volatile("" : "+v"(lc_)); const bf16_t* qp_ = nxt.Q + (size_t)(wid * QBLK + (lc_ & 31)) * PQ + (lc_ >> 5) * 8;
#pragma unroll
    for (int d0 = 0; d0 < 8; ++d0) S.qr[d0] = ld8(qp_ + d0 * 16); }
    SBAR();
    finishSM(pA0, pA1, alA, l_reg, pa0, pa1, pa2, pa3); SBAR();
    pv_tile<0>(o, vb0, pa0, pa1, pa2, pa3);
    if (even) { MASKT(pB0, pB1, NT - 1); partialSM(pB0, pB1, m_reg, mnB, alB); __syncthreads(); RESC(alB);
        finishSM(pB0, pB1, alB, l_reg, pa0, pa1, pa2, pa3); SBAR(); pv_tile<1>(o, vb0, pa0, pa1, pa2, pa3); }
    SBAR(); SEAM_K0();
    if (hi == 0) li_l[r32] = l_reg; asm volatile("s_waitcnt lgkmcnt(0)" ::: "memory");
    float rli[16];
#pragma unroll
    for (int r = 0; r < 16; ++r) rli[r] = __builtin_amdgcn_rcpf(li_l[crow(r, hi)]);
    { int lc_ = lane; asm volatile("" : "+v"(lc_)); const int r32c = lc_ & 31, hic = lc_ >> 5;
    bf16_t* Ow = cur.O + (size_t)(wid * QBLK + 4 * hic) * PO + r32c;
#pragma unroll
    for (int r = 0; r < 16; ++r) { const int orow = (r & 3) + 8 * (r >> 2);
#pragma unroll
        for (int d0 = 0; d0 < 4; ++d0) { const float v = o[d0][r] * rli[r];
            const float vn = __shfl_xor(v, 1);
            if ((r32c & 1) == 0) *(unsigned*)(Ow + (size_t)orow * PO + d0 * 32) = cvtpk(v, vn); } } }
    __syncthreads();
#undef RESC
#undef KBASE
#undef MASKT
#undef SEAM_K0
#undef HALF_STEP
}
#undef ROWP
#undef VMW
#undef VMWN
#undef SLOAD_H
#undef SWRITE_HK
#undef SWRITE_HV
#undef SBAR
#undef KSWZ
}

typedef GAS unsigned gu32;
#define RLX_AGENT __ATOMIC_RELAXED, __HIP_MEMORY_SCOPE_AGENT
#define XB_TMO      128
#define XB_XCNT(j)  (256  + 64 * (j))
#define XB_XSUB(j)  (1280 + 64 * (j))
#define XB_XGEN(j)  (2304 + 64 * (j))
#define XB_TOP      3328
#define XB_TOPGEN   3392
#define XCD_BAR_WORDS 3456
#define XB_SPIN_CAP (1u << 20)
__device__ __forceinline__ unsigned xb_ld(unsigned* p)              { return __hip_atomic_load(p, __ATOMIC_RELAXED, __HIP_MEMORY_SCOPE_AGENT); }
__device__ __forceinline__ unsigned xb_add(unsigned* p, unsigned v) { return __hip_atomic_fetch_add(p, v, __ATOMIC_RELAXED, __HIP_MEMORY_SCOPE_AGENT); }
__device__ __forceinline__ unsigned xb_xcc_id() { return (unsigned)__builtin_amdgcn_s_getreg((3 << 11) | 20) & 0xFu; }
#define XB_SPIN(cond, bar) do { unsigned _sp = 0; while (cond) { __builtin_amdgcn_s_sleep(1); \
    if ((++_sp & 255u) == 0u) { if (xb_ld(&(bar)[XB_TMO])) break; if (_sp > XB_SPIN_CAP) { atomicAdd(&(bar)[XB_TMO], 1u); break; } } } } while (0)
struct XcdBarrier { unsigned* bar; unsigned x; volatile LAS unsigned* st; };
__device__ __forceinline__ XcdBarrier xcd_barrier_post(unsigned* bar, volatile LAS unsigned* st) {
    XcdBarrier b; b.bar = bar; b.x = xb_xcc_id(); b.st = st;
    if (threadIdx.x == 0) (void)xb_add(&bar[XB_XCNT(b.x)], 1u);
    return b;
}
__device__ __forceinline__ void xcd_barrier_complete(unsigned* bar, unsigned x, unsigned& nloc, unsigned& nx) {
    const unsigned G = gridDim.x * gridDim.y * gridDim.z;
    unsigned sum, cnt, mine, sp = 0u;
    for (;;) {
        sum = 0u; cnt = 0u; mine = 0u;
#pragma unroll
        for (unsigned j = 0; j < 16; ++j) { const unsigned c = xb_ld(&bar[XB_XCNT(j)]); sum += c; cnt += (c > 0u) ? 1u : 0u; mine = (j == x) ? c : mine; }
        if (sum == G) break;
        __builtin_amdgcn_s_sleep(1);
        if ((++sp & 255u) == 0u) { if (xb_ld(&bar[XB_TMO])) break; if (sp > XB_SPIN_CAP) { atomicAdd(&bar[XB_TMO], 1u); break; } }
    }
    nloc = mine > 0u ? mine : 1u; nx = cnt > 0u ? cnt : 1u;
}
__device__ __forceinline__ void xcd_barrier(const XcdBarrier& b) {
    asm volatile("s_waitcnt vmcnt(0)" ::: "memory");
    __syncthreads();
    if (threadIdx.x == 0) {
        unsigned* bar = b.bar;
        __builtin_amdgcn_s_waitcnt(0);
        unsigned nloc = b.st[0], nx = b.st[1];
        if (nloc == 0u) { xcd_barrier_complete(bar, b.x, nloc, nx); b.st[0] = nloc; b.st[1] = nx; }
        const unsigned old = xb_add(&bar[XB_XSUB(b.x)], 1u);
        const unsigned gen = old / nloc;
        if (old + 1u == (gen + 1u) * nloc) {
            __builtin_amdgcn_fence(__ATOMIC_RELEASE, "agent");
            asm volatile("s_waitcnt vmcnt(0)" ::: "memory");
            const unsigned og = xb_add(&bar[XB_TOP], 1u);
            const unsigned tg = og / nx;
            if (og + 1u == (tg + 1u) * nx) xb_add(&bar[XB_TOPGEN], 1u);
            else XB_SPIN(xb_ld(&bar[XB_TOPGEN]) == tg, bar);
            __builtin_amdgcn_fence(__ATOMIC_ACQUIRE, "agent");
            xb_add(&bar[XB_XGEN(b.x)], 1u);
            asm volatile("s_waitcnt vmcnt(0)" ::: "memory");
        } else {
            XB_SPIN(xb_ld(&bar[XB_XGEN(b.x)]) == gen, bar);
            __builtin_amdgcn_fence(__ATOMIC_ACQUIRE, "agent");
            asm volatile("s_waitcnt vmcnt(0)" ::: "memory");
        }
    }
    __syncthreads();
}

constexpr int NWAVES = 8;
constexpr int N_PHASES = 12;
constexpr int N_LAUNCHES = MK_N_LAUNCHES;
static_assert(N_LAUNCHES == 1 || N_LAUNCHES == N_PHASES, "MK_N_LAUNCHES is 1 (one dispatch) or 12 (one dispatch per phase)");
struct Args { const float* in[29]; float* out; unsigned char* ws; int ph_lo, ph_hi; };
struct Frame {
    LAS unsigned char* lds; volatile LAS unsigned* MISC; gu32* ctl; unsigned char* ws;
    int tid, lane, wave, vcu, G;
};

__device__ __forceinline__ void p0_tile(const float* src, int ld_src, bf16_t* dst, int ld_dst, LAS float* scr, int lane) {
    const int c4 = lane & 7, r8 = lane >> 3;
    f32x4 v[16];
#pragma unroll
    for (int it = 0; it < 16; ++it) v[it] = *(const f32x4*)(src + (size_t)(it * 8 + r8) * ld_src + 4 * c4);
#pragma unroll
    for (int it = 0; it < 16; ++it) { const int r = it * 8 + r8;
#pragma unroll
        for (int e = 0; e < 4; ++e) scr[(4 * c4 + e) * 132 + r] = v[it][e]; }
    LDS_WAIT(); asm volatile("" ::: "memory");
    const int kc = lane & 15, n4 = lane >> 4;
#pragma unroll
    for (int it = 0; it < 8; ++it) { const int n = it * 4 + n4;
        const f32x4 a = *(const LAS f32x4*)(scr + n * 132 + 8 * kc), b = *(const LAS f32x4*)(scr + n * 132 + 8 * kc + 4);
        u32x4 w; w.x = cvt_pk_bf16(a[0], a[1]); w.y = cvt_pk_bf16(a[2], a[3]); w.z = cvt_pk_bf16(b[0], b[1]); w.w = cvt_pk_bf16(b[2], b[3]);
        *(u32x4*)(dst + (size_t)n * ld_dst + 8 * kc) = w; }
    LDS_WAIT(); asm volatile("" ::: "memory");
}
template <int MODE>
__device__ __forceinline__ void p0_mat_item(const float* src, int ldsrc, int K, int N, bf16_t* dst, int which, int it, LAS float* scr, int lane) {
    const int nblk = N / 32, kb = it / nblk, nb = it - kb * nblk, k0 = 128 * kb, n0 = 32 * nb;
    const int drow = MODE == 0 ? n0 : ((n0 >> 7) * 256 + which * 128 + (n0 & 127));
    p0_tile(src + (size_t)k0 * ldsrc + n0, ldsrc, dst + (size_t)drow * K + k0, K, scr, lane);
}

__device__ __forceinline__ void p0_prologue(Frame& F, const __attribute__((address_space(4))) Args& a) {
    unsigned char* ws = F.ws;
    const int gw = F.vcu * NWAVES + F.wave, NGW = F.G * NWAVES;
    {
        LAS float* scr = (LAS float*)(F.lds + F.wave * 16896);
        constexpr int I_EXP = 256;
        constexpr int N_EG = NEXP * I_EXP, N_EU = N_EG, N_ED = N_EG;
        constexpr int I_IN = 16 * 128, I_OUT = 16 * 64, I_GLU = 8 * 32, I_R = 16 * 2, I_SG = 16 * 16, I_SU = 16 * 16, I_SD = 4 * 64;
        constexpr int NITEMS = N_EG + N_EU + N_ED + I_IN + I_OUT + I_GLU + I_R + I_SG + I_SU + I_SD;
        bf16_t* Wegu = (bf16_t*)(ws + WS_WEGU); bf16_t* Wed = (bf16_t*)(ws + WS_WED);
        for (int it = gw; it < NITEMS; it += NGW) {
            int r = it;
            if (r < N_EG) { const int e = r / I_EXP; p0_mat_item<1>(a.in[21] + (size_t)e * 2048 * 512, 512, 2048, 512, Wegu + (size_t)e * 1024 * 2048, 0, r % I_EXP, scr, F.lane); continue; } r -= N_EG;
            if (r < N_EU) { const int e = r / I_EXP; p0_mat_item<1>(a.in[22] + (size_t)e * 2048 * 512, 512, 2048, 512, Wegu + (size_t)e * 1024 * 2048, 1, r % I_EXP, scr, F.lane); continue; } r -= N_EU;
            if (r < N_ED) { const int e = r / I_EXP; p0_mat_item<0>(a.in[23] + (size_t)e * 512 * 2048, 2048, 512, 2048, Wed + (size_t)e * 2048 * 512, 0, r % I_EXP, scr, F.lane); continue; } r -= N_ED;
            if (r < I_IN) { p0_mat_item<0>(a.in[4], 4104, 2048, 4096, (bf16_t*)(ws + WS_WIN), 0, r, scr, F.lane); continue; } r -= I_IN;
            if (r < I_OUT) { p0_mat_item<0>(a.in[16], 2048, 2048, 2048, (bf16_t*)(ws + WS_WOUT), 0, r, scr, F.lane); continue; } r -= I_OUT;
            if (r < I_GLU) { p0_mat_item<0>(a.in[14], 1024, 1024, 1024, (bf16_t*)(ws + WS_WGLU), 0, r, scr, F.lane); continue; } r -= I_GLU;
            if (r < I_R) { p0_mat_item<0>(a.in[19], 64, 2048, 64, (bf16_t*)(ws + WS_WR), 0, r, scr, F.lane); continue; } r -= I_R;
            if (r < I_SG) { p0_mat_item<1>(a.in[24], 512, 2048, 512, (bf16_t*)(ws + WS_WSGU), 0, r, scr, F.lane); continue; } r -= I_SG;
            if (r < I_SU) { p0_mat_item<1>(a.in[25], 512, 2048, 512, (bf16_t*)(ws + WS_WSGU), 1, r, scr, F.lane); continue; } r -= I_SU;
            p0_mat_item<0>(a.in[26], 2048, 512, 2048, (bf16_t*)(ws + WS_WSD), 0, r, scr, F.lane);
        }
    }
    __syncthreads();
    if (F.vcu < NGRP) {
        const int g = F.vcu, t = F.tid;
        LAS float* apr = (LAS float*)F.lds;
        LAS float* api = apr + 64 * 33;
        LAS float* bbr = api + 64 * 33;
        LAS float* bbi = bbr + 1024;
        LAS float* cr = bbi + 1024;
        LAS float* ci = cr + 1024;
        LAS float* kg = ci + 1024;
        LAS float* dsk = kg + 8192;
        const float* a_re = a.in[6]; const float* a_im = a.in[7]; const float* log_dt = a.in[8];
        const float* b_re = a.in[9]; const float* b_im = a.in[10]; const float* c_re = a.in[11]; const float* c_im = a.in[12]; const float* dsk_g = a.in[13];
        if (t < 64) { const int p = t; const float ar = a_re[g * 64 + p], ai = a_im[g * 64 + p], dt = expf(log_dt[g]);
            for (int tau = 0; tau <= 32; ++tau) { const float m = expf((float)tau * dt * ar); float s, c; sincosf((float)tau * dt * ai, &s, &c); apr[p * 33 + tau] = m * c; api[p * 33 + tau] = m * s; }
            const float abr = apr[p * 33 + 1] - 1.f, abi = api[p * 33 + 1], den = ar * ar + ai * ai;
            const float cre = (abr * ar + abi * ai) / den, cim = (abi * ar - abr * ai) / den;
            for (int h = 0; h < 16; ++h) { const float br = b_re[(g * 64 + p) * 16 + h], bi = b_im[(g * 64 + p) * 16 + h]; bbr[p * 16 + h] = cre * br - cim * bi; bbi[p * 16 + h] = cre * bi + cim * br; } }
        for (int idx = t; idx < 1024; idx += 512) { cr[idx] = c_re[g * 1024 + idx]; ci[idx] = c_im[g * 1024 + idx]; }
        if (t < 16) dsk[t] = dsk_g[g * 16 + t];
        __syncthreads();
        for (int idx = t; idx < 8192; idx += 512) { const int tau = idx >> 8, hp = (idx >> 4) & 15, h = idx & 15; float acc = 0.f;
            for (int p = 0; p < 64; ++p) { const float c_r = cr[hp * 64 + p], c_i = ci[hp * 64 + p], pr = apr[p * 33 + tau], pi = api[p * 33 + tau];
                const float gr = c_r * pr - c_i * pi, gi = c_r * pi + c_i * pr; acc += gr * bbr[p * 16 + h] - gi * bbi[p * 16 + h]; }
            if (tau == 0 && hp == h) acc += dsk[h];
            kg[idx] = acc; }
        __syncthreads();
        bf16_t* OPY = (bf16_t*)(ws + WS_OPY) + (size_t)g * 512 * UGK;
        for (int it = t; it < 512 * 80; it += 512) { const int n = it / 80, ch = it - n * 80, tt = n >> 4, hp = n & 15; float v[8];
            if (ch < 64) { const int j = ch >> 1, h0 = (ch & 1) * 8;
#pragma unroll
                for (int e = 0; e < 8; ++e) v[e] = (tt >= j) ? kg[(tt - j) * 256 + hp * 16 + h0 + e] : 0.f; }
            else { const int q = ch - 64;
#pragma unroll
                for (int e2 = 0; e2 < 4; ++e2) { const int p = q * 4 + e2; const float c_r = cr[hp * 64 + p], c_i = ci[hp * 64 + p], pr = apr[p * 33 + tt + 1], pi = api[p * 33 + tt + 1];
                    v[2 * e2] = c_r * pr - c_i * pi; v[2 * e2 + 1] = -(c_r * pi + c_i * pr); } }
            u32x4 w; w.x = cvt_pk_bf16(v[0], v[1]); w.y = cvt_pk_bf16(v[2], v[3]); w.z = cvt_pk_bf16(v[4], v[5]); w.w = cvt_pk_bf16(v[6], v[7]);
            *(u32x4*)(OPY + (size_t)n * UGK + ch * 8) = w; }
        bf16_t* OPE = (bf16_t*)(ws + WS_OPE) + (size_t)g * 256 * 512;
        for (int it = t; it < 256 * 64; it += 512) { const int n = it >> 6, ch = it & 63; float v[8];
            if (n < 128) { const int p = n >> 1, ri = n & 1, j = ch >> 1, h0 = (ch & 1) * 8; const float pr = apr[p * 33 + 31 - j], pi = api[p * 33 + 31 - j];
#pragma unroll
                for (int e = 0; e < 8; ++e) { const float br = bbr[p * 16 + h0 + e], bi = bbi[p * 16 + h0 + e]; v[e] = ri == 0 ? (pr * br - pi * bi) : (pr * bi + pi * br); } }
            else {
#pragma unroll
                for (int e = 0; e < 8; ++e) v[e] = 0.f; }
            u32x4 w; w.x = cvt_pk_bf16(v[0], v[1]); w.y = cvt_pk_bf16(v[2], v[3]); w.z = cvt_pk_bf16(v[4], v[5]); w.w = cvt_pk_bf16(v[6], v[7]);
            *(u32x4*)(OPE + (size_t)n * 512 + ch * 8) = w; }
    }
    __syncthreads();
    {
        const int gt = F.vcu * 512 + F.tid, NGT = F.G * 512; const u32x4 z4 = {0u, 0u, 0u, 0u};
        for (int i = gt; i < 2 * 2 * 48 * 128; i += NGT) { const int ch = i & 127, r = (i >> 7) % 48, b = ((i >> 7) / 48) & 1, kv = (i >> 7) / 96;
            bf16_t* base = (bf16_t*)(ws + (kv ? WS_V : WS_K)); *(u32x4*)(base + ((size_t)b * KVR + r) * 1024 + ch * 8) = z4; }
        for (int i = gt; i < 128 * 32; i += NGT) { const int ch = i & 31, gb = i >> 5;
            *(u32x4*)((bf16_t*)(ws + WS_UG) + ((size_t)gb * NCHK + 1) * UGK + ch * 8) = z4; }
        for (int i = gt; i < 16 * 48; i += NGT) { const int r = i % 48, bh = i / 48; ((float*)(ws + WS_LOGF))[(size_t)bh * KVR + r] = 0.f; }
    }
    {
        LAS float* wf = (LAS float*)F.lds;
        for (int i = F.tid; i < 8 * 2048; i += 512) { const int h = i & 7, k = i >> 3; wf[h * 2048 + k] = a.in[4][(size_t)k * 4104 + 4096 + h]; }
        __syncthreads();
        const float* x = a.in[0]; const float* meta = a.in[1]; const float* lg = a.in[2]; const float* lb = a.in[3]; const float* bfg = a.in[5];
        bf16_t* XN = (bf16_t*)(ws + WS_XN); float* logf_ = (float*)(ws + WS_LOGF);
        for (int row = gw; row < MX + NMETA; row += NGW) {
            const float* src = row < MX ? x + (size_t)row * DM : meta + (size_t)(row - MX) * DM;
            f32x4 v[8]; float s = 0.f;
#pragma unroll
            for (int j = 0; j < 8; ++j) { v[j] = ((const f32x4*)src)[j * 64 + F.lane]; s += (v[j][0] + v[j][1]) + (v[j][2] + v[j][3]); }
            const float mean = wave_sum(s) * (1.f / DM); float s2 = 0.f;
#pragma unroll
            for (int j = 0; j < 8; ++j) { v[j] = v[j] - mean; s2 += (v[j][0] * v[j][0] + v[j][1] * v[j][1]) + (v[j][2] * v[j][2] + v[j][3] * v[j][3]); }
            const float rstd = 1.f / sqrtf(wave_sum(s2) * (1.f / DM) + LN_EPS);
            float fl[8];
#pragma unroll
            for (int h = 0; h < 8; ++h) fl[h] = 0.f;
#pragma unroll
            for (int j = 0; j < 8; ++j) { const f32x4 g4 = ((const f32x4*)lg)[j * 64 + F.lane], b4 = ((const f32x4*)lb)[j * 64 + F.lane];
                v[j] = v[j] * rstd * g4 + b4;
                *(u32x2*)(XN + (size_t)row * DM + j * 256 + F.lane * 4) = (u32x2){cvt_pk_bf16(v[j][0], v[j][1]), cvt_pk_bf16(v[j][2], v[j][3])};
#pragma unroll
                for (int h = 0; h < 8; ++h) { const f32x4 w4 = *(const LAS f32x4*)(wf + h * 2048 + j * 256 + F.lane * 4); fl[h] += (v[j][0] * w4[0] + v[j][1] * w4[1]) + (v[j][2] * w4[2] + v[j][3] * w4[3]); } }
#pragma unroll
            for (int h = 0; h < 8; ++h) fl[h] = wave_sum(fl[h]);
            if (F.lane < 8) { const int h = F.lane;
                float val = h == 0 ? fl[0] : h == 1 ? fl[1] : h == 2 ? fl[2] : h == 3 ? fl[3] : h == 4 ? fl[4] : h == 5 ? fl[5] : h == 6 ? fl[6] : fl[7];
                val += bfg[h];
                const float lf = fminf(val, 0.f) - log1pf(expf(-fabsf(val)));
                if (row < MX) { const int b = row >> 13, sx = row & (SEQ - 1); logf_[(size_t)(b * 8 + h) * KVR + 64 + sx] = lf; }
                else { const int i = row - MX; logf_[(size_t)(0 * 8 + h) * KVR + 48 + i] = lf; logf_[(size_t)(1 * 8 + h) * KVR + 48 + i] = lf; } }
        }
    }
}

__device__ __forceinline__ void p1_cumsum(Frame& F, int seq) {
    const float* lf = (const float*)(F.ws + WS_LOGF) + (size_t)seq * KVR; float* cum = (float*)(F.ws + WS_CUM) + (size_t)seq * KVR;
    LAS float* part = (LAS float*)F.lds;
    constexpr int PER = 17; const int i0 = F.tid * PER; float s = 0.f;
    for (int k = 0; k < PER; ++k) { const int i = i0 + k; if (i < KVR) s += lf[i]; }
    part[F.tid] = s; __syncthreads();
    float pre = 0.f; for (int j = 0; j < F.tid; ++j) pre += part[j];
    for (int k = 0; k < PER; ++k) { const int i = i0 + k; if (i < KVR) { pre += lf[i]; cum[i] = (i < 48) ? -__builtin_inff() : -pre * LOG2E; } }
    __syncthreads();
}

__device__ __forceinline__ void moe_tables(Frame& F) {
    LAS int* tb = (LAS int*)(F.lds + TB_OFF);
    if (F.tid < NEXP) tb[130 + F.tid] = (int)__hip_atomic_load(F.ctl + CW_CNT + 64 * F.tid, RLX_AGENT);
    __syncthreads();
    if (F.tid == 0) { int tp = 0, cp = 0; for (int e = 0; e < NEXP; ++e) { tb[e] = tp; tb[65 + e] = cp; const int c = tb[130 + e]; tp += (c + 255) >> 8; cp += c; } tb[64] = tp; tb[129] = cp; }
    __syncthreads();
}

template <unsigned MASK>
__global__ void __launch_bounds__(NWAVES * 64, 2) hymba_fwd(Args args_) {
    extern __shared__ __attribute__((aligned(16))) unsigned char lds[];
    (void)args_;
    const __attribute__((address_space(4))) Args& args = *(const __attribute__((address_space(4))) Args*)__builtin_amdgcn_kernarg_segment_ptr();
    Frame F;
    F.lds = (LAS unsigned char*)lds;
    F.MISC = (volatile LAS unsigned*)(F.lds + MISC_OFF);
    F.tid = threadIdx.x; F.lane = F.tid & 63; F.wave = __builtin_amdgcn_readfirstlane(F.tid >> 6);
    F.G = gridDim.x; { const int bx = blockIdx.x; F.vcu = (F.G % 8 == 0) ? (bx % 8) * (F.G / 8) + bx / 8 : bx; }
    unsigned char* ws = args.ws; F.ws = ws;
    F.ctl = (gu32*)(ws + WS_CTL);
    for (int u = F.tid; u < (LDS_BYTES - LDSCTL_OFF) / 4; u += NWAVES * 64) ((LAS unsigned*)(F.lds + LDSCTL_OFF))[u] = 0u;
    __syncthreads();
    XcdBarrier bar; bar.bar = (unsigned*)(F.ctl + CW_BAR); bar.x = 0; bar.st = nullptr;
    if (N_LAUNCHES == 1) bar = xcd_barrier_post((unsigned*)(F.ctl + CW_BAR), F.MISC + 8);
#define GRID_BAR() do { if (N_LAUNCHES == 1) xcd_barrier(bar); } while (0)
    const int lo = args.ph_lo, hi = args.ph_hi;
#define IN(k) (((MASK >> (k)) & 1u) && lo <= (k) && (k) < hi)
#define BOTH(k) (IN(k) && IN((k) + 1))
    const int gw = F.vcu * NWAVES + F.wave, NGW = F.G * NWAVES;
    const int bx = (int)blockIdx.x;

    if (IN(0)) { p0_prologue(F, args); if (BOTH(0)) GRID_BAR(); }

    if (IN(1)) {
        if (F.vcu < 16) p1_cumsum(F, F.vcu);
        pg8::DenseOrder S; S.init(ws + WS_XN, ws + WS_WIN, DM, DM, MIN_ROWS, 4096, F.G, bx);
        pg8::EpiInProj E{(bf16_t*)(ws + WS_UG), (bf16_t*)(ws + WS_Q), (bf16_t*)(ws + WS_K), (bf16_t*)(ws + WS_V)};
        pg8::gemm_phase<pg8::EpiInProj, pg8::DenseOrder, true>(F.lds, pg8::GemmK{DM, DM, DM}, S, E);
        if (BOTH(1)) GRID_BAR();
    }

    if (IN(2)) {
        pg8::EOrder S{(const char*)(ws + WS_UG), (const char*)(ws + WS_OPE), F.G, bx};
        pg8::EpiE E{(float*)(ws + WS_E)};
        pg8::gemm_phase<pg8::EpiE, pg8::EOrder, true>(F.lds, pg8::GemmK{512, UGK, 512}, S, E);
        if (BOTH(2)) GRID_BAR();
    }

    if (IN(3)) {
        for (int sq = gw; sq < 128; sq += NGW) {
            const int g = sq >> 1, p = F.lane;
            const float dt = expf(args.in[8][g]), ar = args.in[6][g * 64 + p], ai = args.in[7][g * 64 + p];
            const float mag = expf(32.f * dt * ar); float sn, cs; sincosf(32.f * dt * ai, &sn, &cs);
            const float a_r = mag * cs, a_i = mag * sn;
            const float* Eb = (const float*)(ws + WS_E) + (size_t)sq * 256 * 128 + 2 * p;
            bf16_t* Ub = (bf16_t*)(ws + WS_UG) + (size_t)sq * NCHK * UGK + 512 + 2 * p;
            float sr = 0.f, si = 0.f;
#pragma unroll 8
            for (int r = 0; r < 256; ++r) { const f32x2 e = *(const f32x2*)(Eb + (size_t)r * 128);
                const float nr = a_r * sr - a_i * si + e[0], ni = a_r * si + a_i * sr + e[1]; sr = nr; si = ni;
                *(unsigned*)(Ub + (size_t)(r + 2) * UGK) = cvt_pk_bf16(sr, si); }
        }
        if (BOTH(3)) GRID_BAR();
    }

    if (IN(4)) {
        pg8::YOrder S{(const char*)(ws + WS_UG), (const char*)(ws + WS_OPY), F.G, bx};
        pg8::EpiY E{(bf16_t*)(ws + WS_YB)};
        pg8::gemm_phase<pg8::EpiY, pg8::YOrder, true>(F.lds, pg8::GemmK{UGK, UGK, UGK}, S, E);
        if (BOTH(4)) GRID_BAR();
    }

    if (IN(5)) {
        pg8::DenseOrder S; S.init(ws + WS_YB, ws + WS_WGLU, 1024, 1024, MX, 1024, F.G, bx);
        pg8::EpiGlu E{(const bf16_t*)(ws + WS_YB), args.in[15], (bf16_t*)(ws + WS_YC)};
        pg8::gemm_phase<pg8::EpiGlu, pg8::DenseOrder, true>(F.lds, pg8::GemmK{1024, 1024, 1024}, S, E);
        if (BOTH(5)) GRID_BAR();
    }

    if (IN(6)) {
        const bf16_t* Qb = (const bf16_t*)(ws + WS_Q); const bf16_t* Kb = (const bf16_t*)(ws + WS_K); const bf16_t* Vb = (const bf16_t*)(ws + WS_V);
        bf16_t* YC = (bf16_t*)(ws + WS_YC); const float* nck = (const float*)(ws + WS_CUM);
        const int nitems = 256;
        LAS char* al = (LAS char*)F.lds;
        att::Seam S;
#define MKREF(R, bh_, qb_) do { const int b_ = (bh_) >> 3, h_ = (bh_) & 7; (R).Q = Qb + ((size_t)b_ * SEQ + (size_t)(qb_) * 256) * 1024 + h_ * 128; \
        (R).K = Kb + (size_t)b_ * KVR * 1024 + h_ * 128; (R).V = Vb + (size_t)b_ * KVR * 1024 + h_ * 128; (R).O = YC + ((size_t)b_ * SEQ + (size_t)(qb_) * 256) * 2048 + 1024 + h_ * 128; \
        (R).nck = nck + (size_t)(bh_) * KVR; (R).P0 = 64 + (qb_) * 256; (R).j_lo = 0; } while (0)
        int L = F.vcu;
        if (L < nitems) {
            int pass = 0; att::BlockRef cur, nxt;
            MKREF(cur, L >> 4, L & 15);
            att::fox_prime(cur, al, S);
            for (;;) {
                const bool more_pass = pass == 0, more_item = L + F.G < nitems, last = !more_pass && !more_item;
                int Ln = L, passn = pass + 1;
                if (!more_pass) { passn = 0; Ln = more_item ? L + F.G : L; }
                if (last) nxt = cur; else { const int x = Ln & 15; MKREF(nxt, Ln >> 4, passn ? 31 - x : x); }
                att::fox_block(cur, nxt, KVR, al, S);
                if (last) break;
                cur = nxt; pass = passn; L = Ln;
            }
        }
#undef MKREF
        if (BOTH(6)) GRID_BAR();
    }

    if (IN(7)) {
        pg8::DenseOrder S; S.init(ws + WS_YC, ws + WS_WOUT, 2048, 2048, MX, 2048, F.G, bx);
        pg8::EpiOut E{(const bf16_t*)(ws + WS_XN), (float*)(ws + WS_Z), (float*)(ws + WS_ST)};
        pg8::gemm_phase<pg8::EpiOut, pg8::DenseOrder, true>(F.lds, pg8::GemmK{2048, 2048, 2048}, S, E);
        if (BOTH(7)) GRID_BAR();
    }

    if (IN(8)) {
        const float* Z = (const float*)(ws + WS_Z); const float* ST = (const float*)(ws + WS_ST); bf16_t* H1 = (bf16_t*)(ws + WS_XN);
        const bf16_t* WR = (const bf16_t*)(ws + WS_WR); const float* lg_ = args.in[17]; const float* lb_ = args.in[18]; const float* rbias = args.in[20];
        int* IDX = (int*)(ws + WS_IDX); float* GWt = (float*)(ws + WS_GW); int* RK = (int*)(ws + WS_RK); int* TOK = (int*)(ws + WS_TOK);
        LAS float* lgs = (LAS float*)(F.lds + F.wave * 4352);
        const int r16 = F.lane & 15, kq = F.lane >> 4;
        const float my_bias = rbias[F.lane];
        for (int rb = gw; rb < MX / 16; rb += NGW) {
            const int row = rb * 16 + r16;
            float s = 0.f, q = 0.f;
#pragma unroll
            for (int i = 0; i < 4; ++i) { const f32x4 t4 = *(const f32x4*)(ST + (size_t)row * 64 + kq * 16 + i * 4); s += t4[0] + t4[2]; q += t4[1] + t4[3]; }
            s += __shfl_xor(s, 16); s += __shfl_xor(s, 32); q += __shfl_xor(q, 16); q += __shfl_xor(q, 32);
            const float mean = s * (1.f / DM), var = fmaxf(q * (1.f / DM) - mean * mean, 0.f), rstd = 1.f / sqrtf(var + LN_EPS);
            f32x4 acc[4];
#pragma unroll
            for (int nb = 0; nb < 4; ++nb) acc[nb] = (f32x4){0.f, 0.f, 0.f, 0.f};
#pragma unroll 2
            for (int ks = 0; ks < 64; ++ks) { const int k0 = ks * 32 + kq * 8;
                const f32x4 z0 = *(const f32x4*)(Z + (size_t)row * DM + k0), z1 = *(const f32x4*)(Z + (size_t)row * DM + k0 + 4);
                const f32x4 g0 = *(const f32x4*)(lg_ + k0), g1 = *(const f32x4*)(lg_ + k0 + 4), b0 = *(const f32x4*)(lb_ + k0), b1 = *(const f32x4*)(lb_ + k0 + 4);
                const f32x4 y0 = (z0 - mean) * rstd * g0 + b0, y1 = (z1 - mean) * rstd * g1 + b1;
                const u32x4 w = pg8::pack8(y0, y1);
                *(u32x4*)(H1 + (size_t)row * DM + k0) = w;
                const bf16x8 af = __builtin_bit_cast(bf16x8, w);
#pragma unroll
                for (int nb = 0; nb < 4; ++nb) { const bf16x8 bfm = *(const bf16x8*)(WR + (size_t)(nb * 16 + r16) * DM + k0);
                    acc[nb] = __builtin_amdgcn_mfma_f32_16x16x32_bf16(af, bfm, acc[nb], 0, 0, 0); } }
#pragma unroll
            for (int nb = 0; nb < 4; ++nb)
#pragma unroll
                for (int rg = 0; rg < 4; ++rg) lgs[(kq * 4 + rg) * 65 + nb * 16 + r16] = acc[nb][rg];
            LDS_WAIT(); asm volatile("" ::: "memory");
            for (int r = 0; r < 16; ++r) {
                const int trow = rb * 16 + r;
                const float score = fast_sigmoid(lgs[r * 65 + F.lane]);
                const float sel = score + my_bias;
                float m1 = sel; m1 = fmaxf(m1, __shfl_xor(m1, 1)); m1 = fmaxf(m1, __shfl_xor(m1, 2)); m1 = fmaxf(m1, __shfl_xor(m1, 4));
                int i1 = (sel == m1) ? F.lane : 1000; i1 = min(i1, __shfl_xor(i1, 1)); i1 = min(i1, __shfl_xor(i1, 2)); i1 = min(i1, __shfl_xor(i1, 4));
                float m2 = (F.lane == i1) ? -__builtin_inff() : sel; m2 = fmaxf(m2, __shfl_xor(m2, 1)); m2 = fmaxf(m2, __shfl_xor(m2, 2)); m2 = fmaxf(m2, __shfl_xor(m2, 4));
                const float gs = m1 + m2; const int mygrp = F.lane >> 3;
                int gcount = 0;
#pragma unroll
                for (int j = 0; j < 8; ++j) { const float gj = __shfl(gs, 8 * j); gcount += (gj > gs || (gj == gs && j < mygrp)) ? 1 : 0; }
                const bool cand = gcount < 4;
                const float cs = cand ? sel : -__builtin_inff();
                int rank = 0;
#pragma unroll 8
                for (int j = 0; j < 64; ++j) { const float cj = __shfl(cs, j); rank += (cj > cs || (cj == cs && j < F.lane)) ? 1 : 0; }
                const bool chosen = cand && rank < TOPK;
                const float tot = wave_sum(chosen ? score : 0.f);
                if (chosen) { const float gate = score / tot * ROUTED_SCALE;
                    const unsigned pos = __hip_atomic_fetch_add(F.ctl + CW_CNT + 64 * F.lane, 1u, RLX_AGENT);
                    TOK[(size_t)F.lane * MX + pos] = trow;
                    IDX[(size_t)trow * 8 + rank] = F.lane; GWt[(size_t)trow * 8 + rank] = gate; RK[(size_t)trow * 8 + rank] = (int)pos; }
            }
            LDS_WAIT(); asm volatile("" ::: "memory");
        }
        if (BOTH(8)) GRID_BAR();
    }

    if (IN(9)) {
        moe_tables(F);
        const LAS int* tb = (const LAS int*)(F.lds + TB_OFF);
        pg8::MoeOrder S; S.tb = tb; S.TT = tb[64]; S.NCT = 4; S.nsh = 64 * 4; S.nwg = S.TT * 4 + S.nsh; S.G = F.G; S.c = bx; S.lda = DM; S.ldb = DM;
        S.Aexp = (const char*)(ws + WS_XN); S.tok = (const int*)(ws + WS_TOK); S.Bexp = (const char*)(ws + WS_WEGU); S.bstride = (size_t)1024 * 2048 * 2;
        S.Ash = (const char*)(ws + WS_XN); S.Bsh = (const char*)(ws + WS_WSGU); S.gather = true;
        pg8::EpiGU E{(bf16_t*)(ws + WS_HID), (bf16_t*)(ws + WS_HIDS)};
        pg8::gemm_phase<pg8::EpiGU, pg8::MoeOrder, true>(F.lds, pg8::GemmK{DM, DM, DM}, S, E);
        if (BOTH(9)) GRID_BAR();
    }

    if (IN(10)) {
        moe_tables(F);
        const LAS int* tb = (const LAS int*)(F.lds + TB_OFF);
        pg8::MoeOrder S; S.tb = tb; S.TT = tb[64]; S.NCT = 8; S.nsh = 64 * 8; S.nwg = S.TT * 8 + S.nsh; S.G = F.G; S.c = bx; S.lda = EFF; S.ldb = EFF;
        S.Aexp = (const char*)(ws + WS_HID); S.tok = nullptr; S.Bexp = (const char*)(ws + WS_WED); S.bstride = (size_t)2048 * 512 * 2;
        S.Ash = (const char*)(ws + WS_HIDS); S.Bsh = (const char*)(ws + WS_WSD); S.gather = false;
        pg8::EpiDown E{(bf16_t*)(ws + WS_C), (bf16_t*)(ws + WS_CS)};
        pg8::gemm_phase<pg8::EpiDown, pg8::MoeOrder, true>(F.lds, pg8::GemmK{EFF, EFF, EFF}, S, E);
        if (BOTH(10)) GRID_BAR();
    }

    if (IN(11)) {
        moe_tables(F);
        const LAS int* tb = (const LAS int*)(F.lds + TB_OFF);
        const bf16_t* H1 = (const bf16_t*)(ws + WS_XN); const bf16_t* CS = (const bf16_t*)(ws + WS_CS); const bf16_t* C = (const bf16_t*)(ws + WS_C);
        const int* IDX = (const int*)(ws + WS_IDX); const float* GWt = (const float*)(ws + WS_GW); const int* RK = (const int*)(ws + WS_RK);
        const float* lg_ = args.in[27]; const float* lb_ = args.in[28]; float* out = args.out;
        for (int row = gw; row < MX; row += NGW) {
            const i32x4 e0 = *(const i32x4*)(IDX + (size_t)row * 8), e1 = *(const i32x4*)(IDX + (size_t)row * 8 + 4);
            const i32x4 r0 = *(const i32x4*)(RK + (size_t)row * 8), r1 = *(const i32x4*)(RK + (size_t)row * 8 + 4);
            const f32x4 w0 = *(const f32x4*)(GWt + (size_t)row * 8), w1 = *(const f32x4*)(GWt + (size_t)row * 8 + 4);
            int slot[8]; float wk[8];
            slot[0] = tb[65 + e0[0]] + r0[0]; slot[1] = tb[65 + e0[1]] + r0[1]; slot[2] = tb[65 + e0[2]] + r0[2]; slot[3] = tb[65 + e0[3]] + r0[3];
            slot[4] = tb[65 + e1[0]] + r1[0]; slot[5] = tb[65 + e1[1]] + r1[1]; slot[6] = tb[65 + e1[2]] + r1[2]; slot[7] = tb[65 + e1[3]] + r1[3];
            wk[0] = w0[0]; wk[1] = w0[1]; wk[2] = w0[2]; wk[3] = w0[3]; wk[4] = w1[0]; wk[5] = w1[1]; wk[6] = w1[2]; wk[7] = w1[3];
            float acc[4][8];
#pragma unroll
            for (int j = 0; j < 4; ++j) { int lo_ = (j * 64 + F.lane) * 8; asm volatile("" : "+v"(lo_)); const size_t off = (size_t)row * DM + (size_t)lo_;
                const u32x4 hw = *(const u32x4*)(H1 + off), sw = *(const u32x4*)(CS + off);
                u32x4 cw[8];
#pragma unroll
                for (int k = 0; k < 8; ++k) cw[k] = *(const u32x4*)(C + (size_t)slot[k] * DM + (size_t)lo_);
                acc[j][0] = ALPHA * bf_lo(hw.x) + bf_lo(sw.x); acc[j][1] = ALPHA * bf_hi(hw.x) + bf_hi(sw.x); acc[j][2] = ALPHA * bf_lo(hw.y) + bf_lo(sw.y); acc[j][3] = ALPHA * bf_hi(hw.y) + bf_hi(sw.y);
                acc[j][4] = ALPHA * bf_lo(hw.z) + bf_lo(sw.z); acc[j][5] = ALPHA * bf_hi(hw.z) + bf_hi(sw.z); acc[j][6] = ALPHA * bf_lo(hw.w) + bf_lo(sw.w); acc[j][7] = ALPHA * bf_hi(hw.w) + bf_hi(sw.w);
#pragma unroll
                for (int k = 0; k < 8; ++k) { acc[j][0] += wk[k] * bf_lo(cw[k].x); acc[j][1] += wk[k] * bf_hi(cw[k].x); acc[j][2] += wk[k] * bf_lo(cw[k].y); acc[j][3] += wk[k] * bf_hi(cw[k].y);
                    acc[j][4] += wk[k] * bf_lo(cw[k].z); acc[j][5] += wk[k] * bf_hi(cw[k].z); acc[j][6] += wk[k] * bf_lo(cw[k].w); acc[j][7] += wk[k] * bf_hi(cw[k].w); }
                asm volatile("" ::: "memory"); }
            float s = 0.f;
#pragma unroll
            for (int j = 0; j < 4; ++j)
#pragma unroll
                for (int e = 0; e < 8; ++e) s += acc[j][e];
            const float mean = wave_sum(s) * (1.f / DM); float s2 = 0.f;
#pragma unroll
            for (int j = 0; j < 4; ++j)
#pragma unroll
                for (int e = 0; e < 8; ++e) { acc[j][e] -= mean; s2 += acc[j][e] * acc[j][e]; }
            const float rstd = 1.f / sqrtf(wave_sum(s2) * (1.f / DM) + LN_EPS);
#pragma unroll
            for (int j = 0; j < 4; ++j) { int c0 = (j * 64 + F.lane) * 8; asm volatile("" : "+v"(c0));
                const f32x4 g0 = *(const f32x4*)(lg_ + c0), g1 = *(const f32x4*)(lg_ + c0 + 4), b0 = *(const f32x4*)(lb_ + c0), b1 = *(const f32x4*)(lb_ + c0 + 4);
                f32x4 o0, o1;
#pragma unroll
                for (int e = 0; e < 4; ++e) { o0[e] = acc[j][e] * rstd * g0[e] + b0[e]; o1[e] = acc[j][4 + e] * rstd * g1[e] + b1[e]; }
                *(f32x4*)(out + (size_t)row * DM + c0) = o0; *(f32x4*)(out + (size_t)row * DM + c0 + 4) = o1; }
        }
    }
#undef IN
#undef BOTH
#undef GRID_BAR
}

#ifndef PH_MASK
#define PH_MASK 0xFFFu
#endif
typedef void (*kern_t)(Args);
template <unsigned MASK> static bool prep_kernel(kern_t& k) {
    k = hymba_fwd<MASK>;
    if (hipFuncSetAttribute((const void*)hymba_fwd<MASK>, hipFuncAttributeMaxDynamicSharedMemorySize, LDS_BYTES) != hipSuccess) { fprintf(stderr, "kernel_launch: hipFuncSetAttribute failed (mask %x)\n", MASK); return false; }
    return true;
}
extern "C" void kernel_launch(void* const* d_in, const int* in_sizes, int n_in, void* d_out, int out_size, void* d_ws, size_t ws_size, hipStream_t stream) {
    static int grid = 0; static kern_t kerns[N_PHASES];
    if (grid == 0) {
        if (n_in != 29 || in_sizes[0] != MX * DM || out_size != MX * DM || ws_size < WS_END) {
            fprintf(stderr, "kernel_launch: unexpected shapes (n_in %d, in0 %d, out %d, ws %zu; need ws >= %zu); nothing launched\n", n_in, n_in > 0 ? in_sizes[0] : -1, out_size, ws_size, (size_t)WS_END); grid = -1; return; }
        int dev = 0, cus = 0;
        if (hipGetDevice(&dev) != hipSuccess || hipDeviceGetAttribute(&cus, hipDeviceAttributeMultiprocessorCount, dev) != hipSuccess) { fprintf(stderr, "kernel_launch: device query failed\n"); grid = -1; return; }
        bool ok = true;
        if constexpr (N_LAUNCHES == 1) ok = prep_kernel<PH_MASK>(kerns[0]);
        else { ok = ok && prep_kernel<0x001u>(kerns[0]) && prep_kernel<0x002u>(kerns[1]) && prep_kernel<0x004u>(kerns[2]) && prep_kernel<0x008u>(kerns[3]) && prep_kernel<0x010u>(kerns[4]) && prep_kernel<0x020u>(kerns[5])
                       && prep_kernel<0x040u>(kerns[6]) && prep_kernel<0x080u>(kerns[7]) && prep_kernel<0x100u>(kerns[8]) && prep_kernel<0x200u>(kerns[9]) && prep_kernel<0x400u>(kerns[10]) && prep_kernel<0x800u>(kerns[11]); }
        if (!ok) { grid = -1; return; }
        (void)hipGetLastError();
        grid = cus;
    }
    if (grid < 0) return;
    if (hipMemsetAsync((char*)d_ws + WS_CTL, 0, CTL_ZERO_BYTES, stream) != hipSuccess) { fprintf(stderr, "kernel_launch: memset failed\n"); return; }
    Args a{};
    for (int i = 0; i < 29; ++i) a.in[i] = (const float*)d_in[i];
    a.out = (float*)d_out; a.ws = (unsigned char*)d_ws;
    for (int li = 0; li < N_LAUNCHES; ++li) {
        if (N_LAUNCHES != 1 && !((PH_MASK >> li) & 1u)) continue;
        a.ph_lo = (N_LAUNCHES == 1) ? 0 : li; a.ph_hi = (N_LAUNCHES == 1) ? N_PHASES : li + 1;
        hipLaunchKernelGGL(kerns[li], dim3(grid), dim3(NWAVES * 64), LDS_BYTES, stream, a);
        const hipError_t le = hipPeekAtLastError();
        if (le != hipSuccess) { fprintf(stderr, "kernel_launch: launch %d failed: %s\n", li, hipGetErrorName(le)); break; }
    }
}
```

```cpp
#include <hip/hip_runtime.h>
#include <cstdio>
#include <cstdint>

#ifndef MK_N_LAUNCHES
#define MK_N_LAUNCHES 1
#endif

#define LAS __attribute__((address_space(3)))
#define GAS __attribute__((address_space(1)))
typedef unsigned short bf16_t;
typedef short bf16x8 __attribute__((ext_vector_type(8)));
typedef short s16x4 __attribute__((ext_vector_type(4)));
typedef float f32x2 __attribute__((ext_vector_type(2)));
typedef float f32x4 __attribute__((ext_vector_type(4)));
typedef float f32x16 __attribute__((ext_vector_type(16)));
typedef unsigned u32x2 __attribute__((ext_vector_type(2)));
typedef unsigned u32x4 __attribute__((ext_vector_type(4)));
typedef int i32x4 __attribute__((ext_vector_type(4)));

constexpr int BATCH = 2, SEQ = 8192, DM = 2048, NMETA = 16;
constexpr int MX = BATCH * SEQ;
constexpr int MIN_ROWS = MX + 256;
constexpr int NHEAD = 8, HD = 128, NGRP = 64, NST = 64;
constexpr int KVR = 64 + SEQ;
constexpr int NCHK = KVR / 32;
constexpr int UGK = 640;
constexpr int NEXP = 64, TOPK = 8, EFF = 512;
constexpr float LN_EPS = 1e-5f;
constexpr float ALPHA = 1.189207115002721f;
constexpr float ROUTED_SCALE = 2.5f;
constexpr float LOG2E = 1.4426950408889634f;
constexpr float QSCALE = 0.08838834764831845f * 1.4426950408889634f;

constexpr size_t MiB = 1u << 20;
constexpr size_t WS_CTL = 0, CTL_ZERO_BYTES = 1 * MiB;
constexpr size_t WS_LOGF = 1 * MiB;
constexpr size_t WS_CUM = 2 * MiB;
constexpr size_t WS_IDX = 3 * MiB;
constexpr size_t WS_GW = 3 * MiB + 512 * 1024;
constexpr size_t WS_RK = 4 * MiB;
constexpr size_t WS_WR = 4 * MiB + 512 * 1024;
constexpr size_t WS_TOK = 5 * MiB;
constexpr size_t WS_ST = 9 * MiB;
constexpr size_t WS_XN = 16 * MiB;
constexpr size_t WS_WED = 81 * MiB;
constexpr size_t WS_WSD = 209 * MiB;
constexpr size_t WS_WSGU = 211 * MiB;
constexpr size_t WS_WGLU = 215 * MiB;
constexpr size_t WS_WOUT = 217 * MiB;
constexpr size_t WS_WIN = 225 * MiB;
constexpr size_t WS_HID = 241 * MiB;
constexpr size_t WS_YC = 241 * MiB;
constexpr size_t WS_YB = 305 * MiB;
constexpr size_t WS_Q = 337 * MiB;
constexpr size_t WS_HIDS = 370 * MiB;
constexpr size_t WS_CS = 386 * MiB;
constexpr size_t WS_C = 450 * MiB;
constexpr size_t WS_WEGU = 450 * MiB;
constexpr size_t WS_Z = 706 * MiB;
constexpr size_t WS_K = 834 * MiB;
constexpr size_t WS_V = 867 * MiB;
constexpr size_t WS_UG = 900 * MiB;
constexpr size_t WS_OPY = 941 * MiB;
constexpr size_t WS_OPE = 981 * MiB;
constexpr size_t WS_E = 997 * MiB;
constexpr size_t WS_END = 1013 * MiB;
static_assert(WS_HID + (size_t)(131072 + 256) * 512 * 2 <= WS_HIDS && WS_Q + (size_t)MX * 1024 * 2 <= WS_HIDS, "map");
static_assert(WS_K + (size_t)2 * KVR * 1024 * 2 <= WS_V && WS_V + (size_t)2 * KVR * 1024 * 2 <= WS_UG, "map");
static_assert(WS_UG + (size_t)64 * 2 * NCHK * UGK * 2 <= WS_OPY && WS_C + (size_t)131072 * 2048 * 2 <= WS_END, "map");
static_assert(WS_XN + (size_t)MIN_ROWS * 2048 * 2 <= WS_WED, "map");
constexpr int CW_TMO = 0, CW_CODE = 1;
constexpr int CW_CNT = 1024;
constexpr int CW_KMAX = 5120;
constexpr int CW_QMAX = 5184;
constexpr int CW_BAR = 8192;
constexpr float T_SKIP = 40.f;

constexpr int RING_BYTES = 139264;
constexpr int LDSCTL_OFF = RING_BYTES;
constexpr int MISC_OFF = LDSCTL_OFF + 64;
constexpr int TB_OFF = LDSCTL_OFF + 1024;
constexpr int LDS_BYTES = 147456;

__device__ __forceinline__ unsigned cvt_pk_bf16(float lo, float hi) { unsigned r; asm volatile("v_cvt_pk_bf16_f32 %0, %1, %2" : "=v"(r) : "v"(lo), "v"(hi)); return r; }
__device__ __forceinline__ float bf_lo(unsigned w) { return __uint_as_float(w << 16); }
__device__ __forceinline__ float bf_hi(unsigned w) { return __uint_as_float(w & 0xffff0000u); }
__device__ __forceinline__ float fast_sigmoid(float x) { return __builtin_amdgcn_rcpf(1.f + __builtin_amdgcn_exp2f(-x * LOG2E)); }
__device__ __forceinline__ float wave_sum(float v) {
#pragma unroll
    for (int o = 1; o < 64; o <<= 1) v += __shfl_xor(v, o);
    return v;
}
#define LDS_WAIT() asm volatile("s_waitcnt lgkmcnt(0)" ::: "memory")
#define VM_WAIT() asm volatile("s_waitcnt vmcnt(0)" ::: "memory")

namespace pg8 {
constexpr int BM = 256, BK = 64, HALF = 128, HTB = HALF * BK * 2, STAGE_BYTES = 8 * HTB, NXCD = 8, WGM = 8;
__host__ __device__ __forceinline__ int lds_byte(int r, int c) { const int st = (r >> 4) * 2 + (c >> 5), rr = r & 15, cc = c & 31, ob = rr * 64 + cc * 2; return st * 1024 + (ob ^ (((ob >> 9) & 1) << 5)); }
__host__ __device__ __forceinline__ void stage_rc(int b, int& R, int& C) { const int st = b / 1024, sb = b % 1024, swz = sb ^ (((sb >> 9) & 1) << 5); R = (st >> 1) * 16 + swz / 64; C = (st & 1) * 32 + (swz % 64) / 2; }
__host__ __device__ __forceinline__ int perm32(int rho) { const int n = rho >> 4, i = rho & 15; return 8 * (i >> 2) + 4 * n + (i & 3); }

struct Unit { const char* A; const char* B; const int* rows; int r0, c0, valid, aux; };
struct GemmK { int K, lda, ldb; };

template <class Epi, class Sched, bool ALIGN_EPI>
__device__ __forceinline__ void gemm_phase(LAS unsigned char* lds, const GemmK g, const Sched& S, const Epi& E) {
    const int tid = threadIdx.x, wid = __builtin_amdgcn_readfirstlane(tid >> 6), lane = tid & 63, wr = wid >> 2, wc = wid & 3, fr = lane & 15, fq = lane >> 4;
    const int K = g.K, nt = K / BK;
    int Rs[2], Cs[2]; unsigned voffB[2];
#pragma unroll
    for (int i = 0; i < 2; ++i) { int R, C; stage_rc(tid * 16 + i * 8192, R, C); const int Rb = Epi::PERM ? ((R & ~31) + perm32(R & 31)) : R;
        Rs[i] = R; Cs[i] = C; voffB[i] = (unsigned)(Rb * g.ldb + C) * 2u; }
    const size_t kstep = (size_t)(BK * 2);
    const size_t hstepB = (size_t)HALF * g.ldb * 2;
    const unsigned ldsw = (unsigned)wid * 1024u;
    const int aoff = lds_byte(wr * 64 + fr, fq * 8), boff = lds_byte(wc * 32 + fr, fq * 8);
#define PG8_SA(b, h) (((b) * 2 + (h)) * HTB)
#define PG8_SB(b, h) ((4 + (b) * 2 + (h)) * HTB)
#define PG8_STAGE(bufoff, gbase, voff) do { _Pragma("unroll") for (int _i = 0; _i < 2; ++_i) \
        __builtin_amdgcn_global_load_lds((const unsigned*)((const char*)(gbase) + (voff)[_i]), (LAS unsigned*)(lds + (bufoff) + ldsw + _i * 8192), 16, 0, 0); } while (0)
#define PG8_LDA(dst, b, h) do { _Pragma("unroll") for (int m = 0; m < 4; ++m) _Pragma("unroll") for (int k = 0; k < 2; ++k) dst[m][k] = *(const LAS bf16x8*)(lds + PG8_SA(b, h) + aoff + m * 2048 + k * 1024); } while (0)
#define PG8_LDB(dst, b, h) do { _Pragma("unroll") for (int n = 0; n < 2; ++n) _Pragma("unroll") for (int k = 0; k < 2; ++k) dst[n][k] = *(const LAS bf16x8*)(lds + PG8_SB(b, h) + boff + n * 2048 + k * 1024); } while (0)
#define PG8_MMA(ai, bj, At, Bt) do { __builtin_amdgcn_s_setprio(1); _Pragma("unroll") for (int m = 0; m < 4; ++m) _Pragma("unroll") for (int n = 0; n < 2; ++n) _Pragma("unroll") for (int k = 0; k < 2; ++k) \
        acc[ai][bj][m][n] = __builtin_amdgcn_mfma_f32_16x16x32_bf16(Bt[n][k], At[m][k], acc[ai][bj][m][n], 0, 0, 0); __builtin_amdgcn_s_setprio(0); } while (0)
#define PG8_WAIT_V(n) asm volatile("s_waitcnt vmcnt(" #n ")" ::: "memory")
#define PG8_WAIT_L(n) asm volatile("s_waitcnt lgkmcnt(" #n ")" ::: "memory")
#define PG8_BAR __builtin_amdgcn_s_barrier()
#define PG8_SCHED __builtin_amdgcn_sched_barrier(0)
#define PG8_VOFFA(u, v0, v1) do { _Pragma("unroll") for (int _i = 0; _i < 2; ++_i) { v0[_i] = S.a_off(u, Rs[_i]) + (unsigned)Cs[_i] * 2u; v1[_i] = S.a_off(u, Rs[_i] + HALF) + (unsigned)Cs[_i] * 2u; } } while (0)
    Unit cur, nxt; int ui = 0;
    if (!S.next(0, cur)) return;
    f32x4 acc[2][2][4][2];
#pragma unroll
    for (int a = 0; a < 2; ++a)
#pragma unroll
        for (int b = 0; b < 2; ++b)
#pragma unroll
            for (int m = 0; m < 4; ++m)
#pragma unroll
                for (int n = 0; n < 2; ++n) acc[a][b][m][n] = (f32x4){0.f, 0.f, 0.f, 0.f};
    bf16x8 At[4][2], B0[2][2], B1[2][2];
    const char* cA = cur.A; const char* cB = cur.B;
    unsigned vA0[2], vA1[2], nA0[2], nA1[2];
    PG8_VOFFA(cur, vA0, vA1);
    PG8_STAGE(PG8_SB(0, 0), cB, voffB); PG8_STAGE(PG8_SB(0, 1), cB + hstepB, voffB); PG8_STAGE(PG8_SA(0, 0), cA, vA0); PG8_STAGE(PG8_SA(0, 1), cA, vA1);
    if (wr == 1) PG8_BAR;
    PG8_WAIT_V(2); PG8_BAR;
    PG8_STAGE(PG8_SB(1, 0), cB + kstep, voffB); PG8_STAGE(PG8_SA(1, 0), cA + kstep, vA0); PG8_STAGE(PG8_SB(1, 1), cB + hstepB + kstep, voffB);
    PG8_WAIT_V(6); PG8_BAR;
    for (;;) {
        const bool has_next = S.next(ui + 1, nxt);
        const char* nA = has_next ? nxt.A : cA; const char* nB = has_next ? nxt.B : cB;
        if (has_next) { PG8_VOFFA(nxt, nA0, nA1); } else { nA0[0] = vA0[0]; nA0[1] = vA0[1]; nA1[0] = vA1[0]; nA1[1] = vA1[1]; }
        for (int t = 0; t < nt; t += 2) {
            const bool last = (t == nt - 2);
            const char* a1 = cA + (size_t)(t + 1) * kstep;
            const char* a2 = last ? nA : cA + (size_t)(t + 2) * kstep; const char* b2 = last ? nB : cB + (size_t)(t + 2) * kstep;
            const char* a3 = a2 + kstep; const char* b3 = b2 + kstep;
            unsigned w0[2], w1[2];
            w0[0] = last ? nA0[0] : vA0[0]; w0[1] = last ? nA0[1] : vA0[1]; w1[0] = last ? nA1[0] : vA1[0]; w1[1] = last ? nA1[1] : vA1[1];
            PG8_LDB(B0, 0, 0); PG8_LDB(B1, 0, 1); PG8_SCHED; PG8_LDA(At, 0, 0); PG8_STAGE(PG8_SA(1, 1), a1, vA1);
            PG8_WAIT_V(8); PG8_WAIT_L(0); PG8_BAR; PG8_MMA(0, 0, At, B0); PG8_MMA(0, 1, At, B1); PG8_BAR; PG8_SCHED;
            PG8_LDA(At, 0, 1); PG8_STAGE(PG8_SB(0, 0), b2, voffB); PG8_STAGE(PG8_SB(0, 1), b2 + hstepB, voffB); PG8_STAGE(PG8_SA(0, 0), a2, w0);
            PG8_WAIT_V(8); PG8_WAIT_L(0); PG8_BAR; PG8_MMA(1, 0, At, B0); PG8_MMA(1, 1, At, B1); PG8_BAR; PG8_SCHED;
            PG8_LDB(B0, 1, 0); PG8_LDB(B1, 1, 1); PG8_SCHED; PG8_LDA(At, 1, 0); PG8_STAGE(PG8_SA(0, 1), a2, w1);
            PG8_WAIT_V(8); PG8_WAIT_L(0); PG8_BAR; PG8_MMA(0, 0, At, B0); PG8_MMA(0, 1, At, B1); PG8_BAR; PG8_SCHED;
            PG8_LDA(At, 1, 1); PG8_STAGE(PG8_SB(1, 0), b3, voffB); PG8_STAGE(PG8_SB(1, 1), b3 + hstepB, voffB); PG8_STAGE(PG8_SA(1, 0), a3, w0);
            PG8_WAIT_V(8); PG8_WAIT_L(0); PG8_BAR; PG8_MMA(1, 0, At, B0); PG8_MMA(1, 1, At, B1); PG8_BAR; PG8_SCHED;
        }
        if constexpr (ALIGN_EPI) { if (wr == 0) PG8_BAR; }
        E(acc, cur, wr, wc, fr, fq);
        if (!has_next) break;
#pragma unroll
        for (int a = 0; a < 2; ++a)
#pragma unroll
            for (int b = 0; b < 2; ++b)
#pragma unroll
                for (int m = 0; m < 4; ++m)
#pragma unroll
                    for (int n = 0; n < 2; ++n) acc[a][b][m][n] = (f32x4){0.f, 0.f, 0.f, 0.f};
        cur = nxt; cA = nA; cB = nB; ++ui;
        vA0[0] = nA0[0]; vA0[1] = nA0[1]; vA1[0] = nA1[0]; vA1[1] = nA1[1];
        if constexpr (ALIGN_EPI) { if (wr == 1) PG8_BAR; }
    }
    PG8_WAIT_V(0);
    if constexpr (!ALIGN_EPI) { if (wr == 0) PG8_BAR; }
    PG8_BAR;
#undef PG8_SA
#undef PG8_SB
#undef PG8_STAGE
#undef PG8_LDA
#undef PG8_LDB
#undef PG8_MMA
#undef PG8_WAIT_V
#undef PG8_WAIT_L
#undef PG8_BAR
#undef PG8_SCHED
#undef PG8_VOFFA
}

__device__ __forceinline__ int xcd_remap(int L, int nwg) { const int q = nwg / NXCD, r = nwg % NXCD, xcd = L % NXCD, off = L / NXCD; return (xcd < r ? xcd * (q + 1) : r * (q + 1) + (xcd - r) * q) + off; }

struct DenseOrder {
    const char* A; const char* B; int lda, ldb, nM, nN, nwg, G, c;
    __device__ __forceinline__ void init(const void* A_, const void* B_, int lda_, int ldb_, int M, int N, int G_, int c_) { A = (const char*)A_; B = (const char*)B_; lda = lda_; ldb = ldb_; nM = M / BM; nN = N / BM; nwg = nM * nN; G = G_; c = c_; }
    __device__ __forceinline__ bool next(int i, Unit& u) const {
        const long L = (long)i * G + c; if (L >= nwg) return false;
        const int wgid = xcd_remap((int)L, nwg);
        const int nig = WGM * nN, gid = wgid / nig, fm = gid * WGM, gsz = (nM - fm) < WGM ? (nM - fm) : WGM;
        const int pm = fm + ((wgid % nig) % gsz), pn = (wgid % nig) / gsz;
        u.A = A + (size_t)pm * BM * lda * 2; u.B = B + (size_t)pn * BM * ldb * 2; u.rows = nullptr; u.r0 = pm * BM; u.c0 = pn; u.valid = BM; u.aux = 0; return true;
    }
    __device__ __forceinline__ unsigned a_off(const Unit&, int R) const { return (unsigned)R * (unsigned)lda * 2u; }
};
struct EOrder {
    const char* UG; const char* OPE; int G, c;
    __device__ __forceinline__ bool next(int i, Unit& u) const {
        const int L = i * G + c; if (L >= 128) return false;
        const int g = L >> 1, b = L & 1;
        u.A = UG + ((size_t)((g * 2 + b) * NCHK + 1)) * UGK * 2; u.B = OPE + (size_t)g * 256 * 512 * 2; u.rows = nullptr; u.r0 = (g * 2 + b) * 256; u.c0 = 0; u.valid = BM; u.aux = g; return true;
    }
    __device__ __forceinline__ unsigned a_off(const Unit&, int R) const { return (unsigned)R * (unsigned)(UGK * 2); }
};
struct YOrder {
    const char* UG; const char* OPY; int G, c;
    __device__ __forceinline__ bool next(int i, Unit& u) const {
        const int L = i * G + c; if (L >= 256) return false;
        const int g = L >> 2, b = (L >> 1) & 1, pn = L & 1;
        u.A = UG + ((size_t)((g * 2 + b) * NCHK + 2)) * UGK * 2; u.B = OPY + ((size_t)g * 512 + pn * 256) * UGK * 2; u.rows = nullptr; u.r0 = b; u.c0 = pn; u.valid = BM; u.aux = g; return true;
    }
    __device__ __forceinline__ unsigned a_off(const Unit&, int R) const { return (unsigned)R * (unsigned)(UGK * 2); }
};
struct MoeOrder {
    const LAS int* tb;
    int TT, NCT, nsh, nwg, G, c, lda, ldb;
    const char* Aexp; const int* tok; const char* Bexp; size_t bstride; const char* Ash; const char* Bsh; bool gather;
    __device__ __forceinline__ bool next(int i, Unit& u) const {
        const long L = (long)i * G + c; if (L >= nwg) return false;
        const int wgid = xcd_remap((int)L, nwg);
        if (wgid < TT * NCT) {
            const int gr = wgid / NCT, ct = wgid - gr * NCT;
            int lo = 0, hi = NEXP;
            while (hi - lo > 1) { const int mid = (lo + hi) >> 1; if (tb[mid] <= gr) lo = mid; else hi = mid; }
            const int e = lo, rt = gr - tb[e], cn = tb[130 + e], cp = tb[65 + e];
            int valid = cn - rt * BM; valid = valid > BM ? BM : valid;
            if (gather) { u.A = Aexp; u.rows = tok + (size_t)e * MX + rt * BM; }
            else { u.A = Aexp + (size_t)(cp + rt * BM) * lda * 2; u.rows = nullptr; }
            u.B = Bexp + (size_t)e * bstride + (size_t)ct * BM * ldb * 2; u.r0 = cp + rt * BM; u.c0 = ct; u.valid = valid; u.aux = 0;
        } else {
            const int s = wgid - TT * NCT, pm = s / NCT, ct = s - pm * NCT;
            u.A = Ash + (size_t)pm * BM * lda * 2; u.rows = nullptr; u.B = Bsh + (size_t)ct * BM * ldb * 2; u.r0 = pm * BM; u.c0 = ct; u.valid = BM; u.aux = 1;
        }
        return true;
    }
    __device__ __forceinline__ unsigned a_off(const Unit& u, int R) const {
        if (u.rows) { const int i = R < u.valid ? R : u.valid - 1; return (unsigned)u.rows[i] * (unsigned)lda * 2u; }
        return (unsigned)R * (unsigned)lda * 2u;
    }
};

#define EPI_LOOP_ROWS for (int ai = 0; ai < 2; ++ai) _Pragma("unroll") for (int m = 0; m < 4; ++m)
__device__ __forceinline__ u32x4 pack8(f32x4 v0, f32x4 v1) { u32x4 w; w.x = cvt_pk_bf16(v0[0], v0[1]); w.y = cvt_pk_bf16(v0[2], v0[3]); w.z = cvt_pk_bf16(v1[0], v1[1]); w.w = cvt_pk_bf16(v1[2], v1[3]); return w; }

struct EpiInProj {
    static constexpr bool PERM = true;
    bf16_t* UG; bf16_t* Q; bf16_t* Kb; bf16_t* Vb;
    __device__ __forceinline__ void operator()(const f32x4 (&acc)[2][2][4][2], const Unit& u, int wr, int wc, int fr, int fq) const {
        const int pn = u.c0, sect = pn >> 2; const bool meta = (u.r0 >= MX);
        if (meta && sect == 1) return;
        const float sc = sect == 1 ? QSCALE : 1.f;
#pragma unroll
        EPI_LOOP_ROWS { const int rt = ai * HALF + wr * 64 + m * 16 + fr;
            if (meta && rt >= NMETA) continue;
#pragma unroll
            for (int bj = 0; bj < 2; ++bj) {
                const int col = (pn & 3) * 256 + bj * HALF + wc * 32 + 8 * fq;
                const u32x4 w = pack8(acc[ai][bj][m][0] * sc, acc[ai][bj][m][1] * sc);
                if (!meta) { const int row = u.r0 + rt, b = row >> 13, s = row & (SEQ - 1);
                    if (sect == 0) { const int gch = col >> 4, half = (col >> 3) & 1;
                        *(u32x4*)(UG + ((size_t)((gch * 2 + b) * NCHK + 2 + (s >> 5)) * UGK + (s & 31) * 16 + 8 * half)) = w; }
                    else if (sect == 1) *(u32x4*)(Q + (size_t)row * 1024 + col) = w;
                    else { bf16_t* dst = sect == 2 ? Kb : Vb; *(u32x4*)(dst + ((size_t)b * KVR + 64 + s) * 1024 + col) = w; }
                } else {
#pragma unroll
                    for (int b = 0; b < 2; ++b) {
                        if (sect == 0) { const int gch = col >> 4, half = (col >> 3) & 1;
                            *(u32x4*)(UG + ((size_t)((gch * 2 + b) * NCHK + 1) * UGK + (16 + rt) * 16 + 8 * half)) = w; }
                        else { bf16_t* dst = sect == 2 ? Kb : Vb; *(u32x4*)(dst + ((size_t)b * KVR + 48 + rt) * 1024 + col) = w; }
                    }
                }
            }
        }
    }
};
struct EpiE {
    static constexpr bool PERM = false;
    float* E;
    __device__ __forceinline__ void operator()(const f32x4 (&acc)[2][2][4][2], const Unit& u, int wr, int wc, int fr, int fq) const {
#pragma unroll
        EPI_LOOP_ROWS { const int rt = ai * HALF + wr * 64 + m * 16 + fr;
#pragma unroll
            for (int n = 0; n < 2; ++n) *(f32x4*)(E + (size_t)(u.r0 + rt) * 128 + wc * 32 + 16 * n + 4 * fq) = acc[ai][0][m][n]; }
    }
};
__device__ __forceinline__ float gelu_tanh(float v) { const float t = 1.5957691216057308f * (v + 0.044715f * v * v * v); return v * fast_sigmoid(t); }
struct EpiY {
    static constexpr bool PERM = true;
    bf16_t* YB;
    __device__ __forceinline__ void operator()(const f32x4 (&acc)[2][2][4][2], const Unit& u, int wr, int wc, int fr, int fq) const {
        const int b = u.r0, g = u.aux;
#pragma unroll
        EPI_LOOP_ROWS { const int rt = ai * HALF + wr * 64 + m * 16 + fr;
#pragma unroll
            for (int bj = 0; bj < 2; ++bj) { const int col = u.c0 * 256 + bj * HALF + wc * 32 + 8 * fq, t = col >> 4, h0 = col & 15;
                f32x4 v0 = acc[ai][bj][m][0], v1 = acc[ai][bj][m][1];
#pragma unroll
                for (int e = 0; e < 4; ++e) { v0[e] = gelu_tanh(v0[e]); v1[e] = gelu_tanh(v1[e]); }
                *(u32x4*)(YB + ((size_t)b * SEQ + 32 * rt + t) * 1024 + g * 16 + h0) = pack8(v0, v1); } }
    }
};
struct EpiGlu {
    static constexpr bool PERM = true;
    const bf16_t* YB; const float* bias; bf16_t* YC;
    __device__ __forceinline__ void operator()(const f32x4 (&acc)[2][2][4][2], const Unit& u, int wr, int wc, int fr, int fq) const {
#pragma unroll
        for (int bj = 0; bj < 2; ++bj) { const int col = u.c0 * 256 + bj * HALF + wc * 32 + 8 * fq;
            const f32x4 b0 = *(const f32x4*)(bias + col), b1 = *(const f32x4*)(bias + col + 4);
#pragma unroll
            EPI_LOOP_ROWS { const int row = u.r0 + ai * HALF + wr * 64 + m * 16 + fr;
                const u32x4 yw = *(const u32x4*)(YB + (size_t)row * 1024 + col);
                f32x4 v0 = acc[ai][bj][m][0] + b0, v1 = acc[ai][bj][m][1] + b1;
                v0[0] = bf_lo(yw.x) * fast_sigmoid(v0[0]); v0[1] = bf_hi(yw.x) * fast_sigmoid(v0[1]); v0[2] = bf_lo(yw.y) * fast_sigmoid(v0[2]); v0[3] = bf_hi(yw.y) * fast_sigmoid(v0[3]);
                v1[0] = bf_lo(yw.z) * fast_sigmoid(v1[0]); v1[1] = bf_hi(yw.z) * fast_sigmoid(v1[1]); v1[2] = bf_lo(yw.w) * fast_sigmoid(v1[2]); v1[3] = bf_hi(yw.w) * fast_sigmoid(v1[3]);
                *(u32x4*)(YC + (size_t)row * 2048 + col) = pack8(v0, v1); } }
    }
};
struct EpiOut {
    static constexpr bool PERM = false;
    const bf16_t* XN; float* Z; float* ST;
    __device__ __forceinline__ void operator()(const f32x4 (&acc)[2][2][4][2], const Unit& u, int wr, int wc, int fr, int fq) const {
#pragma unroll
        EPI_LOOP_ROWS { const int row = u.r0 + ai * HALF + wr * 64 + m * 16 + fr; float s = 0.f, q = 0.f;
#pragma unroll
            for (int bj = 0; bj < 2; ++bj)
#pragma unroll
                for (int n = 0; n < 2; ++n) { const int col = u.c0 * 256 + bj * HALF + wc * 32 + 16 * n + 4 * fq;
                    const u32x2 hw = *(const u32x2*)(XN + (size_t)row * 2048 + col);
                    f32x4 z = acc[ai][bj][m][n];
                    z[0] += ALPHA * bf_lo(hw.x); z[1] += ALPHA * bf_hi(hw.x); z[2] += ALPHA * bf_lo(hw.y); z[3] += ALPHA * bf_hi(hw.y);
                    s += (z[0] + z[1]) + (z[2] + z[3]); q += (z[0] * z[0] + z[1] * z[1]) + (z[2] * z[2] + z[3] * z[3]);
                    *(f32x4*)(Z + (size_t)row * 2048 + col) = z; }
            s += __shfl_xor(s, 16); s += __shfl_xor(s, 32); q += __shfl_xor(q, 16); q += __shfl_xor(q, 32);
            if (fq == 0) *(f32x2*)(ST + ((size_t)row * 32 + u.c0 * 4 + wc) * 2) = (f32x2){s, q}; }
    }
};
struct EpiGU {
    static constexpr bool PERM = true;
    bf16_t* HID; bf16_t* HIDS;
    __device__ __forceinline__ void operator()(const f32x4 (&acc)[2][2][4][2], const Unit& u, int wr, int wc, int fr, int fq) const {
        bf16_t* dst = u.aux ? HIDS : HID;
#pragma unroll
        EPI_LOOP_ROWS { const int rt = ai * HALF + wr * 64 + m * 16 + fr;
            if (rt < u.valid) { f32x4 h0, h1;
#pragma unroll
                for (int e = 0; e < 4; ++e) { const float g0 = acc[ai][0][m][0][e], g1 = acc[ai][0][m][1][e];
                    h0[e] = g0 * fast_sigmoid(g0) * acc[ai][1][m][0][e]; h1[e] = g1 * fast_sigmoid(g1) * acc[ai][1][m][1][e]; }
                *(u32x4*)(dst + (size_t)(u.r0 + rt) * EFF + u.c0 * HALF + wc * 32 + 8 * fq) = pack8(h0, h1); } }
    }
};
struct EpiDown {
    static constexpr bool PERM = true;
    bf16_t* C; bf16_t* CS;
    __device__ __forceinline__ void operator()(const f32x4 (&acc)[2][2][4][2], const Unit& u, int wr, int wc, int fr, int fq) const {
        bf16_t* dst = u.aux ? CS : C;
#pragma unroll
        EPI_LOOP_ROWS { const int rt = ai * HALF + wr * 64 + m * 16 + fr;
            if (rt < u.valid) {
#pragma unroll
                for (int bj = 0; bj < 2; ++bj) *(u32x4*)(dst + (size_t)(u.r0 + rt) * 2048 + u.c0 * 256 + bj * HALF + wc * 32 + 8 * fq) = pack8(acc[ai][bj][m][0], acc[ai][bj][m][1]); } }
    }
};
}

namespace att {
constexpr int D = 128, NW = 8, QBLK = 32, KVBLK = 64, QB = NW * QBLK;
constexpr int PQ = 1024, PKV = 1024, PO = 2048;
constexpr int SHM_V = KVBLK * D * 2, SHM_K = KVBLK * D * 2;
constexpr int OFF_WS = 2 * SHM_V + 2 * SHM_K, OFF_CUM = OFF_WS + NW * 64 * 4, LDS_BYTES = OFF_CUM + 2 * 64 * 4;
constexpr float THR2 = 8.f * 1.4426950408889634f;
constexpr unsigned WINF = 0x7fffffffu;
#define KSWZ(row, colB) ((row) * 256 + ((colB) ^ (((row) & 7) << 4)))
#define SBAR() __builtin_amdgcn_sched_barrier(0)
__device__ __forceinline__ int v_st(int k, int c) { const int kk = (k & ~0xC) | ((k & 4) << 1) | ((k & 8) >> 1); return ((kk >> 3) * 4 + (c >> 5)) * 512 + ((kk & 7) * 32 + (c & 31)) * 2; }
__device__ __forceinline__ int v_rd_base(int lane) { return ((lane & 3) << 3) | (((lane >> 2) & 3) << 6) | (((lane >> 4) & 1) << 5) | (((lane >> 5) & 1) << 8); }
constexpr int v_rd_off(int d0, int ks, int half) { return d0 * 512 + ks * 4096 + half * 2048; }
__device__ __forceinline__ int crow(int r, int hi) { return (r & 3) + 8 * (r >> 2) + 4 * hi; }
__device__ __forceinline__ unsigned cvtpk(float lo, float hi) { unsigned r; asm volatile("v_cvt_pk_bf16_f32 %0, %1, %2" : "=v"(r) : "v"(lo), "v"(hi)); return r; }
__device__ __forceinline__ bf16x8 ld8(const bf16_t* p) { return *reinterpret_cast<const bf16x8*>(p); }
__device__ __forceinline__ void mask_tile(f32x16& p0, f32x16& p1, int dq, unsigned W) {
    const float NEG = -__builtin_inff();
#pragma unroll
    for (int r = 0; r < 16; ++r) { const int c = (r & 3) + 8 * (r >> 2);
        if ((unsigned)(dq - c) >= W) p0[r] = NEG;
        if ((unsigned)(dq - c - 32) >= W) p1[r] = NEG; }
}
__device__ __forceinline__ void partialSM(f32x16& p0, f32x16& p1, float& m_reg, float& mn, float& alpha) {
    float pmax = p0[0];
#pragma unroll
    for (int r = 1; r < 16; ++r) pmax = fmaxf(pmax, p0[r]);
#pragma unroll
    for (int r = 0; r < 16; ++r) pmax = fmaxf(pmax, p1[r]);
    { auto rr = __builtin_amdgcn_permlane32_swap(__float_as_uint(pmax), __float_as_uint(pmax), false, false);
      pmax = fmaxf(__uint_as_float(rr[0]), __uint_as_float(rr[1])); }
    if (__builtin_expect(__all((pmax - m_reg) <= THR2), 1)) { mn = m_reg; alpha = 1.f; }
    else { mn = fmaxf(m_reg, pmax); alpha = __builtin_amdgcn_exp2f(m_reg - mn); m_reg = mn; }
#pragma unroll
    for (int r = 0; r < 16; ++r) p0[r] = p0[r] - mn;
#pragma unroll
    for (int r = 0; r < 16; ++r) p1[r] = p1[r] - mn;
#pragma unroll
    for (int r = 0; r < 16; ++r) p0[r] = __builtin_amdgcn_exp2f(p0[r]);
}
__device__ __forceinline__ void finishSM(f32x16& p0, f32x16& p1, float alpha, float& l_reg, bf16x8& pa0, bf16x8& pa1, bf16x8& pa2, bf16x8& pa3) {
#pragma unroll
    for (int r = 0; r < 16; ++r) p1[r] = __builtin_amdgcn_exp2f(p1[r]);
    float ps = 0;
#pragma unroll
    for (int r = 0; r < 16; ++r) ps += p0[r];
#pragma unroll
    for (int r = 0; r < 16; ++r) ps += p1[r];
    { auto rr = __builtin_amdgcn_permlane32_swap(__float_as_uint(ps), __float_as_uint(ps), false, false);
      ps = __uint_as_float(rr[0]) + __uint_as_float(rr[1]); }
    l_reg = l_reg * alpha + ps;
#define PK4(P, B_, OUT) do { unsigned a0 = cvtpk(P[B_+0], P[B_+1]), a1 = cvtpk(P[B_+2], P[B_+3]);                          \
        unsigned b0 = cvtpk(P[B_+4], P[B_+5]), b1 = cvtpk(P[B_+6], P[B_+7]);                                             \
        auto r0 = __builtin_amdgcn_permlane32_swap(a0, b0, false, false); auto r1 = __builtin_amdgcn_permlane32_swap(a1, b1, false, false); \
        u32x4 w = {r0[0], r1[0], r0[1], r1[1]}; OUT = *reinterpret_cast<bf16x8*>(&w); } while (0)
    PK4(p0, 0, pa0); PK4(p0, 8, pa1); PK4(p1, 0, pa2); PK4(p1, 8, pa3);
#undef PK4
}
template <int KB>
__device__ __forceinline__ void qkt(f32x16& p0, f32x16& p1, const LAS char* K_lds, const LAS float* cumL, int r32, int hi, const bf16x8* qr) {
    { int l_ = r32 + 32 * hi; asm volatile("" : "+v"(l_)); r32 = l_ & 31; hi = l_ >> 5; }
    const LAS float* cb = cumL + KB * 64 + 4 * hi;
#pragma unroll
    for (int g = 0; g < 4; ++g) { const f32x4 a = *(const LAS f32x4*)(cb + 8 * g), b = *(const LAS f32x4*)(cb + 32 + 8 * g);
        p0[4 * g] = a[0]; p0[4 * g + 1] = a[1]; p0[4 * g + 2] = a[2]; p0[4 * g + 3] = a[3];
        p1[4 * g] = b[0]; p1[4 * g + 1] = b[1]; p1[4 * g + 2] = b[2]; p1[4 * g + 3] = b[3]; }
    const LAS char* kb[4];
#pragma unroll
    for (int dd = 0; dd < 4; ++dd) kb[dd] = K_lds + KB * SHM_K + KSWZ(r32, (dd * 16 + hi * 8) * 2);
#pragma unroll
    for (int d0 = 0; d0 < 8; ++d0) { const LAS char* a = kb[d0 & 3] + (d0 >> 2) * 128;
        bf16x8 b0 = *reinterpret_cast<const LAS bf16x8*>(a);
        bf16x8 b1 = *reinterpret_cast<const LAS bf16x8*>(a + 32 * 256);
        p0 = __builtin_amdgcn_mfma_f32_32x32x16_bf16(b0, qr[d0], p0, 0, 0, 0);
        p1 = __builtin_amdgcn_mfma_f32_32x32x16_bf16(b1, qr[d0], p1, 0, 0, 0); }
}
template <int VB>
__device__ __forceinline__ void pv_tile(f32x16* o, int vb0, bf16x8 pa0, bf16x8 pa1, bf16x8 pa2, bf16x8 pa3) {
#define TRRD(dst, off) asm volatile("ds_read_b64_tr_b16 %0, %1 offset:%2" : "=&v"(dst) : "v"(vb0), "i"(off) : "memory")
#define PV_D0(d0) do { s16x4 l0, l1, l2, l3, h0, h1, h2, h3; constexpr int b_ = VB * SHM_V + v_rd_off(d0, 0, 0); \
        TRRD(l0, b_); TRRD(h0, b_ + 2048); TRRD(l1, b_ + 4096); TRRD(h1, b_ + 6144); TRRD(l2, b_ + 8192); TRRD(h2, b_ + 10240); TRRD(l3, b_ + 12288); TRRD(h3, b_ + 14336); \
        asm volatile("s_waitcnt lgkmcnt(0)" ::: "memory"); SBAR();   \
        o[d0] = __builtin_amdgcn_mfma_f32_32x32x16_bf16(pa0, (bf16x8){l0[0], l0[1], l0[2], l0[3], h0[0], h0[1], h0[2], h0[3]}, o[d0], 0, 0, 0);   \
        o[d0] = __builtin_amdgcn_mfma_f32_32x32x16_bf16(pa1, (bf16x8){l1[0], l1[1], l1[2], l1[3], h1[0], h1[1], h1[2], h1[3]}, o[d0], 0, 0, 0);   \
        o[d0] = __builtin_amdgcn_mfma_f32_32x32x16_bf16(pa2, (bf16x8){l2[0], l2[1], l2[2], l2[3], h2[0], h2[1], h2[2], h2[3]}, o[d0], 0, 0, 0);   \
        o[d0] = __builtin_amdgcn_mfma_f32_32x32x16_bf16(pa3, (bf16x8){l3[0], l3[1], l3[2], l3[3], h3[0], h3[1], h3[2], h3[3]}, o[d0], 0, 0, 0); } while (0)
    PV_D0(0); PV_D0(1); PV_D0(2); PV_D0(3);
#undef PV_D0
#undef TRRD
}
struct BlockRef { const bf16_t* Q; const bf16_t* K; const bf16_t* V; bf16_t* O; const float* nck; int P0; int j_lo; };
struct Seam { bf16x8 qr[8]; bf16x8 st_v0, st_v1, st_k0, st_k1; };
#define ROWP(p, k0, rr) ((p) + (size_t)((k0) + (rr)) * PKV + sc)
#define VMW() asm volatile("s_waitcnt vmcnt(0)" ::: "memory")
#define VMWN(n) asm volatile("s_waitcnt vmcnt(%0)" :: "i"(n) : "memory")
#define SLOAD_H(BR, k0, CB) do { S.st_v0 = ld8(ROWP((BR).V, k0, sr)); S.st_v1 = ld8(ROWP((BR).V, k0, 32 + sr));              \
                             S.st_k0 = ld8(ROWP((BR).K, k0, sr)); S.st_k1 = ld8(ROWP((BR).K, k0, 32 + sr)); \
                             if (wid == 0) __builtin_amdgcn_global_load_lds((const unsigned*)((BR).nck + (k0) + lane), (LAS unsigned*)(cumL + (CB) * 64), 4, 0, 0); } while (0)
#define SWRITE_HK(bf) do { int t_ = tid; asm volatile("" : "+v"(t_)); const int kws_ = KSWZ(t_ >> 4, (t_ & 15) * 16); \
                           *(LAS bf16x8*)(K_lds + (bf) * SHM_K + kws_) = S.st_k0; *(LAS bf16x8*)(K_lds + (bf) * SHM_K + kws_ + 32 * 256) = S.st_k1; } while (0)
#define SWRITE_HV(bf) do { int t_ = tid; asm volatile("" : "+v"(t_)); const int vs0_ = v_st(t_ >> 4, (t_ & 15) * 8), vs1_ = v_st(32 + (t_ >> 4), (t_ & 15) * 8); \
                           *(LAS bf16x8*)(V_lds + (bf) * SHM_V + vs0_) = S.st_v0; *(LAS bf16x8*)(V_lds + (bf) * SHM_V + vs1_) = S.st_v1; } while (0)
__device__ __forceinline__ void fox_prime(const BlockRef& cur, LAS char* lds, Seam& S) {
    const int tid = threadIdx.x, wid = __builtin_amdgcn_readfirstlane(tid >> 6), lane = tid & 63, r32 = lane & 31, hi = lane >> 5;
    const int sr = tid >> 4, sc = (tid & 15) * 8; LAS char* K_lds = lds + 2 * SHM_V; LAS float* cumL = (LAS float*)(lds + OFF_CUM);
    const int kb0 = cur.j_lo * KVBLK;
#pragma unroll
    for (int d0 = 0; d0 < 8; ++d0) S.qr[d0] = ld8(cur.Q + (size_t)(wid * QBLK + r32) * PQ + d0 * 16 + hi * 8);
    SLOAD_H(cur, kb0, 0); VMW(); SWRITE_HK(0);
    __syncthreads();
}
__device__ __forceinline__ void fox_block(const BlockRef& cur, const BlockRef& nxt, int skv, LAS char* lds, Seam& S) {
    const int tid = threadIdx.x, wid = __builtin_amdgcn_readfirstlane(tid >> 6), lane = tid & 63, r32 = lane & 31, hi = lane >> 5;
    const int j_lo = cur.j_lo;
    int j_hi = (cur.P0 + QB - 1) / KVBLK + 1; if (j_hi > skv / KVBLK) j_hi = skv / KVBLK;
    const int NT = j_hi - j_lo;
    const int kbn = nxt.j_lo * KVBLK;
    const int qlo = cur.P0 + wid * QBLK;
    LAS char* V_lds = lds; LAS char* K_lds = lds + 2 * SHM_V; LAS float* cumL = (LAS float*)(lds + OFF_CUM);
    LAS float* ws = (LAS float*)(lds + OFF_WS) + wid * 64; LAS float* li_l = ws; LAS float* al_l = ws + 32;
    float m_reg = -1e30f, l_reg = 0; f32x16 o[4] = {};
    const int sr = tid >> 4, sc = (tid & 15) * 8;
    const int vb0 = (int)(unsigned)(uintptr_t)V_lds + v_rd_base(lane);
#define RESC(a) do { if (__any((a) < 1.f)) { if (hi == 0) al_l[r32] = (a); asm volatile("s_waitcnt lgkmcnt(0)" ::: "memory");              \
                     _Pragma("unroll") for (int d_ = 0; d_ < 4; ++d_) _Pragma("unroll") for (int r = 0; r < 16; ++r) o[d_][r] *= al_l[crow(r, hi)]; } } while (0)
#define KBASE(t) ((j_lo + (t)) * KVBLK)
#define MASKT(P0_, P1_, t) do { const int kb_ = KBASE(t); if (kb_ + KVBLK - 1 > qlo) { int lc_ = lane; asm volatile("" : "+v"(lc_)); mask_tile(P0_, P1_, qlo + (lc_ & 31) - 4 * (lc_ >> 5) - kb_, WINF); } } while (0)
    constexpr int NQL = 8;
#define SEAM_K0() do { VMWN(NQL); SWRITE_HK(0); SBAR(); } while (0)
    f32x16 pA0, pA1, pB0, pB1; float mnA, mnB, alA, alB; bf16x8 pa0, pa1, pa2, pa3;
    SWRITE_HV(0); SBAR();
    if (NT > 1) { SLOAD_H(cur, KBASE(1), 1); }
    SBAR(); qkt<0>(pA0, pA1, K_lds, cumL, r32, hi, S.qr);
    MASKT(pA0, pA1, 0); partialSM(pA0, pA1, m_reg, mnA, alA);
    if (NT > 1) { VMW(); SWRITE_HV(1); SWRITE_HK(1); }
    __syncthreads();
#define HALF_STEP(PX0, PX1, mnX, alX, PY0, PY1, alY, t, KB, VB, SB) do {                                                      \
        SBAR(); qkt<KB>(PX0, PX1, K_lds, cumL, r32, hi, S.qr);                                                                \
        finishSM(PY0, PY1, alY, l_reg, pa0, pa1, pa2, pa3); SBAR();                                                           \
        if ((t) + 1 < NT) { SLOAD_H(cur, KBASE((t) + 1), SB); SBAR(); }                                                           \
        pv_tile<VB>(o, vb0, pa0, pa1, pa2, pa3); MASKT(PX0, PX1, (t)); partialSM(PX0, PX1, m_reg, mnX, alX);                  \
        __syncthreads();                                                                                                      \
        if ((t) + 1 < NT) { VMW(); SWRITE_HV(SB); SWRITE_HK(SB); }                                       \
        RESC(alX); __syncthreads(); } while (0)
    for (int t = 1; t + 1 < NT; t += 2) {
        HALF_STEP(pB0, pB1, mnB, alB, pA0, pA1, alA, t, 1, 0, 0);
        HALF_STEP(pA0, pA1, mnA, alA, pB0, pB1, alB, t + 1, 0, 1, 1);
    }
    const bool even = (NT & 1) == 0;
    if (even) { SBAR(); qkt<1>(pB0, pB1, K_lds, cumL, r32, hi, S.qr); SBAR(); }
    SLOAD_H(nxt, kbn, 0); SBAR();
    { int lc_ = lane; asm volatile("" : "+v"(lc_)); const bf16_t* qp_ = nxt.Q + (size_t)(wid * QBLK + (lc_ & 31)) * PQ + (lc_ >> 5) * 8;
#pragma unroll
    for (int d0 = 0; d0 < 8; ++d0) S.qr[d0] = ld8(qp_ + d0 * 16); }
    SBAR();
    finishSM(pA0, pA1, alA, l_reg, pa0, pa1, pa2, pa3); SBAR();
    pv_tile<0>(o, vb0, pa0, pa1, pa2, pa3);
    if (even) { MASKT(pB0, pB1, NT - 1); partialSM(pB0, pB1, m_reg, mnB, alB); __syncthreads(); RESC(alB);
        finishSM(pB0, pB1, alB, l_reg, pa0, pa1, pa2, pa3); SBAR(); pv_tile<1>(o, vb0, pa0, pa1, pa2, pa3); }
    SBAR(); SEAM_K0();
    if (hi == 0) li_l[r32] = l_reg; asm volatile("s_waitcnt lgkmcnt(0)" ::: "memory");
    float rli[16];
#pragma unroll
    for (int r = 0; r < 16; ++r) rli[r] = __builtin_amdgcn_rcpf(li_l[crow(r, hi)]);
    { int lc_ = lane; asm volatile("" : "+v"(lc_)); const int r32c = lc_ & 31, hic = lc_ >> 5;
    bf16_t* Ow = cur.O + (size_t)(wid * QBLK + 4 * hic) * PO + r32c;
#pragma unroll
    for (int r = 0; r < 16; ++r) { const int orow = (r & 3) + 8 * (r >> 2);
#pragma unroll
        for (int d0 = 0; d0 < 4; ++d0) { const float v = o[d0][r] * rli[r];
            const float vn = __shfl_xor(v, 1);
            if ((r32c & 1) == 0) *(unsigned*)(Ow + (size_t)orow * PO + d0 * 32) = cvtpk(v, vn); } } }
    __syncthreads();
#undef RESC
#undef KBASE
#undef MASKT
#undef SEAM_K0
#undef HALF_STEP
}
#undef ROWP
#undef VMW
#undef VMWN
#undef SLOAD_H
#undef SWRITE_HK
#undef SWRITE_HV
#undef SBAR
#undef KSWZ
}

typedef GAS unsigned gu32;
#define RLX_AGENT __ATOMIC_RELAXED, __HIP_MEMORY_SCOPE_AGENT
#define XB_TMO      128
#define XB_XCNT(j)  (256  + 64 * (j))
#define XB_XSUB(j)  (1280 + 64 * (j))
#define XB_XGEN(j)  (2304 + 64 * (j))
#define XB_TOP      3328
#define XB_TOPGEN   3392
#define XCD_BAR_WORDS 3456
#define XB_SPIN_CAP (1u << 20)
__device__ __forceinline__ unsigned xb_ld(unsigned* p)              { return __hip_atomic_load(p, __ATOMIC_RELAXED, __HIP_MEMORY_SCOPE_AGENT); }
__device__ __forceinline__ unsigned xb_add(unsigned* p, unsigned v) { return __hip_atomic_fetch_add(p, v, __ATOMIC_RELAXED, __HIP_MEMORY_SCOPE_AGENT); }
__device__ __forceinline__ unsigned xb_xcc_id() { return (unsigned)__builtin_amdgcn_s_getreg((3 << 11) | 20) & 0xFu; }
#define XB_SPIN(cond, bar) do { unsigned _sp = 0; while (cond) { __builtin_amdgcn_s_sleep(1); \
    if ((++_sp & 255u) == 0u) { if (xb_ld(&(bar)[XB_TMO])) break; if (_sp > XB_SPIN_CAP) { atomicAdd(&(bar)[XB_TMO], 1u); break; } } } } while (0)
struct XcdBarrier { unsigned* bar; unsigned x; volatile LAS unsigned* st; };
__device__ __forceinline__ XcdBarrier xcd_barrier_post(unsigned* bar, volatile LAS unsigned* st) {
    XcdBarrier b; b.bar = bar; b.x = xb_xcc_id(); b.st = st;
    if (threadIdx.x == 0) (void)xb_add(&bar[XB_XCNT(b.x)], 1u);
    return b;
}
__device__ __forceinline__ void xcd_barrier_complete(unsigned* bar, unsigned x, unsigned& nloc, unsigned& nx) {
    const unsigned G = gridDim.x * gridDim.y * gridDim.z;
    unsigned sum, cnt, mine, sp = 0u;
    for (;;) {
        sum = 0u; cnt = 0u; mine = 0u;
#pragma unroll
        for (unsigned j = 0; j < 16; ++j) { const unsigned c = xb_ld(&bar[XB_XCNT(j)]); sum += c; cnt += (c > 0u) ? 1u : 0u; mine = (j == x) ? c : mine; }
        if (sum == G) break;
        __builtin_amdgcn_s_sleep(1);
        if ((++sp & 255u) == 0u) { if (xb_ld(&bar[XB_TMO])) break; if (sp > XB_SPIN_CAP) { atomicAdd(&bar[XB_TMO], 1u); break; } }
    }
    nloc = mine > 0u ? mine : 1u; nx = cnt > 0u ? cnt : 1u;
}
__device__ __forceinline__ void xcd_barrier(const XcdBarrier& b) {
    asm volatile("s_waitcnt vmcnt(0)" ::: "memory");
    __syncthreads();
    if (threadIdx.x == 0) {
        unsigned* bar = b.bar;
        __builtin_amdgcn_s_waitcnt(0);
        unsigned nloc = b.st[0], nx = b.st[1];
        if (nloc == 0u) { xcd_barrier_complete(bar, b.x, nloc, nx); b.st[0] = nloc; b.st[1] = nx; }
        const unsigned old = xb_add(&bar[XB_XSUB(b.x)], 1u);
        const unsigned gen = old / nloc;
        if (old + 1u == (gen + 1u) * nloc) {
            __builtin_amdgcn_fence(__ATOMIC_RELEASE, "agent");
            asm volatile("s_waitcnt vmcnt(0)" ::: "memory");
            const unsigned og = xb_add(&bar[XB_TOP], 1u);
            const unsigned tg = og / nx;
            if (og + 1u == (tg + 1u) * nx) xb_add(&bar[XB_TOPGEN], 1u);
            else XB_SPIN(xb_ld(&bar[XB_TOPGEN]) == tg, bar);
            __builtin_amdgcn_fence(__ATOMIC_ACQUIRE, "agent");
            xb_add(&bar[XB_XGEN(b.x)], 1u);
            asm volatile("s_waitcnt vmcnt(0)" ::: "memory");
        } else {
            XB_SPIN(xb_ld(&bar[XB_XGEN(b.x)]) == gen, bar);
            __builtin_amdgcn_fence(__ATOMIC_ACQUIRE, "agent");
            asm volatile("s_waitcnt vmcnt(0)" ::: "memory");
        }
    }
    __syncthreads();
}

constexpr int NWAVES = 8;
constexpr int N_PHASES = 12;
constexpr int N_LAUNCHES = MK_N_LAUNCHES;
static_assert(N_LAUNCHES == 1 || N_LAUNCHES == N_PHASES, "MK_N_LAUNCHES is 1 (one dispatch) or 12 (one dispatch per phase)");
struct Args { const float* in[29]; float* out; unsigned char* ws; int ph_lo, ph_hi; };
struct Frame {
    LAS unsigned char* lds; volatile LAS unsigned* MISC; gu32* ctl; unsigned char* ws;
    int tid, lane, wave, vcu, G;
};

struct TileRef { const float* src; bf16_t* dst; int ld_src, ld_dst; };
__device__ __forceinline__ void p0_tile_load(const TileRef& t, f32x4 (&v)[16], int lane) {
    const int c4 = lane & 7, r8 = lane >> 3;
#pragma unroll
    for (int it = 0; it < 16; ++it) v[it] = *(const f32x4*)(t.src + (size_t)(it * 8 + r8) * t.ld_src + 4 * c4);
}
__device__ __forceinline__ void p0_tile_store(const TileRef& t, const f32x4 (&v)[16], LAS float* scr, int lane) {
    const int c4 = lane & 7, r8 = lane >> 3;
#pragma unroll
    for (int it = 0; it < 16; ++it) { const int r = it * 8 + r8;
#pragma unroll
        for (int e = 0; e < 4; ++e) scr[(4 * c4 + e) * 132 + r] = v[it][e]; }
    LDS_WAIT(); asm volatile("" ::: "memory");
    const int kc = lane & 15, n4 = lane >> 4;
#pragma unroll
    for (int it = 0; it < 8; ++it) { const int n = it * 4 + n4;
        const f32x4 a = *(const LAS f32x4*)(scr + n * 132 + 8 * kc), b = *(const LAS f32x4*)(scr + n * 132 + 8 * kc + 4);
        u32x4 w; w.x = cvt_pk_bf16(a[0], a[1]); w.y = cvt_pk_bf16(a[2], a[3]); w.z = cvt_pk_bf16(b[0], b[1]); w.w = cvt_pk_bf16(b[2], b[3]);
        *(u32x4*)(t.dst + (size_t)n * t.ld_dst + 8 * kc) = w; }
    LDS_WAIT(); asm volatile("" ::: "memory");
}
template <int MODE>
__device__ __forceinline__ TileRef p0_mat_ref(const float* src, int ldsrc, int K, int N, bf16_t* dst, int which, int it) {
    const int nblk = N / 32, kb = it / nblk, nb = it - kb * nblk, k0 = 128 * kb, n0 = 32 * nb;
    const int drow = MODE == 0 ? n0 : ((n0 >> 7) * 256 + which * 128 + (n0 & 127));
    TileRef t; t.src = src + (size_t)k0 * ldsrc + n0; t.ld_src = ldsrc; t.dst = dst + (size_t)drow * K + k0; t.ld_dst = K; return t;
}
__device__ __forceinline__ void p0_prologue(Frame& F, const __attribute__((address_space(4))) Args& a) {
    unsigned char* ws = F.ws;
    const int gw = F.vcu * NWAVES + F.wave, NGW = F.G * NWAVES;
    {
        LAS float* scr = (LAS float*)(F.lds + F.wave * 16896);
        constexpr int I_EXP = 256;
        constexpr int N_EG = NEXP * I_EXP, N_EU = N_EG, N_ED = N_EG;
        constexpr int I_IN = 16 * 128, I_OUT = 16 * 64, I_GLU = 8 * 32, I_R = 16 * 2, I_SG = 16 * 16, I_SU = 16 * 16, I_SD = 4 * 64;
        constexpr int NITEMS = N_EG + N_EU + N_ED + I_IN + I_OUT + I_GLU + I_R + I_SG + I_SU + I_SD;
        bf16_t* Wegu = (bf16_t*)(ws + WS_WEGU); bf16_t* Wed = (bf16_t*)(ws + WS_WED);
#define P0_REF(T, it_) do { int r = (it_); \
            if (r < N_EG) { const int e = r / I_EXP; T = p0_mat_ref<1>(a.in[21] + (size_t)e * 2048 * 512, 512, 2048, 512, Wegu + (size_t)e * 1024 * 2048, 0, r % I_EXP); break; } r -= N_EG; \
            if (r < N_EU) { const int e = r / I_EXP; T = p0_mat_ref<1>(a.in[22] + (size_t)e * 2048 * 512, 512, 2048, 512, Wegu + (size_t)e * 1024 * 2048, 1, r % I_EXP); break; } r -= N_EU; \
            if (r < N_ED) { const int e = r / I_EXP; T = p0_mat_ref<0>(a.in[23] + (size_t)e * 512 * 2048, 2048, 512, 2048, Wed + (size_t)e * 2048 * 512, 0, r % I_EXP); break; } r -= N_ED; \
            if (r < I_IN) { T = p0_mat_ref<0>(a.in[4], 4104, 2048, 4096, (bf16_t*)(ws + WS_WIN), 0, r); break; } r -= I_IN; \
            if (r < I_OUT) { T = p0_mat_ref<0>(a.in[16], 2048, 2048, 2048, (bf16_t*)(ws + WS_WOUT), 0, r); break; } r -= I_OUT; \
            if (r < I_GLU) { T = p0_mat_ref<0>(a.in[14], 1024, 1024, 1024, (bf16_t*)(ws + WS_WGLU), 0, r); break; } r -= I_GLU; \
            if (r < I_R) { T = p0_mat_ref<0>(a.in[19], 64, 2048, 64, (bf16_t*)(ws + WS_WR), 0, r); break; } r -= I_R; \
            if (r < I_SG) { T = p0_mat_ref<1>(a.in[24], 512, 2048, 512, (bf16_t*)(ws + WS_WSGU), 0, r); break; } r -= I_SG; \
            if (r < I_SU) { T = p0_mat_ref<1>(a.in[25], 512, 2048, 512, (bf16_t*)(ws + WS_WSGU), 1, r); break; } r -= I_SU; \
            T = p0_mat_ref<0>(a.in[26], 2048, 512, 2048, (bf16_t*)(ws + WS_WSD), 0, r); } while (0)
        int it = gw;
        if (it < NITEMS) {
            TileRef tc, tn; f32x4 vc[16], vn[16];
            P0_REF(tc, it); p0_tile_load(tc, vc, F.lane);
            for (;;) {
                const int itn = it + NGW; const bool more = itn < NITEMS;
                if (more) { P0_REF(tn, itn); p0_tile_load(tn, vn, F.lane); }
                p0_tile_store(tc, vc, scr, F.lane);
                if (!more) break;
#pragma unroll
                for (int i = 0; i < 16; ++i) vc[i] = vn[i];
                tc = tn; it = itn;
            }
        }
#undef P0_REF
    }
    __syncthreads();
    if (F.vcu < NGRP) {
        const int g = F.vcu, t = F.tid;
        LAS float* apr = (LAS float*)F.lds;
        LAS float* api = apr + 64 * 33;
        LAS float* bbr = api + 64 * 33;
        LAS float* bbi = bbr + 1024;
        LAS float* cr = bbi + 1024;
        LAS float* ci = cr + 1024;
        LAS float* kg = ci + 1024;
        LAS float* dsk = kg + 8192;
        const float* a_re = a.in[6]; const float* a_im = a.in[7]; const float* log_dt = a.in[8];
        const float* b_re = a.in[9]; const float* b_im = a.in[10]; const float* c_re = a.in[11]; const float* c_im = a.in[12]; const float* dsk_g = a.in[13];
        if (t < 64) { const int p = t; const float ar = a_re[g * 64 + p], ai = a_im[g * 64 + p], dt = expf(log_dt[g]);
            for (int tau = 0; tau <= 32; ++tau) { const float m = expf((float)tau * dt * ar); float s, c; sincosf((float)tau * dt * ai, &s, &c); apr[p * 33 + tau] = m * c; api[p * 33 + tau] = m * s; }
            const float abr = apr[p * 33 + 1] - 1.f, abi = api[p * 33 + 1], den = ar * ar + ai * ai;
            const float cre = (abr * ar + abi * ai) / den, cim = (abi * ar - abr * ai) / den;
            for (int h = 0; h < 16; ++h) { const float br = b_re[(g * 64 + p) * 16 + h], bi = b_im[(g * 64 + p) * 16 + h]; bbr[p * 16 + h] = cre * br - cim * bi; bbi[p * 16 + h] = cre * bi + cim * br; } }
        for (int idx = t; idx < 1024; idx += 512) { cr[idx] = c_re[g * 1024 + idx]; ci[idx] = c_im[g * 1024 + idx]; }
        if (t < 16) dsk[t] = dsk_g[g * 16 + t];
        __syncthreads();
        for (int idx = t; idx < 8192; idx += 512) { const int tau = idx >> 8, hp = (idx >> 4) & 15, h = idx & 15; float acc = 0.f;
            for (int p = 0; p < 64; ++p) { const float c_r = cr[hp * 64 + p], c_i = ci[hp * 64 + p], pr = apr[p * 33 + tau], pi = api[p * 33 + tau];
                const float gr = c_r * pr - c_i * pi, gi = c_r * pi + c_i * pr; acc += gr * bbr[p * 16 + h] - gi * bbi[p * 16 + h]; }
            if (tau == 0 && hp == h) acc += dsk[h];
            kg[idx] = acc; }
        __syncthreads();
        bf16_t* OPY = (bf16_t*)(ws + WS_OPY) + (size_t)g * 512 * UGK;
        for (int it = t; it < 512 * 80; it += 512) { const int n = it / 80, ch = it - n * 80, tt = n >> 4, hp = n & 15; float v[8];
            if (ch < 64) { const int j = ch >> 1, h0 = (ch & 1) * 8;
#pragma unroll
                for (int e = 0; e < 8; ++e) v[e] = (tt >= j) ? kg[(tt - j) * 256 + hp * 16 + h0 + e] : 0.f; }
            else { const int q = ch - 64;
#pragma unroll
                for (int e2 = 0; e2 < 4; ++e2) { const int p = q * 4 + e2; const float c_r = cr[hp * 64 + p], c_i = ci[hp * 64 + p], pr = apr[p * 33 + tt + 1], pi = api[p * 33 + tt + 1];
                    v[2 * e2] = c_r * pr - c_i * pi; v[2 * e2 + 1] = -(c_r * pi + c_i * pr); } }
            u32x4 w; w.x = cvt_pk_bf16(v[0], v[1]); w.y = cvt_pk_bf16(v[2], v[3]); w.z = cvt_pk_bf16(v[4], v[5]); w.w = cvt_pk_bf16(v[6], v[7]);
            *(u32x4*)(OPY + (size_t)n * UGK + ch * 8) = w; }
        bf16_t* OPE = (bf16_t*)(ws + WS_OPE) + (size_t)g * 256 * 512;
        for (int it = t; it < 256 * 64; it += 512) { const int n = it >> 6, ch = it & 63; float v[8];
            if (n < 128) { const int p = n >> 1, ri = n & 1, j = ch >> 1, h0 = (ch & 1) * 8; const float pr = apr[p * 33 + 31 - j], pi = api[p * 33 + 31 - j];
#pragma unroll
                for (int e = 0; e < 8; ++e) { const float br = bbr[p * 16 + h0 + e], bi = bbi[p * 16 + h0 + e]; v[e] = ri == 0 ? (pr * br - pi * bi) : (pr * bi + pi * br); } }
            else {
#pragma unroll
                for (int e = 0; e < 8; ++e) v[e] = 0.f; }
            u32x4 w; w.x = cvt_pk_bf16(v[0], v[1]); w.y = cvt_pk_bf16(v[2], v[3]); w.z = cvt_pk_bf16(v[4], v[5]); w.w = cvt_pk_bf16(v[6], v[7]);
            *(u32x4*)(OPE + (size_t)n * 512 + ch * 8) = w; }
    }
    __syncthreads();
    {
        const int gt = F.vcu * 512 + F.tid, NGT = F.G * 512; const u32x4 z4 = {0u, 0u, 0u, 0u};
        for (int i = gt; i < 2 * 2 * 48 * 128; i += NGT) { const int ch = i & 127, r = (i >> 7) % 48, b = ((i >> 7) / 48) & 1, kv = (i >> 7) / 96;
            bf16_t* base = (bf16_t*)(ws + (kv ? WS_V : WS_K)); *(u32x4*)(base + ((size_t)b * KVR + r) * 1024 + ch * 8) = z4; }
        for (int i = gt; i < 128 * 32; i += NGT) { const int ch = i & 31, gb = i >> 5;
            *(u32x4*)((bf16_t*)(ws + WS_UG) + ((size_t)gb * NCHK + 1) * UGK + ch * 8) = z4; }
        for (int i = gt; i < 16 * 48; i += NGT) { const int r = i % 48, bh = i / 48; ((float*)(ws + WS_LOGF))[(size_t)bh * KVR + r] = 0.f; }
    }
    {
        LAS float* wf = (LAS float*)F.lds;
        for (int i = F.tid; i < 8 * 2048; i += 512) { const int h = i & 7, k = i >> 3; wf[h * 2048 + k] = a.in[4][(size_t)k * 4104 + 4096 + h]; }
        __syncthreads();
        const float* x = a.in[0]; const float* meta = a.in[1]; const float* lg = a.in[2]; const float* lb = a.in[3]; const float* bfg = a.in[5];
        bf16_t* XN = (bf16_t*)(ws + WS_XN); float* logf_ = (float*)(ws + WS_LOGF);
        for (int row = gw; row < MX + NMETA; row += NGW) {
            const float* src = row < MX ? x + (size_t)row * DM : meta + (size_t)(row - MX) * DM;
            f32x4 v[8]; float s = 0.f;
#pragma unroll
            for (int j = 0; j < 8; ++j) { v[j] = ((const f32x4*)src)[j * 64 + F.lane]; s += (v[j][0] + v[j][1]) + (v[j][2] + v[j][3]); }
            const float mean = wave_sum(s) * (1.f / DM); float s2 = 0.f;
#pragma unroll
            for (int j = 0; j < 8; ++j) { v[j] = v[j] - mean; s2 += (v[j][0] * v[j][0] + v[j][1] * v[j][1]) + (v[j][2] * v[j][2] + v[j][3] * v[j][3]); }
            const float rstd = 1.f / sqrtf(wave_sum(s2) * (1.f / DM) + LN_EPS);
            float fl[8];
#pragma unroll
            for (int h = 0; h < 8; ++h) fl[h] = 0.f;
#pragma unroll
            for (int j = 0; j < 8; ++j) { const f32x4 g4 = ((const f32x4*)lg)[j * 64 + F.lane], b4 = ((const f32x4*)lb)[j * 64 + F.lane];
                v[j] = v[j] * rstd * g4 + b4;
                *(u32x2*)(XN + (size_t)row * DM + j * 256 + F.lane * 4) = (u32x2){cvt_pk_bf16(v[j][0], v[j][1]), cvt_pk_bf16(v[j][2], v[j][3])};
#pragma unroll
                for (int h = 0; h < 8; ++h) { const f32x4 w4 = *(const LAS f32x4*)(wf + h * 2048 + j * 256 + F.lane * 4); fl[h] += (v[j][0] * w4[0] + v[j][1] * w4[1]) + (v[j][2] * w4[2] + v[j][3] * w4[3]); } }
#pragma unroll
            for (int h = 0; h < 8; ++h) fl[h] = wave_sum(fl[h]);
            if (F.lane < 8) { const int h = F.lane;
                float val = h == 0 ? fl[0] : h == 1 ? fl[1] : h == 2 ? fl[2] : h == 3 ? fl[3] : h == 4 ? fl[4] : h == 5 ? fl[5] : h == 6 ? fl[6] : fl[7];
                val += bfg[h];
                const float lf = fminf(val, 0.f) - log1pf(expf(-fabsf(val)));
                if (row < MX) { const int b = row >> 13, sx = row & (SEQ - 1); logf_[(size_t)(b * 8 + h) * KVR + 64 + sx] = lf; }
                else { const int i = row - MX; logf_[(size_t)(0 * 8 + h) * KVR + 48 + i] = lf; logf_[(size_t)(1 * 8 + h) * KVR + 48 + i] = lf; } }
        }
    }
}

__device__ __forceinline__ void p1_cumsum(Frame& F, int seq) {
    const float* lf = (const float*)(F.ws + WS_LOGF) + (size_t)seq * KVR; float* cum = (float*)(F.ws + WS_CUM) + (size_t)seq * KVR;
    LAS float* part = (LAS float*)F.lds;
    constexpr int PER = 17; const int i0 = F.tid * PER; float s = 0.f;
    for (int k = 0; k < PER; ++k) { const int i = i0 + k; if (i < KVR) s += lf[i]; }
    part[F.tid] = s; __syncthreads();
    float pre = 0.f; for (int j = 0; j < F.tid; ++j) pre += part[j];
    for (int k = 0; k < PER; ++k) { const int i = i0 + k; if (i < KVR) { pre += lf[i]; cum[i] = (i < 48) ? -__builtin_inff() : -pre * LOG2E; } }
    __syncthreads();
}

__device__ __forceinline__ void moe_tables(Frame& F) {
    LAS int* tb = (LAS int*)(F.lds + TB_OFF);
    if (F.tid < NEXP) tb[130 + F.tid] = (int)__hip_atomic_load(F.ctl + CW_CNT + 64 * F.tid, RLX_AGENT);
    __syncthreads();
    if (F.tid == 0) { int tp = 0, cp = 0; for (int e = 0; e < NEXP; ++e) { tb[e] = tp; tb[65 + e] = cp; const int c = tb[130 + e]; tp += (c + 255) >> 8; cp += c; } tb[64] = tp; tb[129] = cp; }
    __syncthreads();
}

template <unsigned MASK>
__global__ void __launch_bounds__(NWAVES * 64, 2) hymba_fwd(Args args_) {
    extern __shared__ __attribute__((aligned(16))) unsigned char lds[];
    (void)args_;
    const __attribute__((address_space(4))) Args& args = *(const __attribute__((address_space(4))) Args*)__builtin_amdgcn_kernarg_segment_ptr();
    Frame F;
    F.lds = (LAS unsigned char*)lds;
    F.MISC = (volatile LAS unsigned*)(F.lds + MISC_OFF);
    F.tid = threadIdx.x; F.lane = F.tid & 63; F.wave = __builtin_amdgcn_readfirstlane(F.tid >> 6);
    F.G = gridDim.x; { const int bx = blockIdx.x; F.vcu = (F.G % 8 == 0) ? (bx % 8) * (F.G / 8) + bx / 8 : bx; }
    unsigned char* ws = args.ws; F.ws = ws;
    F.ctl = (gu32*)(ws + WS_CTL);
    for (int u = F.tid; u < (LDS_BYTES - LDSCTL_OFF) / 4; u += NWAVES * 64) ((LAS unsigned*)(F.lds + LDSCTL_OFF))[u] = 0u;
    __syncthreads();
    XcdBarrier bar; bar.bar = (unsigned*)(F.ctl + CW_BAR); bar.x = 0; bar.st = nullptr;
    if (N_LAUNCHES == 1) bar = xcd_barrier_post((unsigned*)(F.ctl + CW_BAR), F.MISC + 8);
#define GRID_BAR() do { if (N_LAUNCHES == 1) xcd_barrier(bar); } while (0)
    const int lo = args.ph_lo, hi = args.ph_hi;
#define IN(k) (((MASK >> (k)) & 1u) && lo <= (k) && (k) < hi)
#define BOTH(k) (IN(k) && IN((k) + 1))
#ifndef REP_PH
#define REP_PH -1
#endif
#define REPS(k) for (int rep_ = 0; rep_ < ((REP_PH) == (k) ? 2 : 1); ++rep_)
    const int gw = F.vcu * NWAVES + F.wave, NGW = F.G * NWAVES;
    const int bx = (int)blockIdx.x;

    if (IN(0)) { REPS(0) { p0_prologue(F, args); __syncthreads(); } if (BOTH(0)) GRID_BAR(); }

    if (IN(1)) {
        if (F.vcu < 16) p1_cumsum(F, F.vcu);
        pg8::DenseOrder S; S.init(ws + WS_XN, ws + WS_WIN, DM, DM, MIN_ROWS, 4096, F.G, bx);
        pg8::EpiInProj E{(bf16_t*)(ws + WS_UG), (bf16_t*)(ws + WS_Q), (bf16_t*)(ws + WS_K), (bf16_t*)(ws + WS_V)};
        REPS(1) pg8::gemm_phase<pg8::EpiInProj, pg8::DenseOrder, true>(F.lds, pg8::GemmK{DM, DM, DM}, S, E);
        if (BOTH(1)) GRID_BAR();
    }

    if (IN(2)) {
        pg8::EOrder S{(const char*)(ws + WS_UG), (const char*)(ws + WS_OPE), F.G, bx};
        pg8::EpiE E{(float*)(ws + WS_E)};
        REPS(2) pg8::gemm_phase<pg8::EpiE, pg8::EOrder, true>(F.lds, pg8::GemmK{512, UGK, 512}, S, E);
        if (BOTH(2)) GRID_BAR();
    }

    if (IN(3)) {
        for (int sq = gw; sq < 128; sq += NGW) {
            const int g = sq >> 1, p = F.lane;
            const float dt = expf(args.in[8][g]), ar = args.in[6][g * 64 + p], ai = args.in[7][g * 64 + p];
            const float mag = expf(32.f * dt * ar); float sn, cs; sincosf(32.f * dt * ai, &sn, &cs);
            const float a_r = mag * cs, a_i = mag * sn;
            const float* Eb = (const float*)(ws + WS_E) + (size_t)sq * 256 * 128 + 2 * p;
            bf16_t* Ub = (bf16_t*)(ws + WS_UG) + (size_t)sq * NCHK * UGK + 512 + 2 * p;
            float sr = 0.f, si = 0.f;
#pragma unroll 8
            for (int r = 0; r < 256; ++r) { const f32x2 e = *(const f32x2*)(Eb + (size_t)r * 128);
                const float nr = a_r * sr - a_i * si + e[0], ni = a_r * si + a_i * sr + e[1]; sr = nr; si = ni;
                *(unsigned*)(Ub + (size_t)(r + 2) * UGK) = cvt_pk_bf16(sr, si); }
        }
        if (gw >= 128) {
            const bf16_t* Qb = (const bf16_t*)(ws + WS_Q); const bf16_t* Kb = (const bf16_t*)(ws + WS_K);
            for (int it = gw - 128; it < 1024 + 1032; it += NGW - 128) {
                const bool isq = it < 1024; const int row0 = (isq ? it : it - 1024) * 16;
                const bf16_t* base = (isq ? Qb : Kb) + (size_t)row0 * 1024 + F.lane * 8;
                float mx0 = 0.f, mx1 = 0.f;
#pragma unroll 4
                for (int r = 0; r < 16; ++r) {
#pragma unroll
                    for (int half = 0; half < 2; ++half) { const u32x4 w = *(const u32x4*)(base + (size_t)r * 1024 + half * 512);
                        float ss = bf_lo(w.x) * bf_lo(w.x) + bf_hi(w.x) * bf_hi(w.x) + bf_lo(w.y) * bf_lo(w.y) + bf_hi(w.y) * bf_hi(w.y) + bf_lo(w.z) * bf_lo(w.z) + bf_hi(w.z) * bf_hi(w.z) + bf_lo(w.w) * bf_lo(w.w) + bf_hi(w.w) * bf_hi(w.w);
                        ss += __shfl_xor(ss, 1); ss += __shfl_xor(ss, 2); ss += __shfl_xor(ss, 4); ss += __shfl_xor(ss, 8);
                        if (half == 0) mx0 = fmaxf(mx0, ss); else mx1 = fmaxf(mx1, ss); } }
                if ((F.lane & 15) == 0) { const int g4 = F.lane >> 4;
                    if (isq) { const int b = row0 >> 13, qb = (row0 & (SEQ - 1)) >> 8;
                        __hip_atomic_fetch_max(F.ctl + CW_QMAX + ((b * 8 + g4) * 32 + qb), __float_as_uint(mx0), RLX_AGENT);
                        __hip_atomic_fetch_max(F.ctl + CW_QMAX + ((b * 8 + 4 + g4) * 32 + qb), __float_as_uint(mx1), RLX_AGENT); }
                    else { const int b = row0 / KVR;
                        __hip_atomic_fetch_max(F.ctl + CW_KMAX + (b * 8 + g4), __float_as_uint(mx0), RLX_AGENT);
                        __hip_atomic_fetch_max(F.ctl + CW_KMAX + (b * 8 + 4 + g4), __float_as_uint(mx1), RLX_AGENT); } }
            }
        }
        if (BOTH(3)) GRID_BAR();
    }

    if (IN(4)) {
        pg8::YOrder S{(const char*)(ws + WS_UG), (const char*)(ws + WS_OPY), F.G, bx};
        pg8::EpiY E{(bf16_t*)(ws + WS_YB)};
        REPS(4) pg8::gemm_phase<pg8::EpiY, pg8::YOrder, true>(F.lds, pg8::GemmK{UGK, UGK, UGK}, S, E);
        if (BOTH(4)) GRID_BAR();
    }

    if (IN(5)) {
        pg8::DenseOrder S; S.init(ws + WS_YB, ws + WS_WGLU, 1024, 1024, MX, 1024, F.G, bx);
        pg8::EpiGlu E{(const bf16_t*)(ws + WS_YB), args.in[15], (bf16_t*)(ws + WS_YC)};
        REPS(5) pg8::gemm_phase<pg8::EpiGlu, pg8::DenseOrder, true>(F.lds, pg8::GemmK{1024, 1024, 1024}, S, E);
    }

    if (IN(6)) {
        const bf16_t* Qb = (const bf16_t*)(ws + WS_Q); const bf16_t* Kb = (const bf16_t*)(ws + WS_K); const bf16_t* Vb = (const bf16_t*)(ws + WS_V);
        bf16_t* YC = (bf16_t*)(ws + WS_YC); const float* nck = (const float*)(ws + WS_CUM);
        LAS char* al = (LAS char*)F.lds;
        LAS unsigned* skey = (LAS unsigned*)(F.lds + 71680);
        att::Seam S;
#define MKREF(R, key_) do { const int id_ = (int)((key_) & 511u), bh_ = id_ >> 5, qb_ = id_ & 31, b_ = bh_ >> 3, h_ = bh_ & 7; (R).Q = Qb + ((size_t)b_ * SEQ + (size_t)qb_ * 256) * 1024 + h_ * 128; \
        (R).K = Kb + (size_t)b_ * KVR * 1024 + h_ * 128; (R).V = Vb + (size_t)b_ * KVR * 1024 + h_ * 128; (R).O = YC + ((size_t)b_ * SEQ + (size_t)qb_ * 256) * 2048 + 1024 + h_ * 128; \
        (R).nck = nck + (size_t)bh_ * KVR; (R).P0 = 64 + qb_ * 256; (R).j_lo = (int)(((key_) >> 10) & 1023u); } while (0)
        REPS(6) {
        { const int id = F.tid, bh = id >> 5, qb = id & 31, P0 = 64 + qb * 256; const float* nk = nck + (size_t)bh * KVR;
          const float q2 = __uint_as_float(__hip_atomic_load(F.ctl + CW_QMAX + id, RLX_AGENT)), k2 = __uint_as_float(__hip_atomic_load(F.ctl + CW_KMAX + bh, RLX_AGENT));
          const float thr = nk[P0] - T_SKIP - 2.f * sqrtf(q2 * k2) * 1.001f;
          int lo_ = 0, hi_ = 4 * qb + 1;
          while (lo_ < hi_) { const int mid = (lo_ + hi_) >> 1; if (nk[64 * mid + 63] < thr) lo_ = mid + 1; else hi_ = mid; }
          skey[id] = ((unsigned)(4 * qb + 5 - lo_) << 20) | ((unsigned)lo_ << 10) | (unsigned)id; }
        for (int k = 2; k <= 512; k <<= 1)
            for (int j = k >> 1; j > 0; j >>= 1) { __syncthreads(); const int ixj = F.tid ^ j;
                if (ixj > F.tid) { const unsigned a = skey[F.tid], b = skey[ixj]; const bool up = (F.tid & k) == 0;
                    if (up ? (a < b) : (a > b)) { skey[F.tid] = b; skey[ixj] = a; } } }
        __syncthreads();
        int pi = F.vcu;
        if (pi < 256) {
            int pass = 0; att::BlockRef cur, nxt;
            { const unsigned key = skey[511 - pi]; MKREF(cur, key); }
            att::fox_prime(cur, al, S);
            for (;;) {
                const bool more_pass = pass == 0, more_item = pi + F.G < 256, last = !more_pass && !more_item;
                int pin = pi, passn = pass + 1;
                if (!more_pass) { passn = 0; pin = more_item ? pi + F.G : pi; }
                if (last) nxt = cur; else { const unsigned key = skey[passn ? pin : 511 - pin]; MKREF(nxt, key); }
                att::fox_block(cur, nxt, KVR, al, S);
                if (last) break;
                cur = nxt; pass = passn; pi = pin;
            }
        }
        __syncthreads();
        }
#undef MKREF
        if (BOTH(6)) GRID_BAR();
    }

    if (IN(7)) {
        pg8::DenseOrder S; S.init(ws + WS_YC, ws + WS_WOUT, 2048, 2048, MX, 2048, F.G, bx);
        pg8::EpiOut E{(const bf16_t*)(ws + WS_XN), (float*)(ws + WS_Z), (float*)(ws + WS_ST)};
        REPS(7) pg8::gemm_phase<pg8::EpiOut, pg8::DenseOrder, true>(F.lds, pg8::GemmK{2048, 2048, 2048}, S, E);
        if (BOTH(7)) GRID_BAR();
    }

    if (IN(8)) {
        const float* Z = (const float*)(ws + WS_Z); const float* ST = (const float*)(ws + WS_ST); bf16_t* H1 = (bf16_t*)(ws + WS_XN);
        const bf16_t* WR = (const bf16_t*)(ws + WS_WR); const float* lg_ = args.in[17]; const float* lb_ = args.in[18]; const float* rbias = args.in[20];
        int* IDX = (int*)(ws + WS_IDX); float* GWt = (float*)(ws + WS_GW); int* RK = (int*)(ws + WS_RK); int* TOK = (int*)(ws + WS_TOK);
        LAS float* lgs = (LAS float*)(F.lds + F.wave * 4352);
        const int r16 = F.lane & 15, kq = F.lane >> 4;
        const float my_bias = rbias[F.lane];
        for (int rb = gw; rb < MX / 16; rb += NGW) {
            const int row = rb * 16 + r16;
            float s = 0.f, q = 0.f;
#pragma unroll
            for (int i = 0; i < 4; ++i) { const f32x4 t4 = *(const f32x4*)(ST + (size_t)row * 64 + kq * 16 + i * 4); s += t4[0] + t4[2]; q += t4[1] + t4[3]; }
            s += __shfl_xor(s, 16); s += __shfl_xor(s, 32); q += __shfl_xor(q, 16); q += __shfl_xor(q, 32);
            const float mean = s * (1.f / DM), var = fmaxf(q * (1.f / DM) - mean * mean, 0.f), rstd = 1.f / sqrtf(var + LN_EPS);
            f32x4 acc[4];
#pragma unroll
            for (int nb = 0; nb < 4; ++nb) acc[nb] = (f32x4){0.f, 0.f, 0.f, 0.f};
#pragma unroll 2
            for (int ks = 0; ks < 64; ++ks) { const int k0 = ks * 32 + kq * 8;
                const f32x4 z0 = *(const f32x4*)(Z + (size_t)row * DM + k0), z1 = *(const f32x4*)(Z + (size_t)row * DM + k0 + 4);
                const f32x4 g0 = *(const f32x4*)(lg_ + k0), g1 = *(const f32x4*)(lg_ + k0 + 4), b0 = *(const f32x4*)(lb_ + k0), b1 = *(const f32x4*)(lb_ + k0 + 4);
                const f32x4 y0 = (z0 - mean) * rstd * g0 + b0, y1 = (z1 - mean) * rstd * g1 + b1;
                const u32x4 w = pg8::pack8(y0, y1);
                *(u32x4*)(H1 + (size_t)row * DM + k0) = w;
                const bf16x8 af = __builtin_bit_cast(bf16x8, w);
#pragma unroll
                for (int nb = 0; nb < 4; ++nb) { const bf16x8 bfm = *(const bf16x8*)(WR + (size_t)(nb * 16 + r16) * DM + k0);
                    acc[nb] = __builtin_amdgcn_mfma_f32_16x16x32_bf16(af, bfm, acc[nb], 0, 0, 0); } }
#pragma unroll
            for (int nb = 0; nb < 4; ++nb)
#pragma unroll
                for (int rg = 0; rg < 4; ++rg) lgs[(kq * 4 + rg) * 65 + nb * 16 + r16] = acc[nb][rg];
            LDS_WAIT(); asm volatile("" ::: "memory");
            for (int r = 0; r < 16; ++r) {
                const int trow = rb * 16 + r;
                const float score = fast_sigmoid(lgs[r * 65 + F.lane]);
                const float sel = score + my_bias;
                float m1 = sel; m1 = fmaxf(m1, __shfl_xor(m1, 1)); m1 = fmaxf(m1, __shfl_xor(m1, 2)); m1 = fmaxf(m1, __shfl_xor(m1, 4));
                int i1 = (sel == m1) ? F.lane : 1000; i1 = min(i1, __shfl_xor(i1, 1)); i1 = min(i1, __shfl_xor(i1, 2)); i1 = min(i1, __shfl_xor(i1, 4));
                float m2 = (F.lane == i1) ? -__builtin_inff() : sel; m2 = fmaxf(m2, __shfl_xor(m2, 1)); m2 = fmaxf(m2, __shfl_xor(m2, 2)); m2 = fmaxf(m2, __shfl_xor(m2, 4));
                const float gs = m1 + m2; const int mygrp = F.lane >> 3;
                int gcount = 0;
#pragma unroll
                for (int j = 0; j < 8; ++j) { const float gj = __shfl(gs, 8 * j); gcount += (gj > gs || (gj == gs && j < mygrp)) ? 1 : 0; }
                const bool cand = gcount < 4;
                const float cs = cand ? sel : -__builtin_inff();
                int rank = 0;
#pragma unroll 8
                for (int j = 0; j < 64; ++j) { const float cj = __shfl(cs, j); rank += (cj > cs || (cj == cs && j < F.lane)) ? 1 : 0; }
                const bool chosen = cand && rank < TOPK;
                const float tot = wave_sum(chosen ? score : 0.f);
                if (chosen) { const float gate = score / tot * ROUTED_SCALE;
                    const unsigned pos = __hip_atomic_fetch_add(F.ctl + CW_CNT + 64 * F.lane, 1u, RLX_AGENT);
                    TOK[(size_t)F.lane * MX + pos] = trow;
                    IDX[(size_t)trow * 8 + rank] = F.lane; GWt[(size_t)trow * 8 + rank] = gate; RK[(size_t)trow * 8 + rank] = (int)pos; }
            }
            LDS_WAIT(); asm volatile("" ::: "memory");
        }
        if (BOTH(8)) GRID_BAR();
    }

    if (IN(9)) {
        moe_tables(F);
        const LAS int* tb = (const LAS int*)(F.lds + TB_OFF);
        pg8::MoeOrder S; S.tb = tb; S.TT = tb[64]; S.NCT = 4; S.nsh = 64 * 4; S.nwg = S.TT * 4 + S.nsh; S.G = F.G; S.c = bx; S.lda = DM; S.ldb = DM;
        S.Aexp = (const char*)(ws + WS_XN); S.tok = (const int*)(ws + WS_TOK); S.Bexp = (const char*)(ws + WS_WEGU); S.bstride = (size_t)1024 * 2048 * 2;
        S.Ash = (const char*)(ws + WS_XN); S.Bsh = (const char*)(ws + WS_WSGU); S.gather = true;
        pg8::EpiGU E{(bf16_t*)(ws + WS_HID), (bf16_t*)(ws + WS_HIDS)};
        REPS(9) pg8::gemm_phase<pg8::EpiGU, pg8::MoeOrder, true>(F.lds, pg8::GemmK{DM, DM, DM}, S, E);
        if (BOTH(9)) GRID_BAR();
    }

    if (IN(10)) {
        moe_tables(F);
        const LAS int* tb = (const LAS int*)(F.lds + TB_OFF);
        pg8::MoeOrder S; S.tb = tb; S.TT = tb[64]; S.NCT = 8; S.nsh = 64 * 8; S.nwg = S.TT * 8 + S.nsh; S.G = F.G; S.c = bx; S.lda = EFF; S.ldb = EFF;
        S.Aexp = (const char*)(ws + WS_HID); S.tok = nullptr; S.Bexp = (const char*)(ws + WS_WED); S.bstride = (size_t)2048 * 512 * 2;
        S.Ash = (const char*)(ws + WS_HIDS); S.Bsh = (const char*)(ws + WS_WSD); S.gather = false;
        pg8::EpiDown E{(bf16_t*)(ws + WS_C), (bf16_t*)(ws + WS_CS)};
        REPS(10) pg8::gemm_phase<pg8::EpiDown, pg8::MoeOrder, true>(F.lds, pg8::GemmK{EFF, EFF, EFF}, S, E);
        if (BOTH(10)) GRID_BAR();
    }

    if (IN(11)) {
        moe_tables(F);
        const LAS int* tb = (const LAS int*)(F.lds + TB_OFF);
        const bf16_t* H1 = (const bf16_t*)(ws + WS_XN); const bf16_t* CS = (const bf16_t*)(ws + WS_CS); const bf16_t* C = (const bf16_t*)(ws + WS_C);
        const int* IDX = (const int*)(ws + WS_IDX); const float* GWt = (const float*)(ws + WS_GW); const int* RK = (const int*)(ws + WS_RK);
        const float* lg_ = args.in[27]; const float* lb_ = args.in[28]; float* out = args.out;
        REPS(11)
        for (int row = gw; row < MX; row += NGW) {
            const i32x4 e0 = *(const i32x4*)(IDX + (size_t)row * 8), e1 = *(const i32x4*)(IDX + (size_t)row * 8 + 4);
            const i32x4 r0 = *(const i32x4*)(RK + (size_t)row * 8), r1 = *(const i32x4*)(RK + (size_t)row * 8 + 4);
            const f32x4 w0 = *(const f32x4*)(GWt + (size_t)row * 8), w1 = *(const f32x4*)(GWt + (size_t)row * 8 + 4);
            int slot[8]; float wk[8];
            slot[0] = tb[65 + e0[0]] + r0[0]; slot[1] = tb[65 + e0[1]] + r0[1]; slot[2] = tb[65 + e0[2]] + r0[2]; slot[3] = tb[65 + e0[3]] + r0[3];
            slot[4] = tb[65 + e1[0]] + r1[0]; slot[5] = tb[65 + e1[1]] + r1[1]; slot[6] = tb[65 + e1[2]] + r1[2]; slot[7] = tb[65 + e1[3]] + r1[3];
            wk[0] = w0[0]; wk[1] = w0[1]; wk[2] = w0[2]; wk[3] = w0[3]; wk[4] = w1[0]; wk[5] = w1[1]; wk[6] = w1[2]; wk[7] = w1[3];
            float acc[4][8];
#pragma unroll
            for (int j = 0; j < 4; ++j) { int lo_ = (j * 64 + F.lane) * 8; asm volatile("" : "+v"(lo_)); const size_t off = (size_t)row * DM + (size_t)lo_;
                const u32x4 hw = *(const u32x4*)(H1 + off), sw = *(const u32x4*)(CS + off);
                u32x4 cw[8];
#pragma unroll
                for (int k = 0; k < 8; ++k) cw[k] = *(const u32x4*)(C + (size_t)slot[k] * DM + (size_t)lo_);
                acc[j][0] = ALPHA * bf_lo(hw.x) + bf_lo(sw.x); acc[j][1] = ALPHA * bf_hi(hw.x) + bf_hi(sw.x); acc[j][2] = ALPHA * bf_lo(hw.y) + bf_lo(sw.y); acc[j][3] = ALPHA * bf_hi(hw.y) + bf_hi(sw.y);
                acc[j][4] = ALPHA * bf_lo(hw.z) + bf_lo(sw.z); acc[j][5] = ALPHA * bf_hi(hw.z) + bf_hi(sw.z); acc[j][6] = ALPHA * bf_lo(hw.w) + bf_lo(sw.w); acc[j][7] = ALPHA * bf_hi(hw.w) + bf_hi(sw.w);
#pragma unroll
                for (int k = 0; k < 8; ++k) { acc[j][0] += wk[k] * bf_lo(cw[k].x); acc[j][1] += wk[k] * bf_hi(cw[k].x); acc[j][2] += wk[k] * bf_lo(cw[k].y); acc[j][3] += wk[k] * bf_hi(cw[k].y);
                    acc[j][4] += wk[k] * bf_lo(cw[k].z); acc[j][5] += wk[k] * bf_hi(cw[k].z); acc[j][6] += wk[k] * bf_lo(cw[k].w); acc[j][7] += wk[k] * bf_hi(cw[k].w); }
                asm volatile("" ::: "memory"); }
            float s = 0.f;
#pragma unroll
            for (int j = 0; j < 4; ++j)
#pragma unroll
                for (int e = 0; e < 8; ++e) s += acc[j][e];
            const float mean = wave_sum(s) * (1.f / DM); float s2 = 0.f;
#pragma unroll
            for (int j = 0; j < 4; ++j)
#pragma unroll
                for (int e = 0; e < 8; ++e) { acc[j][e] -= mean; s2 += acc[j][e] * acc[j][e]; }
            const float rstd = 1.f / sqrtf(wave_sum(s2) * (1.f / DM) + LN_EPS);
#pragma unroll
            for (int j = 0; j < 4; ++j) { int c0 = (j * 64 + F.lane) * 8; asm volatile("" : "+v"(c0));
                const f32x4 g0 = *(const f32x4*)(lg_ + c0), g1 = *(const f32x4*)(lg_ + c0 + 4), b0 = *(const f32x4*)(lb_ + c0), b1 = *(const f32x4*)(lb_ + c0 + 4);
                f32x4 o0, o1;
#pragma unroll
                for (int e = 0; e < 4; ++e) { o0[e] = acc[j][e] * rstd * g0[e] + b0[e]; o1[e] = acc[j][4 + e] * rstd * g1[e] + b1[e]; }
                *(f32x4*)(out + (size_t)row * DM + c0) = o0; *(f32x4*)(out + (size_t)row * DM + c0 + 4) = o1; }
        }
    }
#undef IN
#undef BOTH
#undef GRID_BAR
}

#ifndef PH_MASK
#define PH_MASK 0xFFFu
#endif
typedef void (*kern_t)(Args);
template <unsigned MASK> static bool prep_kernel(kern_t& k) {
    k = hymba_fwd<MASK>;
    if (hipFuncSetAttribute((const void*)hymba_fwd<MASK>, hipFuncAttributeMaxDynamicSharedMemorySize, LDS_BYTES) != hipSuccess) { fprintf(stderr, "kernel_launch: hipFuncSetAttribute failed (mask %x)\n", MASK); return false; }
    return true;
}
extern "C" void kernel_launch(void* const* d_in, const int* in_sizes, int n_in, void* d_out, int out_size, void* d_ws, size_t ws_size, hipStream_t stream) {
    static int grid = 0; static kern_t kerns[N_PHASES];
    if (grid == 0) {
        if (n_in != 29 || in_sizes[0] != MX * DM || out_size != MX * DM || ws_size < WS_END) {
            fprintf(stderr, "kernel_launch: unexpected shapes (n_in %d, in0 %d, out %d, ws %zu; need ws >= %zu); nothing launched\n", n_in, n_in > 0 ? in_sizes[0] : -1, out_size, ws_size, (size_t)WS_END); grid = -1; return; }
        int dev = 0, cus = 0;
        if (hipGetDevice(&dev) != hipSuccess || hipDeviceGetAttribute(&cus, hipDeviceAttributeMultiprocessorCount, dev) != hipSuccess) { fprintf(stderr, "kernel_launch: device query failed\n"); grid = -1; return; }
        bool ok = true;
        if constexpr (N_LAUNCHES == 1) ok = prep_kernel<PH_MASK>(kerns[0]);
        else { ok = ok && prep_kernel<0x001u>(kerns[0]) && prep_kernel<0x002u>(kerns[1]) && prep_kernel<0x004u>(kerns[2]) && prep_kernel<0x008u>(kerns[3]) && prep_kernel<0x010u>(kerns[4]) && prep_kernel<0x020u>(kerns[5])
                       && prep_kernel<0x040u>(kerns[6]) && prep_kernel<0x080u>(kerns[7]) && prep_kernel<0x100u>(kerns[8]) && prep_kernel<0x200u>(kerns[9]) && prep_kernel<0x400u>(kerns[10]) && prep_kernel<0x800u>(kerns[11]); }
        if (!ok) { grid = -1; return; }
        (void)hipGetLastError();
        grid = cus;
    }
    if (grid < 0) return;
    if (hipMemsetAsync((char*)d_ws + WS_CTL, 0, CTL_ZERO_BYTES, stream) != hipSuccess) { fprintf(stderr, "kernel_launch: memset failed\n"); return; }
    Args a{};
    for (int i = 0; i < 29; ++i) a.in[i] = (const float*)d_in[i];
    a.out = (float*)d_out; a.ws = (unsigned char*)d_ws;
    for (int li = 0; li < N_LAUNCHES; ++li) {
        if (N_LAUNCHES != 1 && !((PH_MASK >> li) & 1u)) continue;
        a.ph_lo = (N_LAUNCHES == 1) ? 0 : li; a.ph_hi = (N_LAUNCHES == 1) ? N_PHASES : li + 1;
        hipLaunchKernelGGL(kerns[li], dim3(grid), dim3(NWAVES * 64), LDS_BYTES, stream, a);
        const hipError_t le = hipPeekAtLastError();
        if (le != hipSuccess) { fprintf(stderr, "kernel_launch: launch %d failed: %s\n", li, hipGetErrorName(le)); break; }
    }
}
```

```cpp
#include <hip/hip_runtime.h>
#include <cstdio>
#include <cstdint>

#ifndef MK_N_LAUNCHES
#define MK_N_LAUNCHES 1
#endif

#define LAS __attribute__((address_space(3)))
#define GAS __attribute__((address_space(1)))
typedef unsigned short bf16_t;
typedef short bf16x8 __attribute__((ext_vector_type(8)));
typedef short s16x4 __attribute__((ext_vector_type(4)));
typedef float f32x2 __attribute__((ext_vector_type(2)));
typedef float f32x4 __attribute__((ext_vector_type(4)));
typedef float f32x16 __attribute__((ext_vector_type(16)));
typedef unsigned u32x2 __attribute__((ext_vector_type(2)));
typedef unsigned u32x4 __attribute__((ext_vector_type(4)));
typedef int i32x4 __attribute__((ext_vector_type(4)));
typedef int i32x8 __attribute__((ext_vector_type(8)));

constexpr int BATCH = 2, SEQ = 8192, DM = 2048, NMETA = 16;
constexpr int MX = BATCH * SEQ;
constexpr int MIN_ROWS = MX + 256;
constexpr int NHEAD = 8, HD = 128, NGRP = 64, NST = 64;
constexpr int KVR = 64 + SEQ;
constexpr int NCHK = KVR / 32;
constexpr int UGK = 640;
constexpr int NEXP = 64, TOPK = 8, EFF = 512;
constexpr float LN_EPS = 1e-5f;
constexpr float ALPHA = 1.189207115002721f;
constexpr float ROUTED_SCALE = 2.5f;
constexpr float LOG2E = 1.4426950408889634f;
constexpr float QSCALE = 0.08838834764831845f * 1.4426950408889634f;
constexpr float W8SCALE = 256.f;
constexpr float H8SCALE = 8.f;

constexpr size_t MiB = 1u << 20;
constexpr size_t WS_CTL = 0, CTL_ZERO_BYTES = 1 * MiB;
constexpr size_t WS_LOGF = 1 * MiB;
constexpr size_t WS_CUM = 2 * MiB;
constexpr size_t WS_IDX = 3 * MiB;
constexpr size_t WS_GW = 3 * MiB + 512 * 1024;
constexpr size_t WS_RK = 4 * MiB;
constexpr size_t WS_WR = 4 * MiB + 512 * 1024;
constexpr size_t WS_TOK = 5 * MiB;
constexpr size_t WS_ST = 9 * MiB;
constexpr size_t WS_XN = 16 * MiB;
constexpr size_t WS_WED = 81 * MiB;
constexpr size_t WS_WSD = 209 * MiB;
constexpr size_t WS_WSGU = 211 * MiB;
constexpr size_t WS_WGLU = 215 * MiB;
constexpr size_t WS_WOUT = 217 * MiB;
constexpr size_t WS_WIN = 225 * MiB;
constexpr size_t WS_HID = 241 * MiB;
constexpr size_t WS_H1F8 = 310 * MiB;
constexpr size_t WS_YC = 241 * MiB;
constexpr size_t WS_YB = 305 * MiB;
constexpr size_t WS_Q = 337 * MiB;
constexpr size_t WS_HIDS = 370 * MiB;
constexpr size_t WS_CS = 386 * MiB;
constexpr size_t WS_C = 450 * MiB;
constexpr size_t WS_WEGU = 450 * MiB;
constexpr size_t WS_Z = 706 * MiB;
constexpr size_t WS_K = 834 * MiB;
constexpr size_t WS_V = 867 * MiB;
constexpr size_t WS_UG = 900 * MiB;
constexpr size_t WS_OPY = 941 * MiB;
constexpr size_t WS_OPE = 981 * MiB;
constexpr size_t WS_E = 997 * MiB;
constexpr size_t WS_END = 1013 * MiB;
static_assert(WS_HID + (size_t)(131072 + 256) * 512 * 2 <= WS_HIDS && WS_Q + (size_t)MX * 1024 * 2 <= WS_HIDS, "map");
static_assert(WS_K + (size_t)2 * KVR * 1024 * 2 <= WS_V && WS_V + (size_t)2 * KVR * 1024 * 2 <= WS_UG, "map");
static_assert(WS_UG + (size_t)64 * 2 * NCHK * UGK * 2 <= WS_OPY && WS_C + (size_t)131072 * 2048 * 2 <= WS_END, "map");
static_assert(WS_XN + (size_t)MIN_ROWS * 2048 * 2 <= WS_WED, "map");
constexpr int CW_TMO = 0, CW_CODE = 1;
constexpr int CW_CNT = 1024;
constexpr int CW_KMAX = 5120;
constexpr int CW_QMAX = 5184;
constexpr int CW_BAR = 8192;
constexpr float T_SKIP = 40.f;

constexpr int RING_BYTES = 139264;
constexpr int LDSCTL_OFF = RING_BYTES;
constexpr int MISC_OFF = LDSCTL_OFF + 64;
constexpr int TB_OFF = LDSCTL_OFF + 1024;
constexpr int LDS_BYTES = 147456;

__device__ __forceinline__ unsigned cvt_pk_bf16(float lo, float hi) { unsigned r; asm volatile("v_cvt_pk_bf16_f32 %0, %1, %2" : "=v"(r) : "v"(lo), "v"(hi)); return r; }
__device__ __forceinline__ float bf_lo(unsigned w) { return __uint_as_float(w << 16); }
__device__ __forceinline__ float bf_hi(unsigned w) { return __uint_as_float(w & 0xffff0000u); }
__device__ __forceinline__ float fast_sigmoid(float x) { return __builtin_amdgcn_rcpf(1.f + __builtin_amdgcn_exp2f(-x * LOG2E)); }
__device__ __forceinline__ float wave_sum(float v) {
#pragma unroll
    for (int o = 1; o < 64; o <<= 1) v += __shfl_xor(v, o);
    return v;
}
#define LDS_WAIT() asm volatile("s_waitcnt lgkmcnt(0)" ::: "memory")
#define VM_WAIT() asm volatile("s_waitcnt vmcnt(0)" ::: "memory")

namespace pg8 {
constexpr int BM = 256, BK = 64, HALF = 128, HTB = HALF * BK * 2, STAGE_BYTES = 8 * HTB, NXCD = 8, WGM = 8;
__host__ __device__ __forceinline__ int lds_byte(int r, int c) { const int st = (r >> 4) * 2 + (c >> 5), rr = r & 15, cc = c & 31, ob = rr * 64 + cc * 2; return st * 1024 + (ob ^ (((ob >> 9) & 1) << 5)); }
__host__ __device__ __forceinline__ void stage_rc(int b, int& R, int& C) { const int st = b / 1024, sb = b % 1024, swz = sb ^ (((sb >> 9) & 1) << 5); R = (st >> 1) * 16 + swz / 64; C = (st & 1) * 32 + (swz % 64) / 2; }
__host__ __device__ __forceinline__ int perm32(int rho) { const int n = rho >> 4, i = rho & 15; return 8 * (i >> 2) + 4 * n + (i & 3); }

struct Unit { const char* A; const char* B; const int* rows; int r0, c0, valid, aux; };
struct GemmK { int K, lda, ldb; };

template <class Epi, class Sched, bool ALIGN_EPI, bool F8 = false>
__device__ __forceinline__ void gemm_phase(LAS unsigned char* lds, const GemmK g, const Sched& S, const Epi& E) {
    const int tid = threadIdx.x, wid = __builtin_amdgcn_readfirstlane(tid >> 6), lane = tid & 63, wr = wid >> 2, wc = wid & 3, fr = lane & 15, fq = lane >> 4;
    constexpr unsigned ES = F8 ? 1u : 2u;
    const int K = g.K, nt = (K * (int)ES) / (BK * 2);
    int Rs[2], Cs[2]; unsigned voffB[2];
#pragma unroll
    for (int i = 0; i < 2; ++i) { int R, C; stage_rc(tid * 16 + i * 8192, R, C); const int Rb = Epi::PERM ? ((R & ~31) + perm32(R & 31)) : R;
        Rs[i] = R; Cs[i] = C; voffB[i] = (unsigned)(Rb * g.ldb) * ES + (unsigned)C * 2u; }
    const size_t kstep = (size_t)(BK * 2);
    const size_t hstepB = (size_t)HALF * g.ldb * ES;
    const unsigned ldsw = (unsigned)wid * 1024u;
    const int aoff = lds_byte(wr * 64 + fr, fq * (F8 ? 16 : 8)), boff = lds_byte(wc * 32 + fr, fq * (F8 ? 16 : 8));
    constexpr int KSTR = F8 ? 16 : 1024;
    int f8scale = 0x7f7f7f7f; asm volatile("" : "+v"(f8scale));
#define PG8_SA(b, h) (((b) * 2 + (h)) * HTB)
#define PG8_SB(b, h) ((4 + (b) * 2 + (h)) * HTB)
#define PG8_STAGE(bufoff, gbase, voff) do { _Pragma("unroll") for (int _i = 0; _i < 2; ++_i) \
        __builtin_amdgcn_global_load_lds((const unsigned*)((const char*)(gbase) + (voff)[_i]), (LAS unsigned*)(lds + (bufoff) + ldsw + _i * 8192), 16, 0, 0); } while (0)
#define PG8_LDA(dst, b, h) do { _Pragma("unroll") for (int m = 0; m < 4; ++m) _Pragma("unroll") for (int k = 0; k < 2; ++k) dst[m][k] = *(const LAS bf16x8*)(lds + PG8_SA(b, h) + aoff + m * 2048 + k * KSTR); } while (0)
#define PG8_LDB(dst, b, h) do { _Pragma("unroll") for (int n = 0; n < 2; ++n) _Pragma("unroll") for (int k = 0; k < 2; ++k) dst[n][k] = *(const LAS bf16x8*)(lds + PG8_SB(b, h) + boff + n * 2048 + k * KSTR); } while (0)
#define PG8_CAT8(x0, x1) __builtin_shufflevector(__builtin_bit_cast(i32x4, x0), __builtin_bit_cast(i32x4, x1), 0, 1, 2, 3, 4, 5, 6, 7)
#define PG8_MMA(ai, bj, At, Bt) do { __builtin_amdgcn_s_setprio(1); if constexpr (F8) { _Pragma("unroll") for (int m = 0; m < 4; ++m) _Pragma("unroll") for (int n = 0; n < 2; ++n) \
        asm volatile("v_mfma_scale_f32_16x16x128_f8f6f4 %0, %1, %2, %0, %3, %3 op_sel_hi:[0,0,0]" : "+v"(acc[ai][bj][m][n]) : "v"(PG8_CAT8(Bt[n][0], Bt[n][1])), "v"(PG8_CAT8(At[m][0], At[m][1])), "v"(f8scale)); } \
      else { _Pragma("unroll") for (int m = 0; m < 4; ++m) _Pragma("unroll") for (int n = 0; n < 2; ++n) _Pragma("unroll") for (int k = 0; k < 2; ++k) \
        acc[ai][bj][m][n] = __builtin_amdgcn_mfma_f32_16x16x32_bf16(Bt[n][k], At[m][k], acc[ai][bj][m][n], 0, 0, 0); } __builtin_amdgcn_s_setprio(0); } while (0)
#define PG8_WAIT_V(n) asm volatile("s_waitcnt vmcnt(" #n ")" ::: "memory")
#define PG8_WAIT_L(n) asm volatile("s_waitcnt lgkmcnt(" #n ")" ::: "memory")
#define PG8_BAR __builtin_amdgcn_s_barrier()
#define PG8_SCHED __builtin_amdgcn_sched_barrier(0)
#define PG8_VOFFA(u, v0, v1) do { _Pragma("unroll") for (int _i = 0; _i < 2; ++_i) { v0[_i] = S.a_off(u, Rs[_i]) + (unsigned)Cs[_i] * 2u; v1[_i] = S.a_off(u, Rs[_i] + HALF) + (unsigned)Cs[_i] * 2u; } } while (0)
    Unit cur, nxt; int ui = 0;
    if (!S.next(0, cur)) return;
    f32x4 acc[2][2][4][2];
#pragma unroll
    for (int a = 0; a < 2; ++a)
#pragma unroll
        for (int b = 0; b < 2; ++b)
#pragma unroll
            for (int m = 0; m < 4; ++m)
#pragma unroll
                for (int n = 0; n < 2; ++n) acc[a][b][m][n] = (f32x4){0.f, 0.f, 0.f, 0.f};
    bf16x8 At[4][2], B0[2][2], B1[2][2];
    const char* cA = cur.A; const char* cB = cur.B;
    unsigned vA0[2], vA1[2], nA0[2], nA1[2];
    PG8_VOFFA(cur, vA0, vA1);
    PG8_STAGE(PG8_SB(0, 0), cB, voffB); PG8_STAGE(PG8_SB(0, 1), cB + hstepB, voffB); PG8_STAGE(PG8_SA(0, 0), cA, vA0); PG8_STAGE(PG8_SA(0, 1), cA, vA1);
    if (wr == 1) PG8_BAR;
    PG8_WAIT_V(2); PG8_BAR;
    PG8_STAGE(PG8_SB(1, 0), cB + kstep, voffB); PG8_STAGE(PG8_SA(1, 0), cA + kstep, vA0); PG8_STAGE(PG8_SB(1, 1), cB + hstepB + kstep, voffB);
    PG8_WAIT_V(6); PG8_BAR;
    for (;;) {
        const bool has_next = S.next(ui + 1, nxt);
        const char* nA = has_next ? nxt.A : cA; const char* nB = has_next ? nxt.B : cB;
        if (has_next) { PG8_VOFFA(nxt, nA0, nA1); } else { nA0[0] = vA0[0]; nA0[1] = vA0[1]; nA1[0] = vA1[0]; nA1[1] = vA1[1]; }
#pragma unroll 1
        for (int t = 0; t < nt; t += 2) {
            const bool last = (t == nt - 2);
            const char* a1 = cA + (size_t)(t + 1) * kstep;
            const char* a2 = last ? nA : cA + (size_t)(t + 2) * kstep; const char* b2 = last ? nB : cB + (size_t)(t + 2) * kstep;
            const char* a3 = a2 + kstep; const char* b3 = b2 + kstep;
            unsigned w0[2], w1[2];
            w0[0] = last ? nA0[0] : vA0[0]; w0[1] = last ? nA0[1] : vA0[1]; w1[0] = last ? nA1[0] : vA1[0]; w1[1] = last ? nA1[1] : vA1[1];
            PG8_LDB(B0, 0, 0); PG8_LDB(B1, 0, 1); PG8_SCHED; PG8_LDA(At, 0, 0); PG8_STAGE(PG8_SA(1, 1), a1, vA1);
            PG8_WAIT_V(8); PG8_WAIT_L(0); PG8_BAR; PG8_MMA(0, 0, At, B0); PG8_MMA(0, 1, At, B1); PG8_BAR; PG8_SCHED;
            PG8_LDA(At, 0, 1); PG8_STAGE(PG8_SB(0, 0), b2, voffB); PG8_STAGE(PG8_SB(0, 1), b2 + hstepB, voffB); PG8_STAGE(PG8_SA(0, 0), a2, w0);
            PG8_WAIT_V(8); PG8_WAIT_L(0); PG8_BAR; PG8_MMA(1, 0, At, B0); PG8_MMA(1, 1, At, B1); PG8_BAR; PG8_SCHED;
            PG8_LDB(B0, 1, 0); PG8_LDB(B1, 1, 1); PG8_SCHED; PG8_LDA(At, 1, 0); PG8_STAGE(PG8_SA(0, 1), a2, w1);
            PG8_WAIT_V(8); PG8_WAIT_L(0); PG8_BAR; PG8_MMA(0, 0, At, B0); PG8_MMA(0, 1, At, B1); PG8_BAR; PG8_SCHED;
            PG8_LDA(At, 1, 1); PG8_STAGE(PG8_SB(1, 0), b3, voffB); PG8_STAGE(PG8_SB(1, 1), b3 + hstepB, voffB); PG8_STAGE(PG8_SA(1, 0), a3, w0);
            PG8_WAIT_V(8); PG8_WAIT_L(0); PG8_BAR; PG8_MMA(1, 0, At, B0); PG8_MMA(1, 1, At, B1); PG8_BAR; PG8_SCHED;
        }
        if constexpr (ALIGN_EPI) { if (wr == 0) PG8_BAR; }
        if constexpr (F8) asm volatile("s_nop 15\n\ts_nop 7" ::: "memory");
        E(acc, cur, wr, wc, fr, fq);
        if (!has_next) break;
#pragma unroll
        for (int a = 0; a < 2; ++a)
#pragma unroll
            for (int b = 0; b < 2; ++b)
#pragma unroll
                for (int m = 0; m < 4; ++m)
#pragma unroll
                    for (int n = 0; n < 2; ++n) acc[a][b][m][n] = (f32x4){0.f, 0.f, 0.f, 0.f};
        cur = nxt; cA = nA; cB = nB; ++ui;
        vA0[0] = nA0[0]; vA0[1] = nA0[1]; vA1[0] = nA1[0]; vA1[1] = nA1[1];
        if constexpr (ALIGN_EPI) { if (wr == 1) PG8_BAR; }
    }
    PG8_WAIT_V(0);
    if constexpr (!ALIGN_EPI) { if (wr == 0) PG8_BAR; }
    PG8_BAR;
#undef PG8_SA
#undef PG8_SB
#undef PG8_STAGE
#undef PG8_LDA
#undef PG8_LDB
#undef PG8_MMA
#undef PG8_CAT8
#undef PG8_WAIT_V
#undef PG8_WAIT_L
#undef PG8_BAR
#undef PG8_SCHED
#undef PG8_VOFFA
}

__device__ __forceinline__ int xcd_remap(int L, int nwg) { const int q = nwg / NXCD, r = nwg % NXCD, xcd = L % NXCD, off = L / NXCD; return (xcd < r ? xcd * (q + 1) : r * (q + 1) + (xcd - r) * q) + off; }

struct DenseOrder {
    const char* A; const char* B; int lda, ldb, nM, nN, nwg, G, c;
    __device__ __forceinline__ void init(const void* A_, const void* B_, int lda_, int ldb_, int M, int N, int G_, int c_) { A = (const char*)A_; B = (const char*)B_; lda = lda_ * 2; ldb = ldb_ * 2; nM = M / BM; nN = N / BM; nwg = nM * nN; G = G_; c = c_; }
    __device__ __forceinline__ bool next(int i, Unit& u) const {
        const long L = (long)i * G + c; if (L >= nwg) return false;
        const int wgid = xcd_remap((int)L, nwg);
        const int nig = WGM * nN, gid = wgid / nig, fm = gid * WGM, gsz = (nM - fm) < WGM ? (nM - fm) : WGM;
        const int pm = fm + ((wgid % nig) % gsz), pn = (wgid % nig) / gsz;
        u.A = A + (size_t)pm * BM * lda; u.B = B + (size_t)pn * BM * ldb; u.rows = nullptr; u.r0 = pm * BM; u.c0 = pn; u.valid = BM; u.aux = 0; return true;
    }
    __device__ __forceinline__ unsigned a_off(const Unit&, int R) const { return (unsigned)R * (unsigned)lda; }
};
struct EOrder {
    const char* UG; const char* OPE; int G, c;
    __device__ __forceinline__ bool next(int i, Unit& u) const {
        const int L = i * G + c; if (L >= 128) return false;
        const int g = L >> 1, b = L & 1;
        u.A = UG + ((size_t)((g * 2 + b) * NCHK + 1)) * UGK * 2; u.B = OPE + (size_t)g * 256 * 512 * 2; u.rows = nullptr; u.r0 = (g * 2 + b) * 256; u.c0 = 0; u.valid = BM; u.aux = g; return true;
    }
    __device__ __forceinline__ unsigned a_off(const Unit&, int R) const { return (unsigned)R * (unsigned)(UGK * 2); }
};
struct YOrder {
    const char* UG; const char* OPY; int G, c;
    __device__ __forceinline__ bool next(int i, Unit& u) const {
        const int L = i * G + c; if (L >= 256) return false;
        const int g = L >> 2, b = (L >> 1) & 1, pn = L & 1;
        u.A = UG + ((size_t)((g * 2 + b) * NCHK + 2)) * UGK * 2; u.B = OPY + ((size_t)g * 512 + pn * 256) * UGK * 2; u.rows = nullptr; u.r0 = b; u.c0 = pn; u.valid = BM; u.aux = g; return true;
    }
    __device__ __forceinline__ unsigned a_off(const Unit&, int R) const { return (unsigned)R * (unsigned)(UGK * 2); }
};
struct OneUnit {
    Unit u; unsigned rowbytes;
    __device__ __forceinline__ bool next(int i, Unit& uu) const { if (i > 0) return false; uu = u; return true; }
    __device__ __forceinline__ unsigned a_off(const Unit&, int R) const { return (unsigned)R * rowbytes; }
};
struct MoeOrder {
    const LAS int* tb;
    int TT, NCT, nsh, nwg, G, c, lda, ldb;
    const char* Aexp; const int* tok; const char* Bexp; size_t bstride; const char* Ash; const char* Bsh; bool gather;
    __device__ __forceinline__ bool next(int i, Unit& u) const {
        const long L = (long)i * G + c; if (L >= nwg) return false;
        const int wgid = xcd_remap((int)L, nwg);
        if (wgid < TT * NCT) {
            const int gr = wgid / NCT, ct = wgid - gr * NCT;
            int lo = 0, hi = NEXP;
            while (hi - lo > 1) { const int mid = (lo + hi) >> 1; if (tb[mid] <= gr) lo = mid; else hi = mid; }
            const int e = lo, rt = gr - tb[e], cn = tb[130 + e], cp = tb[65 + e];
            int valid = cn - rt * BM; valid = valid > BM ? BM : valid;
            if (gather) { u.A = Aexp; u.rows = tok + (size_t)e * MX + rt * BM; }
            else { u.A = Aexp + (size_t)(cp + rt * BM) * lda; u.rows = nullptr; }
            u.B = Bexp + (size_t)e * bstride + (size_t)ct * BM * ldb; u.r0 = cp + rt * BM; u.c0 = ct; u.valid = valid; u.aux = 0;
        } else {
            const int s = wgid - TT * NCT, pm = s / NCT, ct = s - pm * NCT;
            u.A = Ash + (size_t)pm * BM * lda; u.rows = nullptr; u.B = Bsh + (size_t)ct * BM * ldb; u.r0 = pm * BM; u.c0 = ct; u.valid = BM; u.aux = 1;
        }
        return true;
    }
    __device__ __forceinline__ unsigned a_off(const Unit& u, int R) const {
        if (u.rows) { const int i = R < u.valid ? R : u.valid - 1; return (unsigned)u.rows[i] * (unsigned)lda; }
        return (unsigned)R * (unsigned)lda;
    }
};

#define EPI_LOOP_ROWS for (int ai = 0; ai < 2; ++ai) _Pragma("unroll") for (int m = 0; m < 4; ++m)
__device__ __forceinline__ u32x4 pack8(f32x4 v0, f32x4 v1) { u32x4 w; w.x = cvt_pk_bf16(v0[0], v0[1]); w.y = cvt_pk_bf16(v0[2], v0[3]); w.z = cvt_pk_bf16(v1[0], v1[1]); w.w = cvt_pk_bf16(v1[2], v1[3]); return w; }

struct EpiInProj {
    static constexpr bool PERM = true;
    bf16_t* UG; bf16_t* Q; bf16_t* Kb; bf16_t* Vb;
    __device__ __forceinline__ void operator()(const f32x4 (&acc)[2][2][4][2], const Unit& u, int wr, int wc, int fr, int fq) const {
        const int pn = u.c0, sect = pn >> 2; const bool meta = (u.r0 >= MX);
        if (meta && sect == 1) return;
        const float sc = sect == 1 ? QSCALE : 1.f;
#pragma unroll
        EPI_LOOP_ROWS { const int rt = ai * HALF + wr * 64 + m * 16 + fr;
            if (meta && rt >= NMETA) continue;
#pragma unroll
            for (int bj = 0; bj < 2; ++bj) {
                const int col = (pn & 3) * 256 + bj * HALF + wc * 32 + 8 * fq;
                const u32x4 w = pack8(acc[ai][bj][m][0] * sc, acc[ai][bj][m][1] * sc);
                if (!meta) { const int row = u.r0 + rt, b = row >> 13, s = row & (SEQ - 1);
                    if (sect == 0) { const int gch = col >> 4, half = (col >> 3) & 1;
                        *(u32x4*)(UG + ((size_t)((gch * 2 + b) * NCHK + 2 + (s >> 5)) * UGK + (s & 31) * 16 + 8 * half)) = w; }
                    else if (sect == 1) *(u32x4*)(Q + (size_t)row * 1024 + col) = w;
                    else { bf16_t* dst = sect == 2 ? Kb : Vb; *(u32x4*)(dst + ((size_t)b * KVR + 64 + s) * 1024 + col) = w; }
                } else {
#pragma unroll
                    for (int b = 0; b < 2; ++b) {
                        if (sect == 0) { const int gch = col >> 4, half = (col >> 3) & 1;
                            *(u32x4*)(UG + ((size_t)((gch * 2 + b) * NCHK + 1) * UGK + (16 + rt) * 16 + 8 * half)) = w; }
                        else { bf16_t* dst = sect == 2 ? Kb : Vb; *(u32x4*)(dst + ((size_t)b * KVR + 48 + rt) * 1024 + col) = w; }
                    }
                }
            }
        }
    }
};
struct EpiE {
    static constexpr bool PERM = false;
    float* E;
    __device__ __forceinline__ void operator()(const f32x4 (&acc)[2][2][4][2], const Unit& u, int wr, int wc, int fr, int fq) const {
#pragma unroll
        EPI_LOOP_ROWS { const int rt = ai * HALF + wr * 64 + m * 16 + fr;
#pragma unroll
            for (int n = 0; n < 2; ++n) *(f32x4*)(E + (size_t)(u.r0 + rt) * 128 + wc * 32 + 16 * n + 4 * fq) = acc[ai][0][m][n]; }
    }
};
__device__ __forceinline__ float gelu_tanh(float v) { const float t = 1.5957691216057308f * (v + 0.044715f * v * v * v); return v * fast_sigmoid(t); }
struct EpiY {
    static constexpr bool PERM = true;
    bf16_t* YB;
    __device__ __forceinline__ void operator()(const f32x4 (&acc)[2][2][4][2], const Unit& u, int wr, int wc, int fr, int fq) const {
        const int b = u.r0, g = u.aux;
#pragma unroll
        EPI_LOOP_ROWS { const int rt = ai * HALF + wr * 64 + m * 16 + fr;
#pragma unroll
            for (int bj = 0; bj < 2; ++bj) { const int col = u.c0 * 256 + bj * HALF + wc * 32 + 8 * fq, t = col >> 4, h0 = col & 15;
                f32x4 v0 = acc[ai][bj][m][0], v1 = acc[ai][bj][m][1];
#pragma unroll
                for (int e = 0; e < 4; ++e) { v0[e] = gelu_tanh(v0[e]); v1[e] = gelu_tanh(v1[e]); }
                *(u32x4*)(YB + ((size_t)b * SEQ + 32 * rt + t) * 1024 + g * 16 + h0) = pack8(v0, v1); } }
    }
};
struct EpiGlu {
    static constexpr bool PERM = true;
    const bf16_t* YB; const float* bias; bf16_t* YC;
    __device__ __forceinline__ void operator()(const f32x4 (&acc)[2][2][4][2], const Unit& u, int wr, int wc, int fr, int fq) const {
#pragma unroll
        for (int bj = 0; bj < 2; ++bj) { const int col = u.c0 * 256 + bj * HALF + wc * 32 + 8 * fq;
            const f32x4 b0 = *(const f32x4*)(bias + col), b1 = *(const f32x4*)(bias + col + 4);
#pragma unroll
            EPI_LOOP_ROWS { const int row = u.r0 + ai * HALF + wr * 64 + m * 16 + fr;
                const u32x4 yw = *(const u32x4*)(YB + (size_t)row * 1024 + col);
                f32x4 v0 = acc[ai][bj][m][0] + b0, v1 = acc[ai][bj][m][1] + b1;
                v0[0] = bf_lo(yw.x) * fast_sigmoid(v0[0]); v0[1] = bf_hi(yw.x) * fast_sigmoid(v0[1]); v0[2] = bf_lo(yw.y) * fast_sigmoid(v0[2]); v0[3] = bf_hi(yw.y) * fast_sigmoid(v0[3]);
                v1[0] = bf_lo(yw.z) * fast_sigmoid(v1[0]); v1[1] = bf_hi(yw.z) * fast_sigmoid(v1[1]); v1[2] = bf_lo(yw.w) * fast_sigmoid(v1[2]); v1[3] = bf_hi(yw.w) * fast_sigmoid(v1[3]);
                *(u32x4*)(YC + (size_t)row * 2048 + col) = pack8(v0, v1); } }
    }
};
struct EpiOut {
    static constexpr bool PERM = false;
    const bf16_t* XN; float* Z; float* ST;
    __device__ __forceinline__ void operator()(const f32x4 (&acc)[2][2][4][2], const Unit& u, int wr, int wc, int fr, int fq) const {
#pragma unroll
        EPI_LOOP_ROWS { const int row = u.r0 + ai * HALF + wr * 64 + m * 16 + fr; float s = 0.f, q = 0.f;
#pragma unroll
            for (int bj = 0; bj < 2; ++bj)
#pragma unroll
                for (int n = 0; n < 2; ++n) { const int col = u.c0 * 256 + bj * HALF + wc * 32 + 16 * n + 4 * fq;
                    const u32x2 hw = *(const u32x2*)(XN + (size_t)row * 2048 + col);
                    f32x4 z = acc[ai][bj][m][n];
                    z[0] += ALPHA * bf_lo(hw.x); z[1] += ALPHA * bf_hi(hw.x); z[2] += ALPHA * bf_lo(hw.y); z[3] += ALPHA * bf_hi(hw.y);
                    s += (z[0] + z[1]) + (z[2] + z[3]); q += (z[0] * z[0] + z[1] * z[1]) + (z[2] * z[2] + z[3] * z[3]);
                    *(f32x4*)(Z + (size_t)row * 2048 + col) = z; }
            s += __shfl_xor(s, 16); s += __shfl_xor(s, 32); q += __shfl_xor(q, 16); q += __shfl_xor(q, 32);
            if (fq == 0) *(f32x2*)(ST + ((size_t)row * 32 + u.c0 * 4 + wc) * 2) = (f32x2){s, q}; }
    }
};
__device__ __forceinline__ float clamp448(float v) { return __builtin_fminf(__builtin_fmaxf(v, -448.f), 448.f); }
__device__ __forceinline__ u32x2 pack8_fp8(f32x4 v0, f32x4 v1) {
    int lo = 0, hi = 0;
    lo = __builtin_amdgcn_cvt_pk_fp8_f32(clamp448(v0[0]), clamp448(v0[1]), lo, false); lo = __builtin_amdgcn_cvt_pk_fp8_f32(clamp448(v0[2]), clamp448(v0[3]), lo, true);
    hi = __builtin_amdgcn_cvt_pk_fp8_f32(clamp448(v1[0]), clamp448(v1[1]), hi, false); hi = __builtin_amdgcn_cvt_pk_fp8_f32(clamp448(v1[2]), clamp448(v1[3]), hi, true);
    return (u32x2){(unsigned)lo, (unsigned)hi};
}
struct EpiGU {
    static constexpr bool PERM = true;
    unsigned char* HID; unsigned char* HIDS;
    __device__ __forceinline__ void operator()(const f32x4 (&acc)[2][2][4][2], const Unit& u, int wr, int wc, int fr, int fq) const {
        unsigned char* dst = u.aux ? HIDS : HID; constexpr float WI = 1.f / W8SCALE;
#pragma unroll
        EPI_LOOP_ROWS { const int rt = ai * HALF + wr * 64 + m * 16 + fr;
            if (rt < u.valid) { f32x4 h0, h1;
#pragma unroll
                for (int e = 0; e < 4; ++e) { const float g0 = acc[ai][0][m][0][e] * WI, g1 = acc[ai][0][m][1][e] * WI;
                    h0[e] = g0 * fast_sigmoid(g0) * (acc[ai][1][m][0][e] * (WI * H8SCALE)); h1[e] = g1 * fast_sigmoid(g1) * (acc[ai][1][m][1][e] * (WI * H8SCALE)); }
                *(u32x2*)(dst + (size_t)(u.r0 + rt) * EFF + u.c0 * HALF + wc * 32 + 8 * fq) = pack8_fp8(h0, h1); } }
    }
};
struct EpiDown {
    static constexpr bool PERM = true;
    bf16_t* C; bf16_t* CS;
    __device__ __forceinline__ void operator()(const f32x4 (&acc)[2][2][4][2], const Unit& u, int wr, int wc, int fr, int fq) const {
        bf16_t* dst = u.aux ? CS : C;
#pragma unroll
        EPI_LOOP_ROWS { const int rt = ai * HALF + wr * 64 + m * 16 + fr;
            if (rt < u.valid) {
#pragma unroll
                for (int bj = 0; bj < 2; ++bj) *(u32x4*)(dst + (size_t)(u.r0 + rt) * 2048 + u.c0 * 256 + bj * HALF + wc * 32 + 8 * fq) = pack8(acc[ai][bj][m][0] * (1.f / (W8SCALE * H8SCALE)), acc[ai][bj][m][1] * (1.f / (W8SCALE * H8SCALE))); } }
    }
};
}

namespace att {
constexpr int D = 128, NW = 8, QBLK = 32, KVBLK = 64, QB = NW * QBLK;
constexpr int PQ = 1024, PKV = 1024, PO = 2048;
constexpr int SHM_V = KVBLK * D * 2, SHM_K = KVBLK * D * 2;
constexpr int OFF_WS = 2 * SHM_V + 2 * SHM_K, OFF_CUM = OFF_WS + NW * 64 * 4, LDS_BYTES = OFF_CUM + 2 * 64 * 4;
constexpr float THR2 = 8.f * 1.4426950408889634f;
constexpr unsigned WINF = 0x7fffffffu;
#define KSWZ(row, colB) ((row) * 256 + ((colB) ^ (((row) & 7) << 4)))
#define SBAR() __builtin_amdgcn_sched_barrier(0)
__device__ __forceinline__ int v_st(int k, int c) { const int kk = (k & ~0xC) | ((k & 4) << 1) | ((k & 8) >> 1); return ((kk >> 3) * 4 + (c >> 5)) * 512 + ((kk & 7) * 32 + (c & 31)) * 2; }
__device__ __forceinline__ int v_rd_base(int lane) { return ((lane & 3) << 3) | (((lane >> 2) & 3) << 6) | (((lane >> 4) & 1) << 5) | (((lane >> 5) & 1) << 8); }
constexpr int v_rd_off(int d0, int ks, int half) { return d0 * 512 + ks * 4096 + half * 2048; }
__device__ __forceinline__ int crow(int r, int hi) { return (r & 3) + 8 * (r >> 2) + 4 * hi; }
__device__ __forceinline__ unsigned cvtpk(float lo, float hi) { unsigned r; asm volatile("v_cvt_pk_bf16_f32 %0, %1, %2" : "=v"(r) : "v"(lo), "v"(hi)); return r; }
__device__ __forceinline__ bf16x8 ld8(const bf16_t* p) { return *reinterpret_cast<const bf16x8*>(p); }
__device__ __forceinline__ void mask_tile(f32x16& p0, f32x16& p1, int dq, unsigned W) {
    const float NEG = -__builtin_inff();
#pragma unroll
    for (int r = 0; r < 16; ++r) { const int c = (r & 3) + 8 * (r >> 2);
        if ((unsigned)(dq - c) >= W) p0[r] = NEG;
        if ((unsigned)(dq - c - 32) >= W) p1[r] = NEG; }
}
__device__ __forceinline__ void partialSM(f32x16& p0, f32x16& p1, float& m_reg, float& mn, float& alpha) {
    float pmax = p0[0];
#pragma unroll
    for (int r = 1; r < 16; ++r) pmax = fmaxf(pmax, p0[r]);
#pragma unroll
    for (int r = 0; r < 16; ++r) pmax = fmaxf(pmax, p1[r]);
    { auto rr = __builtin_amdgcn_permlane32_swap(__float_as_uint(pmax), __float_as_uint(pmax), false, false);
      pmax = fmaxf(__uint_as_float(rr[0]), __uint_as_float(rr[1])); }
    if (__builtin_expect(__all((pmax - m_reg) <= THR2), 1)) { mn = m_reg; alpha = 1.f; }
    else { mn = fmaxf(m_reg, pmax); alpha = __builtin_amdgcn_exp2f(m_reg - mn); m_reg = mn; }
#pragma unroll
    for (int r = 0; r < 16; ++r) p0[r] = p0[r] - mn;
#pragma unroll
    for (int r = 0; r < 16; ++r) p1[r] = p1[r] - mn;
#pragma unroll
    for (int r = 0; r < 16; ++r) p0[r] = __builtin_amdgcn_exp2f(p0[r]);
}
__device__ __forceinline__ void finishSM(f32x16& p0, f32x16& p1, float alpha, float& l_reg, bf16x8& pa0, bf16x8& pa1, bf16x8& pa2, bf16x8& pa3) {
#pragma unroll
    for (int r = 0; r < 16; ++r) p1[r] = __builtin_amdgcn_exp2f(p1[r]);
    float ps = 0;
#pragma unroll
    for (int r = 0; r < 16; ++r) ps += p0[r];
#pragma unroll
    for (int r = 0; r < 16; ++r) ps += p1[r];
    { auto rr = __builtin_amdgcn_permlane32_swap(__float_as_uint(ps), __float_as_uint(ps), false, false);
      ps = __uint_as_float(rr[0]) + __uint_as_float(rr[1]); }
    l_reg = l_reg * alpha + ps;
#define PK4(P, B_, OUT) do { unsigned a0 = cvtpk(P[B_+0], P[B_+1]), a1 = cvtpk(P[B_+2], P[B_+3]);                          \
        unsigned b0 = cvtpk(P[B_+4], P[B_+5]), b1 = cvtpk(P[B_+6], P[B_+7]);                                             \
        auto r0 = __builtin_amdgcn_permlane32_swap(a0, b0, false, false); auto r1 = __builtin_amdgcn_permlane32_swap(a1, b1, false, false); \
        u32x4 w = {r0[0], r1[0], r0[1], r1[1]}; OUT = *reinterpret_cast<bf16x8*>(&w); } while (0)
    PK4(p0, 0, pa0); PK4(p0, 8, pa1); PK4(p1, 0, pa2); PK4(p1, 8, pa3);
#undef PK4
}
template <int KB>
__device__ __forceinline__ void qkt(f32x16& p0, f32x16& p1, const LAS char* K_lds, const LAS float* cumL, int r32, int hi, const bf16x8* qr) {
    { int l_ = r32 + 32 * hi; asm volatile("" : "+v"(l_)); r32 = l_ & 31; hi = l_ >> 5; }
    const LAS float* cb = cumL + KB * 64 + 4 * hi;
#pragma unroll
    for (int g = 0; g < 4; ++g) { const f32x4 a = *(const LAS f32x4*)(cb + 8 * g), b = *(const LAS f32x4*)(cb + 32 + 8 * g);
        p0[4 * g] = a[0]; p0[4 * g + 1] = a[1]; p0[4 * g + 2] = a[2]; p0[4 * g + 3] = a[3];
        p1[4 * g] = b[0]; p1[4 * g + 1] = b[1]; p1[4 * g + 2] = b[2]; p1[4 * g + 3] = b[3]; }
    const LAS char* kb[4];
#pragma unroll
    for (int dd = 0; dd < 4; ++dd) kb[dd] = K_lds + KB * SHM_K + KSWZ(r32, (dd * 16 + hi * 8) * 2);
#pragma unroll
    for (int d0 = 0; d0 < 8; ++d0) { const LAS char* a = kb[d0 & 3] + (d0 >> 2) * 128;
        bf16x8 b0 = *reinterpret_cast<const LAS bf16x8*>(a);
        bf16x8 b1 = *reinterpret_cast<const LAS bf16x8*>(a + 32 * 256);
        p0 = __builtin_amdgcn_mfma_f32_32x32x16_bf16(b0, qr[d0], p0, 0, 0, 0);
        p1 = __builtin_amdgcn_mfma_f32_32x32x16_bf16(b1, qr[d0], p1, 0, 0, 0); }
}
template <int VB>
__device__ __forceinline__ void pv_tile(f32x16* o, int vb0, bf16x8 pa0, bf16x8 pa1, bf16x8 pa2, bf16x8 pa3) {
#define TRRD(dst, off) asm volatile("ds_read_b64_tr_b16 %0, %1 offset:%2" : "=&v"(dst) : "v"(vb0), "i"(off) : "memory")
#define PV_D0(d0) do { s16x4 l0, l1, l2, l3, h0, h1, h2, h3; constexpr int b_ = VB * SHM_V + v_rd_off(d0, 0, 0); \
        TRRD(l0, b_); TRRD(h0, b_ + 2048); TRRD(l1, b_ + 4096); TRRD(h1, b_ + 6144); TRRD(l2, b_ + 8192); TRRD(h2, b_ + 10240); TRRD(l3, b_ + 12288); TRRD(h3, b_ + 14336); \
        asm volatile("s_waitcnt lgkmcnt(0)" ::: "memory"); SBAR();   \
        o[d0] = __builtin_amdgcn_mfma_f32_32x32x16_bf16(pa0, (bf16x8){l0[0], l0[1], l0[2], l0[3], h0[0], h0[1], h0[2], h0[3]}, o[d0], 0, 0, 0);   \
        o[d0] = __builtin_amdgcn_mfma_f32_32x32x16_bf16(pa1, (bf16x8){l1[0], l1[1], l1[2], l1[3], h1[0], h1[1], h1[2], h1[3]}, o[d0], 0, 0, 0);   \
        o[d0] = __builtin_amdgcn_mfma_f32_32x32x16_bf16(pa2, (bf16x8){l2[0], l2[1], l2[2], l2[3], h2[0], h2[1], h2[2], h2[3]}, o[d0], 0, 0, 0);   \
        o[d0] = __builtin_amdgcn_mfma_f32_32x32x16_bf16(pa3, (bf16x8){l3[0], l3[1], l3[2], l3[3], h3[0], h3[1], h3[2], h3[3]}, o[d0], 0, 0, 0); } while (0)
    PV_D0(0); PV_D0(1); PV_D0(2); PV_D0(3);
#undef PV_D0
#undef TRRD
}
struct BlockRef { const bf16_t* Q; const bf16_t* K; const bf16_t* V; bf16_t* O; const float* nck; int P0; int j_lo; };
struct Seam { bf16x8 qr[8]; bf16x8 st_v0, st_v1, st_k0, st_k1; };
#define ROWP(p, k0, rr) ((p) + (size_t)((k0) + (rr)) * PKV + sc)
#define VMW() asm volatile("s_waitcnt vmcnt(0)" ::: "memory")
#define VMWN(n) asm volatile("s_waitcnt vmcnt(%0)" :: "i"(n) : "memory")
#define SLOAD_H(BR, k0, CB) do { S.st_v0 = ld8(ROWP((BR).V, k0, sr)); S.st_v1 = ld8(ROWP((BR).V, k0, 32 + sr));              \
                             S.st_k0 = ld8(ROWP((BR).K, k0, sr)); S.st_k1 = ld8(ROWP((BR).K, k0, 32 + sr)); \
                             if (wid == 0) __builtin_amdgcn_global_load_lds((const unsigned*)((BR).nck + (k0) + lane), (LAS unsigned*)(cumL + (CB) * 64), 4, 0, 0); } while (0)
#define SWRITE_HK(bf) do { int t_ = tid; asm volatile("" : "+v"(t_)); const int kws_ = KSWZ(t_ >> 4, (t_ & 15) * 16); \
                           *(LAS bf16x8*)(K_lds + (bf) * SHM_K + kws_) = S.st_k0; *(LAS bf16x8*)(K_lds + (bf) * SHM_K + kws_ + 32 * 256) = S.st_k1; } while (0)
#define SWRITE_HV(bf) do { int t_ = tid; asm volatile("" : "+v"(t_)); const int vs0_ = v_st(t_ >> 4, (t_ & 15) * 8), vs1_ = v_st(32 + (t_ >> 4), (t_ & 15) * 8); \
                           *(LAS bf16x8*)(V_lds + (bf) * SHM_V + vs0_) = S.st_v0; *(LAS bf16x8*)(V_lds + (bf) * SHM_V + vs1_) = S.st_v1; } while (0)
__device__ __forceinline__ void fox_prime(const BlockRef& cur, LAS char* lds, Seam& S) {
    const int tid = threadIdx.x, wid = __builtin_amdgcn_readfirstlane(tid >> 6), lane = tid & 63, r32 = lane & 31, hi = lane >> 5;
    const int sr = tid >> 4, sc = (tid & 15) * 8; LAS char* K_lds = lds + 2 * SHM_V; LAS float* cumL = (LAS float*)(lds + OFF_CUM);
    const int kb0 = cur.j_lo * KVBLK;
#pragma unroll
    for (int d0 = 0; d0 < 8; ++d0) S.qr[d0] = ld8(cur.Q + (size_t)(wid * QBLK + r32) * PQ + d0 * 16 + hi * 8);
    SLOAD_H(cur, kb0, 0); VMW(); SWRITE_HK(0);
    __syncthreads();
}
__device__ __forceinline__ void fox_block(const BlockRef& cur, const BlockRef& nxt, int skv, LAS char* lds, Seam& S) {
    const int tid = threadIdx.x, wid = __builtin_amdgcn_readfirstlane(tid >> 6), lane = tid & 63, r32 = lane & 31, hi = lane >> 5;
    const int j_lo = cur.j_lo;
    int j_hi = (cur.P0 + QB - 1) / KVBLK + 1; if (j_hi > skv / KVBLK) j_hi = skv / KVBLK;
    const int NT = j_hi - j_lo;
    const int kbn = nxt.j_lo * KVBLK;
    const int qlo = cur.P0 + wid * QBLK;
    LAS char* V_lds = lds; LAS char* K_lds = lds + 2 * SHM_V; LAS float* cumL = (LAS float*)(lds + OFF_CUM);
    LAS float* ws = (LAS float*)(lds + OFF_WS) + wid * 64; LAS float* li_l = ws; LAS float* al_l = ws + 32;
    float m_reg = -1e30f, l_reg = 0; f32x16 o[4] = {};
    const int sr = tid >> 4, sc = (tid & 15) * 8;
    const int vb0 = (int)(unsigned)(uintptr_t)V_lds + v_rd_base(lane);
#define RESC(a) do { if (__any((a) < 1.f)) { if (hi == 0) al_l[r32] = (a); asm volatile("s_waitcnt lgkmcnt(0)" ::: "memory");              \
                     _Pragma("unroll") for (int d_ = 0; d_ < 4; ++d_) _Pragma("unroll") for (int r = 0; r < 16; ++r) o[d_][r] *= al_l[crow(r, hi)]; } } while (0)
#define KBASE(t) ((j_lo + (t)) * KVBLK)
#define MASKT(P0_, P1_, t) do { const int kb_ = KBASE(t); if (kb_ + KVBLK - 1 > qlo) { int lc_ = lane; asm volatile("" : "+v"(lc_)); mask_tile(P0_, P1_, qlo + (lc_ & 31) - 4 * (lc_ >> 5) - kb_, WINF); } } while (0)
    constexpr int NQL = 8;
#define SEAM_K0() do { VMWN(NQL); SWRITE_HK(0); SBAR(); } while (0)
    f32x16 pA0, pA1, pB0, pB1; float mnA, mnB, alA, alB; bf16x8 pa0, pa1, pa2, pa3;
    SWRITE_HV(0); SBAR();
    if (NT > 1) { SLOAD_H(cur, KBASE(1), 1); }
    SBAR(); qkt<0>(pA0, pA1, K_lds, cumL, r32, hi, S.qr);
    MASKT(pA0, pA1, 0); partialSM(pA0, pA1, m_reg, mnA, alA);
    if (NT > 1) { VMW(); SWRITE_HV(1); SWRITE_HK(1); }
    __syncthreads();
#define HALF_STEP(PX0, PX1, mnX, alX, PY0, PY1, alY, t, KB, VB, SB) do {                                                      \
        SBAR(); qkt<KB>(PX0, PX1, K_lds, cumL, r32, hi, S.qr);                                                                \
        finishSM(PY0, PY1, alY, l_reg, pa0, pa1, pa2, pa3); SBAR();                                                           \
        if ((t) + 1 < NT) { SLOAD_H(cur, KBASE((t) + 1), SB); SBAR(); }                                                           \
        pv_tile<VB>(o, vb0, pa0, pa1, pa2, pa3); MASKT(PX0, PX1, (t)); partialSM(PX0, PX1, m_reg, mnX, alX);                  \
        __syncthreads();                                                                                                      \
        if ((t) + 1 < NT) { VMW(); SWRITE_HV(SB); SWRITE_HK(SB); }                                       \
        RESC(alX); __syncthreads(); } while (0)
    for (int t = 1; t + 1 < NT; t += 2) {
        HALF_STEP(pB0, pB1, mnB, alB, pA0, pA1, alA, t, 1, 0, 0);
        HALF_STEP(pA0, pA1, mnA, alA, pB0, pB1, alB, t + 1, 0, 1, 1);
    }
    const bool even = (NT & 1) == 0;
    if (even) { SBAR(); qkt<1>(pB0, pB1, K_lds, cumL, r32, hi, S.qr); SBAR(); }
    SLOAD_H(nxt, kbn, 0); SBAR();
    { int lc_ = lane; asm volatile("" : "+v"(lc_)); const bf16_t* qp_ = nxt.Q + (size_t)(wid * QBLK + (lc_ & 31)) * PQ + (lc_ >> 5) * 8;
#pragma unroll
    for (int d0 = 0; d0 < 8; ++d0) S.qr[d0] = ld8(qp_ + d0 * 16); }
    SBAR();
    finishSM(pA0, pA1, alA, l_reg, pa0, pa1, pa2, pa3); SBAR();
    pv_tile<0>(o, vb0, pa0, pa1, pa2, pa3);
    if (even) { MASKT(pB0, pB1, NT - 1); partialSM(pB0, pB1, m_reg, mnB, alB); __syncthreads(); RESC(alB);
        finishSM(pB0, pB1, alB, l_reg, pa0, pa1, pa2, pa3); SBAR(); pv_tile<1>(o, vb0, pa0, pa1, pa2, pa3); }
    SBAR(); SEAM_K0();
    if (hi == 0) li_l[r32] = l_reg; asm volatile("s_waitcnt lgkmcnt(0)" ::: "memory");
    float rli[16];
#pragma unroll
    for (int r = 0; r < 16; ++r) rli[r] = __builtin_amdgcn_rcpf(li_l[crow(r, hi)]);
    { int lc_ = lane; asm volatile("" : "+v"(lc_)); const int r32c = lc_ & 31, hic = lc_ >> 5;
    bf16_t* Ow = cur.O + (size_t)(wid * QBLK + 4 * hic) * PO + r32c;
#pragma unroll
    for (int r = 0; r < 16; ++r) { const int orow = (r & 3) + 8 * (r >> 2);
#pragma unroll
        for (int d0 = 0; d0 < 4; ++d0) { const float v = o[d0][r] * rli[r];
            const float vn = __shfl_xor(v, 1);
            if ((r32c & 1) == 0) *(unsigned*)(Ow + (size_t)orow * PO + d0 * 32) = cvtpk(v, vn); } } }
    __syncthreads();
#undef RESC
#undef KBASE
#undef MASKT
#undef SEAM_K0
#undef HALF_STEP
}
#undef ROWP
#undef VMW
#undef VMWN
#undef SLOAD_H
#undef SWRITE_HK
#undef SWRITE_HV
#undef SBAR
#undef KSWZ
}

typedef GAS unsigned gu32;
#define RLX_AGENT __ATOMIC_RELAXED, __HIP_MEMORY_SCOPE_AGENT
#define XB_TMO      128
#define XB_XCNT(j)  (256  + 64 * (j))
#define XB_XSUB(j)  (1280 + 64 * (j))
#define XB_XGEN(j)  (2304 + 64 * (j))
#define XB_TOP      3328
#define XB_TOPGEN   3392
#define XCD_BAR_WORDS 3456
#define XB_SPIN_CAP (1u << 20)
__device__ __forceinline__ unsigned xb_ld(unsigned* p)              { return __hip_atomic_load(p, __ATOMIC_RELAXED, __HIP_MEMORY_SCOPE_AGENT); }
__device__ __forceinline__ unsigned xb_add(unsigned* p, unsigned v) { return __hip_atomic_fetch_add(p, v, __ATOMIC_RELAXED, __HIP_MEMORY_SCOPE_AGENT); }
__device__ __forceinline__ unsigned xb_xcc_id() { return (unsigned)__builtin_amdgcn_s_getreg((3 << 11) | 20) & 0xFu; }
#define XB_SPIN(cond, bar) do { unsigned _sp = 0; while (cond) { __builtin_amdgcn_s_sleep(1); \
    if ((++_sp & 255u) == 0u) { if (xb_ld(&(bar)[XB_TMO])) break; if (_sp > XB_SPIN_CAP) { atomicAdd(&(bar)[XB_TMO], 1u); break; } } } } while (0)
struct XcdBarrier { unsigned* bar; unsigned x; volatile LAS unsigned* st; };
__device__ __forceinline__ XcdBarrier xcd_barrier_post(unsigned* bar, volatile LAS unsigned* st) {
    XcdBarrier b; b.bar = bar; b.x = xb_xcc_id(); b.st = st;
    if (threadIdx.x == 0) (void)xb_add(&bar[XB_XCNT(b.x)], 1u);
    return b;
}
__device__ __forceinline__ void xcd_barrier_complete(unsigned* bar, unsigned x, unsigned& nloc, unsigned& nx) {
    const unsigned G = gridDim.x * gridDim.y * gridDim.z;
    unsigned sum, cnt, mine, sp = 0u;
    for (;;) {
        sum = 0u; cnt = 0u; mine = 0u;
#pragma unroll
        for (unsigned j = 0; j < 16; ++j) { const unsigned c = xb_ld(&bar[XB_XCNT(j)]); sum += c; cnt += (c > 0u) ? 1u : 0u; mine = (j == x) ? c : mine; }
        if (sum == G) break;
        __builtin_amdgcn_s_sleep(1);
        if ((++sp & 255u) == 0u) { if (xb_ld(&bar[XB_TMO])) break; if (sp > XB_SPIN_CAP) { atomicAdd(&bar[XB_TMO], 1u); break; } }
    }
    nloc = mine > 0u ? mine : 1u; nx = cnt > 0u ? cnt : 1u;
}
__device__ __forceinline__ void xcd_barrier(const XcdBarrier& b) {
    asm volatile("s_waitcnt vmcnt(0)" ::: "memory");
    __syncthreads();
    if (threadIdx.x == 0) {
        unsigned* bar = b.bar;
        __builtin_amdgcn_s_waitcnt(0);
        unsigned nloc = b.st[0], nx = b.st[1];
        if (nloc == 0u) { xcd_barrier_complete(bar, b.x, nloc, nx); b.st[0] = nloc; b.st[1] = nx; }
        const unsigned old = xb_add(&bar[XB_XSUB(b.x)], 1u);
        const unsigned gen = old / nloc;
        if (old + 1u == (gen + 1u) * nloc) {
            __builtin_amdgcn_fence(__ATOMIC_RELEASE, "agent");
            asm volatile("s_waitcnt vmcnt(0)" ::: "memory");
            const unsigned og = xb_add(&bar[XB_TOP], 1u);
            const unsigned tg = og / nx;
            if (og + 1u == (tg + 1u) * nx) xb_add(&bar[XB_TOPGEN], 1u);
            else XB_SPIN(xb_ld(&bar[XB_TOPGEN]) == tg, bar);
            __builtin_amdgcn_fence(__ATOMIC_ACQUIRE, "agent");
            xb_add(&bar[XB_XGEN(b.x)], 1u);
            asm volatile("s_waitcnt vmcnt(0)" ::: "memory");
        } else {
            XB_SPIN(xb_ld(&bar[XB_XGEN(b.x)]) == gen, bar);
            __builtin_amdgcn_fence(__ATOMIC_ACQUIRE, "agent");
            asm volatile("s_waitcnt vmcnt(0)" ::: "memory");
        }
    }
    __syncthreads();
}

constexpr int NWAVES = 8;
constexpr int N_PHASES = 12;
constexpr int N_LAUNCHES = MK_N_LAUNCHES;
static_assert(N_LAUNCHES == 1 || N_LAUNCHES == N_PHASES, "MK_N_LAUNCHES is 1 (one dispatch) or 12 (one dispatch per phase)");
struct Args { const float* in[29]; float* out; unsigned char* ws; int ph_lo, ph_hi; };
struct Frame {
    LAS unsigned char* lds; volatile LAS unsigned* MISC; gu32* ctl; unsigned char* ws;
    int tid, lane, wave, vcu, G;
};

struct TileRef { const float* src; void* dst; int ld_src, ld_dst, f8; };
__device__ __forceinline__ void p0_tile_load(const TileRef& t, f32x4 (&v)[16], int lane) {
    const int c4 = lane & 7, r8 = lane >> 3;
#pragma unroll
    for (int it = 0; it < 16; ++it) v[it] = *(const f32x4*)(t.src + (size_t)(it * 8 + r8) * t.ld_src + 4 * c4);
}
__device__ __forceinline__ void p0_tile_store(const TileRef& t, const f32x4 (&v)[16], LAS float* scr, int lane) {
    const int c4 = lane & 7, r8 = lane >> 3;
#pragma unroll
    for (int it = 0; it < 16; ++it) { const int r = it * 8 + r8;
#pragma unroll
        for (int e = 0; e < 4; ++e) scr[(4 * c4 + e) * 132 + r] = v[it][e]; }
    LDS_WAIT(); asm volatile("" ::: "memory");
    const int kc = lane & 15, n4 = lane >> 4;
#pragma unroll
    for (int it = 0; it < 8; ++it) { const int n = it * 4 + n4;
        const f32x4 a = *(const LAS f32x4*)(scr + n * 132 + 8 * kc), b = *(const LAS f32x4*)(scr + n * 132 + 8 * kc + 4);
        if (t.f8) { int lo = 0, hi = 0;
            lo = __builtin_amdgcn_cvt_pk_fp8_f32(a[0] * W8SCALE, a[1] * W8SCALE, lo, false); lo = __builtin_amdgcn_cvt_pk_fp8_f32(a[2] * W8SCALE, a[3] * W8SCALE, lo, true);
            hi = __builtin_amdgcn_cvt_pk_fp8_f32(b[0] * W8SCALE, b[1] * W8SCALE, hi, false); hi = __builtin_amdgcn_cvt_pk_fp8_f32(b[2] * W8SCALE, b[3] * W8SCALE, hi, true);
            *(u32x2*)((unsigned char*)t.dst + (size_t)n * t.ld_dst + 8 * kc) = (u32x2){(unsigned)lo, (unsigned)hi}; }
        else { u32x4 w; w.x = cvt_pk_bf16(a[0], a[1]); w.y = cvt_pk_bf16(a[2], a[3]); w.z = cvt_pk_bf16(b[0], b[1]); w.w = cvt_pk_bf16(b[2], b[3]);
            *(u32x4*)((bf16_t*)t.dst + (size_t)n * t.ld_dst + 8 * kc) = w; } }
    LDS_WAIT(); asm volatile("" ::: "memory");
}
template <int MODE, int F8>
__device__ __forceinline__ TileRef p0_mat_ref(const float* src, int ldsrc, int K, int N, void* dst, int which, int it) {
    const int nblk = N / 32, kb = it / nblk, nb = it - kb * nblk, k0 = 128 * kb, n0 = 32 * nb;
    const int drow = MODE == 0 ? n0 : ((n0 >> 7) * 256 + which * 128 + (n0 & 127));
    TileRef t; t.src = src + (size_t)k0 * ldsrc + n0; t.ld_src = ldsrc; t.f8 = F8; t.ld_dst = K;
    t.dst = F8 ? (void*)((unsigned char*)dst + (size_t)drow * K + k0) : (void*)((bf16_t*)dst + (size_t)drow * K + k0); return t;
}
__device__ __forceinline__ void p0_prologue(Frame& F, const __attribute__((address_space(4))) Args& a) {
    unsigned char* ws = F.ws;
    const int gw = F.vcu * NWAVES + F.wave, NGW = F.G * NWAVES;
    {
        LAS float* scr = (LAS float*)(F.lds + F.wave * 16896);
        constexpr int I_EXP = 256;
        constexpr int N_EG = NEXP * I_EXP, N_EU = N_EG, N_ED = N_EG;
        constexpr int I_IN = 16 * 128, I_OUT = 16 * 64, I_GLU = 8 * 32, I_R = 16 * 2, I_SG = 16 * 16, I_SU = 16 * 16, I_SD = 4 * 64;
        constexpr int NITEMS = N_EG + N_EU + N_ED + I_IN + I_OUT + I_GLU + I_R + I_SG + I_SU + I_SD;
        unsigned char* Wegu = ws + WS_WEGU; unsigned char* Wed = ws + WS_WED;
#define P0_REF(T, it_) do { int r = (it_); \
            if (r < N_EG) { const int e = r / I_EXP; T = p0_mat_ref<1, 1>(a.in[21] + (size_t)e * 2048 * 512, 512, 2048, 512, Wegu + (size_t)e * 1024 * 2048, 0, r % I_EXP); break; } r -= N_EG; \
            if (r < N_EU) { const int e = r / I_EXP; T = p0_mat_ref<1, 1>(a.in[22] + (size_t)e * 2048 * 512, 512, 2048, 512, Wegu + (size_t)e * 1024 * 2048, 1, r % I_EXP); break; } r -= N_EU; \
            if (r < N_ED) { const int e = r / I_EXP; T = p0_mat_ref<0, 1>(a.in[23] + (size_t)e * 512 * 2048, 2048, 512, 2048, Wed + (size_t)e * 2048 * 512, 0, r % I_EXP); break; } r -= N_ED; \
            if (r < I_IN) { T = p0_mat_ref<0, 0>(a.in[4], 4104, 2048, 4096, (bf16_t*)(ws + WS_WIN), 0, r); break; } r -= I_IN; \
            if (r < I_OUT) { T = p0_mat_ref<0, 0>(a.in[16], 2048, 2048, 2048, (bf16_t*)(ws + WS_WOUT), 0, r); break; } r -= I_OUT; \
            if (r < I_GLU) { T = p0_mat_ref<0, 0>(a.in[14], 1024, 1024, 1024, (bf16_t*)(ws + WS_WGLU), 0, r); break; } r -= I_GLU; \
            if (r < I_R) { T = p0_mat_ref<0, 0>(a.in[19], 64, 2048, 64, (bf16_t*)(ws + WS_WR), 0, r); break; } r -= I_R; \
            if (r < I_SG) { T = p0_mat_ref<1, 1>(a.in[24], 512, 2048, 512, (ws + WS_WSGU), 0, r); break; } r -= I_SG; \
            if (r < I_SU) { T = p0_mat_ref<1, 1>(a.in[25], 512, 2048, 512, (ws + WS_WSGU), 1, r); break; } r -= I_SU; \
            T = p0_mat_ref<0, 1>(a.in[26], 2048, 512, 2048, (ws + WS_WSD), 0, r); } while (0)
        int it = gw;
        if (it < NITEMS) {
            TileRef tc, tn; f32x4 vc[16], vn[16];
            P0_REF(tc, it); p0_tile_load(tc, vc, F.lane);
            for (;;) {
                const int itn = it + NGW; const bool more = itn < NITEMS;
                if (more) { P0_REF(tn, itn); p0_tile_load(tn, vn, F.lane); }
                p0_tile_store(tc, vc, scr, F.lane);
                if (!more) break;
#pragma unroll
                for (int i = 0; i < 16; ++i) vc[i] = vn[i];
                tc = tn; it = itn;
            }
        }
#undef P0_REF
    }
    __syncthreads();
    if (F.vcu < NGRP) {
        const int g = F.vcu, t = F.tid;
        LAS float* apr = (LAS float*)F.lds;
        LAS float* api = apr + 64 * 33;
        LAS float* bbr = api + 64 * 33;
        LAS float* bbi = bbr + 1024;
        LAS float* cr = bbi + 1024;
        LAS float* ci = cr + 1024;
        LAS float* kg = ci + 1024;
        LAS float* dsk = kg + 8192;
        const float* a_re = a.in[6]; const float* a_im = a.in[7]; const float* log_dt = a.in[8];
        const float* b_re = a.in[9]; const float* b_im = a.in[10]; const float* c_re = a.in[11]; const float* c_im = a.in[12]; const float* dsk_g = a.in[13];
        if (t < 64) { const int p = t; const float ar = a_re[g * 64 + p], ai = a_im[g * 64 + p], dt = expf(log_dt[g]);
            for (int tau = 0; tau <= 32; ++tau) { const float m = expf((float)tau * dt * ar); float s, c; sincosf((float)tau * dt * ai, &s, &c); apr[p * 33 + tau] = m * c; api[p * 33 + tau] = m * s; }
            const float abr = apr[p * 33 + 1] - 1.f, abi = api[p * 33 + 1], den = ar * ar + ai * ai;
            const float cre = (abr * ar + abi * ai) / den, cim = (abi * ar - abr * ai) / den;
            for (int h = 0; h < 16; ++h) { const float br = b_re[(g * 64 + p) * 16 + h], bi = b_im[(g * 64 + p) * 16 + h]; bbr[p * 16 + h] = cre * br - cim * bi; bbi[p * 16 + h] = cre * bi + cim * br; } }
        for (int idx = t; idx < 1024; idx += 512) { cr[idx] = c_re[g * 1024 + idx]; ci[idx] = c_im[g * 1024 + idx]; }
        if (t < 16) dsk[t] = dsk_g[g * 16 + t];
        __syncthreads();
        for (int idx = t; idx < 8192; idx += 512) { const int tau = idx >> 8, hp = (idx >> 4) & 15, h = idx & 15; float acc = 0.f;
            for (int p = 0; p < 64; ++p) { const float c_r = cr[hp * 64 + p], c_i = ci[hp * 64 + p], pr = apr[p * 33 + tau], pi = api[p * 33 + tau];
                const float gr = c_r * pr - c_i * pi, gi = c_r * pi + c_i * pr; acc += gr * bbr[p * 16 + h] - gi * bbi[p * 16 + h]; }
            if (tau == 0 && hp == h) acc += dsk[h];
            kg[idx] = acc; }
        __syncthreads();
        bf16_t* OPY = (bf16_t*)(ws + WS_OPY) + (size_t)g * 512 * UGK;
        for (int it = t; it < 512 * 80; it += 512) { const int n = it / 80, ch = it - n * 80, tt = n >> 4, hp = n & 15; float v[8];
            if (ch < 64) { const int j = ch >> 1, h0 = (ch & 1) * 8;
#pragma unroll
                for (int e = 0; e < 8; ++e) v[e] = (tt >= j) ? kg[(tt - j) * 256 + hp * 16 + h0 + e] : 0.f; }
            else { const int q = ch - 64;
#pragma unroll
                for (int e2 = 0; e2 < 4; ++e2) { const int p = q * 4 + e2; const float c_r = cr[hp * 64 + p], c_i = ci[hp * 64 + p], pr = apr[p * 33 + tt + 1], pi = api[p * 33 + tt + 1];
                    v[2 * e2] = c_r * pr - c_i * pi; v[2 * e2 + 1] = -(c_r * pi + c_i * pr); } }
            u32x4 w; w.x = cvt_pk_bf16(v[0], v[1]); w.y = cvt_pk_bf16(v[2], v[3]); w.z = cvt_pk_bf16(v[4], v[5]); w.w = cvt_pk_bf16(v[6], v[7]);
            *(u32x4*)(OPY + (size_t)n * UGK + ch * 8) = w; }
        bf16_t* OPE = (bf16_t*)(ws + WS_OPE) + (size_t)g * 256 * 512;
        for (int it = t; it < 256 * 64; it += 512) { const int n = it >> 6, ch = it & 63; float v[8];
            if (n < 128) { const int p = n >> 1, ri = n & 1, j = ch >> 1, h0 = (ch & 1) * 8; const float pr = apr[p * 33 + 31 - j], pi = api[p * 33 + 31 - j];
#pragma unroll
                for (int e = 0; e < 8; ++e) { const float br = bbr[p * 16 + h0 + e], bi = bbi[p * 16 + h0 + e]; v[e] = ri == 0 ? (pr * br - pi * bi) : (pr * bi + pi * br); } }
            else {
#pragma unroll
                for (int e = 0; e < 8; ++e) v[e] = 0.f; }
            u32x4 w; w.x = cvt_pk_bf16(v[0], v[1]); w.y = cvt_pk_bf16(v[2], v[3]); w.z = cvt_pk_bf16(v[4], v[5]); w.w = cvt_pk_bf16(v[6], v[7]);
            *(u32x4*)(OPE + (size_t)n * 512 + ch * 8) = w; }
    }
    __syncthreads();
    {
        const int gt = F.vcu * 512 + F.tid, NGT = F.G * 512; const u32x4 z4 = {0u, 0u, 0u, 0u};
        for (int i = gt; i < 2 * 2 * 48 * 128; i += NGT) { const int ch = i & 127, r = (i >> 7) % 48, b = ((i >> 7) / 48) & 1, kv = (i >> 7) / 96;
            bf16_t* base = (bf16_t*)(ws + (kv ? WS_V : WS_K)); *(u32x4*)(base + ((size_t)b * KVR + r) * 1024 + ch * 8) = z4; }
        for (int i = gt; i < 128 * 32; i += NGT) { const int ch = i & 31, gb = i >> 5;
            *(u32x4*)((bf16_t*)(ws + WS_UG) + ((size_t)gb * NCHK + 1) * UGK + ch * 8) = z4; }
        for (int i = gt; i < 16 * 48; i += NGT) { const int r = i % 48, bh = i / 48; ((float*)(ws + WS_LOGF))[(size_t)bh * KVR + r] = 0.f; }
    }
    {
        LAS float* wf = (LAS float*)F.lds;
        for (int i = F.tid; i < 8 * 2048; i += 512) { const int h = i & 7, k = i >> 3; wf[h * 2048 + k] = a.in[4][(size_t)k * 4104 + 4096 + h]; }
        __syncthreads();
        const float* x = a.in[0]; const float* meta = a.in[1]; const float* lg = a.in[2]; const float* lb = a.in[3]; const float* bfg = a.in[5];
        bf16_t* XN = (bf16_t*)(ws + WS_XN); float* logf_ = (float*)(ws + WS_LOGF);
        for (int row = gw; row < MX + NMETA; row += NGW) {
            const float* src = row < MX ? x + (size_t)row * DM : meta + (size_t)(row - MX) * DM;
            f32x4 v[8]; float s = 0.f;
#pragma unroll
            for (int j = 0; j < 8; ++j) { v[j] = ((const f32x4*)src)[j * 64 + F.lane]; s += (v[j][0] + v[j][1]) + (v[j][2] + v[j][3]); }
            const float mean = wave_sum(s) * (1.f / DM); float s2 = 0.f;
#pragma unroll
            for (int j = 0; j < 8; ++j) { v[j] = v[j] - mean; s2 += (v[j][0] * v[j][0] + v[j][1] * v[j][1]) + (v[j][2] * v[j][2] + v[j][3] * v[j][3]); }
            const float rstd = 1.f / sqrtf(wave_sum(s2) * (1.f / DM) + LN_EPS);
            float fl[8];
#pragma unroll
            for (int h = 0; h < 8; ++h) fl[h] = 0.f;
#pragma unroll
            for (int j = 0; j < 8; ++j) { const f32x4 g4 = ((const f32x4*)lg)[j * 64 + F.lane], b4 = ((const f32x4*)lb)[j * 64 + F.lane];
                v[j] = v[j] * rstd * g4 + b4;
                *(u32x2*)(XN + (size_t)row * DM + j * 256 + F.lane * 4) = (u32x2){cvt_pk_bf16(v[j][0], v[j][1]), cvt_pk_bf16(v[j][2], v[j][3])};
#pragma unroll
                for (int h = 0; h < 8; ++h) { const f32x4 w4 = *(const LAS f32x4*)(wf + h * 2048 + j * 256 + F.lane * 4); fl[h] += (v[j][0] * w4[0] + v[j][1] * w4[1]) + (v[j][2] * w4[2] + v[j][3] * w4[3]); } }
#pragma unroll
            for (int h = 0; h < 8; ++h) fl[h] = wave_sum(fl[h]);
            if (F.lane < 8) { const int h = F.lane;
                float val = h == 0 ? fl[0] : h == 1 ? fl[1] : h == 2 ? fl[2] : h == 3 ? fl[3] : h == 4 ? fl[4] : h == 5 ? fl[5] : h == 6 ? fl[6] : fl[7];
                val += bfg[h];
                const float lf = fminf(val, 0.f) - log1pf(expf(-fabsf(val)));
                if (row < MX) { const int b = row >> 13, sx = row & (SEQ - 1); logf_[(size_t)(b * 8 + h) * KVR + 64 + sx] = lf; }
                else { const int i = row - MX; logf_[(size_t)(0 * 8 + h) * KVR + 48 + i] = lf; logf_[(size_t)(1 * 8 + h) * KVR + 48 + i] = lf; } }
        }
    }
    {
        __syncthreads();
        LAS float* hm = (LAS float*)F.lds;
        const float* meta = a.in[1]; const float* lg = a.in[2]; const float* lb = a.in[3]; const float* w_in = a.in[4];
#pragma unroll 1
        for (int rr = 0; rr < 2; ++rr) { const int row = F.wave * 2 + rr; const float* src = meta + (size_t)row * DM;
            f32x4 v[8]; float s = 0.f;
#pragma unroll
            for (int j = 0; j < 8; ++j) { v[j] = ((const f32x4*)src)[j * 64 + F.lane]; s += (v[j][0] + v[j][1]) + (v[j][2] + v[j][3]); }
            const float mean = wave_sum(s) * (1.f / DM); float s2 = 0.f;
#pragma unroll
            for (int j = 0; j < 8; ++j) { v[j] = v[j] - mean; s2 += (v[j][0] * v[j][0] + v[j][1] * v[j][1]) + (v[j][2] * v[j][2] + v[j][3] * v[j][3]); }
            const float rstd = 1.f / sqrtf(wave_sum(s2) * (1.f / DM) + LN_EPS);
#pragma unroll
            for (int j = 0; j < 8; ++j) { const f32x4 g4 = ((const f32x4*)lg)[j * 64 + F.lane], b4 = ((const f32x4*)lb)[j * 64 + F.lane];
                *(LAS f32x4*)(hm + row * 2048 + j * 256 + F.lane * 4) = v[j] * rstd * g4 + b4; } }
        __syncthreads();
        for (int c = F.vcu; c < 256; c += F.G) {
            const int col0 = 16 * c, sect = col0 >> 10; if (sect == 1) continue;
            const int r = F.tid >> 5, ks = F.tid & 31;
            f32x4 a0 = {0.f, 0.f, 0.f, 0.f}, a1 = a0, a2 = a0, a3 = a0;
#pragma unroll 4
            for (int i = 0; i < 64; ++i) { const int k = ks + 32 * i; const float h = hm[r * 2048 + k]; const f32x4* wp = (const f32x4*)(w_in + (size_t)k * 4104 + col0);
                a0 += h * wp[0]; a1 += h * wp[1]; a2 += h * wp[2]; a3 += h * wp[3]; }
#pragma unroll
            for (int o = 1; o < 32; o <<= 1) {
#pragma unroll
                for (int e = 0; e < 4; ++e) { a0[e] += __shfl_xor(a0[e], o); a1[e] += __shfl_xor(a1[e], o); a2[e] += __shfl_xor(a2[e], o); a3[e] += __shfl_xor(a3[e], o); } }
            if (ks == 0) { const int colsec = col0 & 1023;
                const u32x4 w0 = {cvt_pk_bf16(a0[0], a0[1]), cvt_pk_bf16(a0[2], a0[3]), cvt_pk_bf16(a1[0], a1[1]), cvt_pk_bf16(a1[2], a1[3])};
                const u32x4 w1 = {cvt_pk_bf16(a2[0], a2[1]), cvt_pk_bf16(a2[2], a2[3]), cvt_pk_bf16(a3[0], a3[1]), cvt_pk_bf16(a3[2], a3[3])};
#pragma unroll
                for (int b = 0; b < 2; ++b) { bf16_t* dst;
                    if (sect == 0) dst = (bf16_t*)(ws + WS_UG) + ((size_t)(((colsec >> 4) * 2 + b) * NCHK + 1)) * UGK + (16 + r) * 16;
                    else dst = (bf16_t*)(ws + (sect == 2 ? WS_K : WS_V)) + ((size_t)b * KVR + 48 + r) * 1024 + colsec;
                    *(u32x4*)dst = w0; *(u32x4*)(dst + 8) = w1; } }
        }
    }
}

__device__ __forceinline__ void p1_cumsum(Frame& F, int seq) {
    const float* lf = (const float*)(F.ws + WS_LOGF) + (size_t)seq * KVR; float* cum = (float*)(F.ws + WS_CUM) + (size_t)seq * KVR;
    LAS float* part = (LAS float*)F.lds;
    constexpr int PER = 17; const int i0 = F.tid * PER; float s = 0.f;
    for (int k = 0; k < PER; ++k) { const int i = i0 + k; if (i < KVR) s += lf[i]; }
    part[F.tid] = s; __syncthreads();
    float pre = 0.f; for (int j = 0; j < F.tid; ++j) pre += part[j];
    for (int k = 0; k < PER; ++k) { const int i = i0 + k; if (i < KVR) { pre += lf[i]; cum[i] = (i < 48) ? -__builtin_inff() : -pre * LOG2E; } }
    __syncthreads();
}

__device__ __forceinline__ void moe_tables(Frame& F) {
    LAS int* tb = (LAS int*)(F.lds + TB_OFF);
    if (F.tid < NEXP) tb[130 + F.tid] = (int)__hip_atomic_load(F.ctl + CW_CNT + 64 * F.tid, RLX_AGENT);
    __syncthreads();
    if (F.tid == 0) { int tp = 0, cp = 0; for (int e = 0; e < NEXP; ++e) { tb[e] = tp; tb[65 + e] = cp; const int c = tb[130 + e]; tp += (c + 255) >> 8; cp += c; } tb[64] = tp; tb[129] = cp; }
    __syncthreads();
}

template <unsigned MASK>
__global__ void __launch_bounds__(NWAVES * 64, 2) hymba_fwd(Args args_) {
    extern __shared__ __attribute__((aligned(16))) unsigned char lds[];
    (void)args_;
    const __attribute__((address_space(4))) Args& args = *(const __attribute__((address_space(4))) Args*)__builtin_amdgcn_kernarg_segment_ptr();
    Frame F;
    F.lds = (LAS unsigned char*)lds;
    F.MISC = (volatile LAS unsigned*)(F.lds + MISC_OFF);
    F.tid = threadIdx.x; F.lane = F.tid & 63; F.wave = __builtin_amdgcn_readfirstlane(F.tid >> 6);
    F.G = gridDim.x; { const int bx = blockIdx.x; F.vcu = (F.G % 8 == 0) ? (bx % 8) * (F.G / 8) + bx / 8 : bx; }
    unsigned char* ws = args.ws; F.ws = ws;
    F.ctl = (gu32*)(ws + WS_CTL);
    for (int u = F.tid; u < (LDS_BYTES - LDSCTL_OFF) / 4; u += NWAVES * 64) ((LAS unsigned*)(F.lds + LDSCTL_OFF))[u] = 0u;
    __syncthreads();
    XcdBarrier bar; bar.bar = (unsigned*)(F.ctl + CW_BAR); bar.x = 0; bar.st = nullptr;
    if (N_LAUNCHES == 1) bar = xcd_barrier_post((unsigned*)(F.ctl + CW_BAR), F.MISC + 8);
#define GRID_BAR() do { if (N_LAUNCHES == 1) xcd_barrier(bar); } while (0)
    const int lo = args.ph_lo, hi = args.ph_hi;
#define IN(k) (((MASK >> (k)) & 1u) && lo <= (k) && (k) < hi)
#define BOTH(k) (IN(k) && IN((k) + 1))
#ifndef REP_PH
#define REP_PH -1
#endif
#define REPS(k) for (int rep_ = 0; rep_ < ((REP_PH) == (k) ? 2 : 1); ++rep_)
    const int gw = F.vcu * NWAVES + F.wave, NGW = F.G * NWAVES;
    const int bx = (int)blockIdx.x;

    if (IN(0)) { REPS(0) { p0_prologue(F, args); __syncthreads(); } if (BOTH(0)) GRID_BAR(); }

    if (IN(1)) {
        if (F.vcu < 16) p1_cumsum(F, F.vcu);
        pg8::DenseOrder S; S.init(ws + WS_XN, ws + WS_WIN, DM, DM, MX, 4096, F.G, bx);
        pg8::EpiInProj E{(bf16_t*)(ws + WS_UG), (bf16_t*)(ws + WS_Q), (bf16_t*)(ws + WS_K), (bf16_t*)(ws + WS_V)};
        REPS(1) pg8::gemm_phase<pg8::EpiInProj, pg8::DenseOrder, true>(F.lds, pg8::GemmK{DM, DM, DM}, S, E);
        if (BOTH(1)) GRID_BAR();
    }

    if (IN(2)) {
        REPS(2)
        for (int L = bx; L < 256; L += F.G) {
            const int g = L >> 2, b = (L >> 1) & 1, pn = L & 1, gb = g * 2 + b;
            { pg8::OneUnit S; S.u.A = (const char*)(ws + WS_UG) + ((size_t)(gb * NCHK + 1)) * UGK * 2; S.u.B = (const char*)(ws + WS_OPE) + (size_t)g * 256 * 512 * 2; S.u.rows = nullptr;
              S.u.r0 = gb * 256; S.u.c0 = 0; S.u.valid = 256; S.u.aux = g; S.rowbytes = UGK * 2;
              pg8::EpiE E{(float*)(ws + WS_E)};
              pg8::gemm_phase<pg8::EpiE, pg8::OneUnit, false>(F.lds, pg8::GemmK{512, UGK, 512}, S, E); }
            VM_WAIT(); __syncthreads();
            if (F.wave == 0) {
                __builtin_amdgcn_fence(__ATOMIC_ACQUIRE, "agent");
                const int p = F.lane;
                const float dt = expf(args.in[8][g]), ar = args.in[6][g * 64 + p], ai = args.in[7][g * 64 + p];
                const float mag = expf(32.f * dt * ar); float sn, cs; sincosf(32.f * dt * ai, &sn, &cs);
                const float a_r = mag * cs, a_i = mag * sn;
                const float* Eb = (const float*)(ws + WS_E) + (size_t)gb * 256 * 128 + 2 * p;
                bf16_t* Ub = (bf16_t*)(ws + WS_UG) + (size_t)gb * NCHK * UGK + 512 + 2 * p;
                float sr = 0.f, si = 0.f;
#pragma unroll 8
                for (int r = 0; r < 256; ++r) { const f32x2 e = *(const f32x2*)(Eb + (size_t)r * 128);
                    const float nr = a_r * sr - a_i * si + e[0], ni = a_r * si + a_i * sr + e[1]; sr = nr; si = ni;
                    *(unsigned*)(Ub + (size_t)(r + 2) * UGK) = cvt_pk_bf16(sr, si); }
            } else {
                const bf16_t* Qb = (const bf16_t*)(ws + WS_Q); const bf16_t* Kb = (const bf16_t*)(ws + WS_K);
                for (int it = (L * 7 + F.wave - 1); it < 1024 + 1032; it += 256 * 7) {
                    const bool isq = it < 1024; const int row0 = (isq ? it : it - 1024) * 16;
                    const bf16_t* base = (isq ? Qb : Kb) + (size_t)row0 * 1024 + F.lane * 8;
                    float mx0 = 0.f, mx1 = 0.f;
#pragma unroll 4
                    for (int r = 0; r < 16; ++r) {
#pragma unroll
                        for (int half = 0; half < 2; ++half) { const u32x4 w = *(const u32x4*)(base + (size_t)r * 1024 + half * 512);
                            float ss = bf_lo(w.x) * bf_lo(w.x) + bf_hi(w.x) * bf_hi(w.x) + bf_lo(w.y) * bf_lo(w.y) + bf_hi(w.y) * bf_hi(w.y) + bf_lo(w.z) * bf_lo(w.z) + bf_hi(w.z) * bf_hi(w.z) + bf_lo(w.w) * bf_lo(w.w) + bf_hi(w.w) * bf_hi(w.w);
                            ss += __shfl_xor(ss, 1); ss += __shfl_xor(ss, 2); ss += __shfl_xor(ss, 4); ss += __shfl_xor(ss, 8);
                            if (half == 0) mx0 = fmaxf(mx0, ss); else mx1 = fmaxf(mx1, ss); } }
                    if ((F.lane & 15) == 0) { const int g4 = F.lane >> 4;
                        if (isq) { const int bb = row0 >> 13, qb = (row0 & (SEQ - 1)) >> 8;
                            __hip_atomic_fetch_max(F.ctl + CW_QMAX + ((bb * 8 + g4) * 32 + qb), __float_as_uint(mx0), RLX_AGENT);
                            __hip_atomic_fetch_max(F.ctl + CW_QMAX + ((bb * 8 + 4 + g4) * 32 + qb), __float_as_uint(mx1), RLX_AGENT); }
                        else { const int bb = row0 / KVR;
                            __hip_atomic_fetch_max(F.ctl + CW_KMAX + (bb * 8 + g4), __float_as_uint(mx0), RLX_AGENT);
                            __hip_atomic_fetch_max(F.ctl + CW_KMAX + (bb * 8 + 4 + g4), __float_as_uint(mx1), RLX_AGENT); } }
                }
            }
            VM_WAIT(); __syncthreads();
            if (F.tid == 0) { __builtin_amdgcn_fence(__ATOMIC_ACQUIRE, "agent"); VM_WAIT(); }
            __syncthreads();
            { pg8::OneUnit S; S.u.A = (const char*)(ws + WS_UG) + ((size_t)(gb * NCHK + 2)) * UGK * 2; S.u.B = (const char*)(ws + WS_OPY) + ((size_t)g * 512 + pn * 256) * UGK * 2; S.u.rows = nullptr;
              S.u.r0 = b; S.u.c0 = pn; S.u.valid = 256; S.u.aux = g; S.rowbytes = UGK * 2;
              pg8::EpiY E{(bf16_t*)(ws + WS_YB)};
              pg8::gemm_phase<pg8::EpiY, pg8::OneUnit, false>(F.lds, pg8::GemmK{UGK, UGK, UGK}, S, E); }
        }
        if (BOTH(2)) GRID_BAR();
    }

    if (IN(5)) {
        pg8::DenseOrder S; S.init(ws + WS_YB, ws + WS_WGLU, 1024, 1024, MX, 1024, F.G, bx);
        pg8::EpiGlu E{(const bf16_t*)(ws + WS_YB), args.in[15], (bf16_t*)(ws + WS_YC)};
        REPS(5) pg8::gemm_phase<pg8::EpiGlu, pg8::DenseOrder, true>(F.lds, pg8::GemmK{1024, 1024, 1024}, S, E);
    }

    if (IN(6)) {
        const bf16_t* Qb = (const bf16_t*)(ws + WS_Q); const bf16_t* Kb = (const bf16_t*)(ws + WS_K); const bf16_t* Vb = (const bf16_t*)(ws + WS_V);
        bf16_t* YC = (bf16_t*)(ws + WS_YC); const float* nck = (const float*)(ws + WS_CUM);
        LAS char* al = (LAS char*)F.lds;
        LAS unsigned* skey = (LAS unsigned*)(F.lds + 71680);
        att::Seam S;
#define MKREF(R, key_) do { const int id_ = (int)((key_) & 511u), bh_ = id_ >> 5, qb_ = id_ & 31, b_ = bh_ >> 3, h_ = bh_ & 7; (R).Q = Qb + ((size_t)b_ * SEQ + (size_t)qb_ * 256) * 1024 + h_ * 128; \
        (R).K = Kb + (size_t)b_ * KVR * 1024 + h_ * 128; (R).V = Vb + (size_t)b_ * KVR * 1024 + h_ * 128; (R).O = YC + ((size_t)b_ * SEQ + (size_t)qb_ * 256) * 2048 + 1024 + h_ * 128; \
        (R).nck = nck + (size_t)bh_ * KVR; (R).P0 = 64 + qb_ * 256; (R).j_lo = (int)(((key_) >> 10) & 1023u); } while (0)
        REPS(6) {
        { const int id = F.tid, bh = id >> 5, qb = id & 31, P0 = 64 + qb * 256; const float* nk = nck + (size_t)bh * KVR;
          const float q2 = __uint_as_float(__hip_atomic_load(F.ctl + CW_QMAX + id, RLX_AGENT)), k2 = __uint_as_float(__hip_atomic_load(F.ctl + CW_KMAX + bh, RLX_AGENT));
          const float thr = nk[P0] - T_SKIP - 2.f * sqrtf(q2 * k2) * 1.001f;
          int lo_ = 0, hi_ = 4 * qb + 1;
          while (lo_ < hi_) { const int mid = (lo_ + hi_) >> 1; if (nk[64 * mid + 63] < thr) lo_ = mid + 1; else hi_ = mid; }
          skey[id] = ((unsigned)(4 * qb + 5 - lo_) << 20) | ((unsigned)lo_ << 10) | (unsigned)id; }
        for (int k = 2; k <= 512; k <<= 1)
            for (int j = k >> 1; j > 0; j >>= 1) { __syncthreads(); const int ixj = F.tid ^ j;
                if (ixj > F.tid) { const unsigned a = skey[F.tid], b = skey[ixj]; const bool up = (F.tid & k) == 0;
                    if (up ? (a < b) : (a > b)) { skey[F.tid] = b; skey[ixj] = a; } } }
        __syncthreads();
        int pi = F.vcu;
        if (pi < 256) {
            int pass = 0; att::BlockRef cur, nxt;
            { const unsigned key = skey[511 - pi]; MKREF(cur, key); }
            att::fox_prime(cur, al, S);
            for (;;) {
                const bool more_pass = pass == 0, more_item = pi + F.G < 256, last = !more_pass && !more_item;
                int pin = pi, passn = pass + 1;
                if (!more_pass) { passn = 0; pin = more_item ? pi + F.G : pi; }
                if (last) nxt = cur; else { const unsigned key = skey[passn ? pin : 511 - pin]; MKREF(nxt, key); }
                att::fox_block(cur, nxt, KVR, al, S);
                if (last) break;
                cur = nxt; pass = passn; pi = pin;
            }
        }
        __syncthreads();
        }
#undef MKREF
        if (BOTH(6)) GRID_BAR();
    }

    if (IN(7)) {
        pg8::DenseOrder S; S.init(ws + WS_YC, ws + WS_WOUT, 2048, 2048, MX, 2048, F.G, bx);
        pg8::EpiOut E{(const bf16_t*)(ws + WS_XN), (float*)(ws + WS_Z), (float*)(ws + WS_ST)};
        REPS(7) pg8::gemm_phase<pg8::EpiOut, pg8::DenseOrder, true>(F.lds, pg8::GemmK{2048, 2048, 2048}, S, E);
        if (BOTH(7)) GRID_BAR();
    }

    if (IN(8)) {
        const float* Z = (const float*)(ws + WS_Z); const float* ST = (const float*)(ws + WS_ST); bf16_t* H1 = (bf16_t*)(ws + WS_XN); unsigned char* H1F8 = ws + WS_H1F8;
        const bf16_t* WR = (const bf16_t*)(ws + WS_WR); const float* lg_ = args.in[17]; const float* lb_ = args.in[18]; const float* rbias = args.in[20];
        int* IDX = (int*)(ws + WS_IDX); float* GWt = (float*)(ws + WS_GW); int* RK = (int*)(ws + WS_RK); int* TOK = (int*)(ws + WS_TOK);
        LAS float* lgs = (LAS float*)(F.lds + F.wave * 4352);
        const int r16 = F.lane & 15, kq = F.lane >> 4;
        const float my_bias = rbias[F.lane];
        for (int rb = gw; rb < MX / 16; rb += NGW) {
            const int row = rb * 16 + r16;
            float s = 0.f, q = 0.f;
#pragma unroll
            for (int i = 0; i < 4; ++i) { const f32x4 t4 = *(const f32x4*)(ST + (size_t)row * 64 + kq * 16 + i * 4); s += t4[0] + t4[2]; q += t4[1] + t4[3]; }
            s += __shfl_xor(s, 16); s += __shfl_xor(s, 32); q += __shfl_xor(q, 16); q += __shfl_xor(q, 32);
            const float mean = s * (1.f / DM), var = fmaxf(q * (1.f / DM) - mean * mean, 0.f), rstd = 1.f / sqrtf(var + LN_EPS);
            f32x4 acc[4];
#pragma unroll
            for (int nb = 0; nb < 4; ++nb) acc[nb] = (f32x4){0.f, 0.f, 0.f, 0.f};
#pragma unroll 2
            for (int ks = 0; ks < 64; ++ks) { const int k0 = ks * 32 + kq * 8;
                const f32x4 z0 = *(const f32x4*)(Z + (size_t)row * DM + k0), z1 = *(const f32x4*)(Z + (size_t)row * DM + k0 + 4);
                const f32x4 g0 = *(const f32x4*)(lg_ + k0), g1 = *(const f32x4*)(lg_ + k0 + 4), b0 = *(const f32x4*)(lb_ + k0), b1 = *(const f32x4*)(lb_ + k0 + 4);
                const f32x4 y0 = (z0 - mean) * rstd * g0 + b0, y1 = (z1 - mean) * rstd * g1 + b1;
                const u32x4 w = pg8::pack8(y0, y1);
                *(u32x4*)(H1 + (size_t)row * DM + k0) = w;
                *(u32x2*)(H1F8 + (size_t)row * DM + k0) = pg8::pack8_fp8(y0, y1);
                const bf16x8 af = __builtin_bit_cast(bf16x8, w);
#pragma unroll
                for (int nb = 0; nb < 4; ++nb) { const bf16x8 bfm = *(const bf16x8*)(WR + (size_t)(nb * 16 + r16) * DM + k0);
                    acc[nb] = __builtin_amdgcn_mfma_f32_16x16x32_bf16(af, bfm, acc[nb], 0, 0, 0); } }
#pragma unroll
            for (int nb = 0; nb < 4; ++nb)
#pragma unroll
                for (int rg = 0; rg < 4; ++rg) lgs[(kq * 4 + rg) * 65 + nb * 16 + r16] = acc[nb][rg];
            LDS_WAIT(); asm volatile("" ::: "memory");
            for (int r = 0; r < 16; ++r) {
                const int trow = rb * 16 + r;
                const float score = fast_sigmoid(lgs[r * 65 + F.lane]);
                const float sel = score + my_bias;
                float m1 = sel; m1 = fmaxf(m1, __shfl_xor(m1, 1)); m1 = fmaxf(m1, __shfl_xor(m1, 2)); m1 = fmaxf(m1, __shfl_xor(m1, 4));
                int i1 = (sel == m1) ? F.lane : 1000; i1 = min(i1, __shfl_xor(i1, 1)); i1 = min(i1, __shfl_xor(i1, 2)); i1 = min(i1, __shfl_xor(i1, 4));
                float m2 = (F.lane == i1) ? -__builtin_inff() : sel; m2 = fmaxf(m2, __shfl_xor(m2, 1)); m2 = fmaxf(m2, __shfl_xor(m2, 2)); m2 = fmaxf(m2, __shfl_xor(m2, 4));
                const float gs = m1 + m2; const int mygrp = F.lane >> 3;
                int gcount = 0;
#pragma unroll
                for (int j = 0; j < 8; ++j) { const float gj = __shfl(gs, 8 * j); gcount += (gj > gs || (gj == gs && j < mygrp)) ? 1 : 0; }
                const bool cand = gcount < 4;
                const float cs = cand ? sel : -__builtin_inff();
                int rank = 0;
#pragma unroll 8
                for (int j = 0; j < 64; ++j) { const float cj = __shfl(cs, j); rank += (cj > cs || (cj == cs && j < F.lane)) ? 1 : 0; }
                const bool chosen = cand && rank < TOPK;
                const float tot = wave_sum(chosen ? score : 0.f);
                if (chosen) { const float gate = score / tot * ROUTED_SCALE;
                    const unsigned pos = __hip_atomic_fetch_add(F.ctl + CW_CNT + 64 * F.lane, 1u, RLX_AGENT);
                    TOK[(size_t)F.lane * MX + pos] = trow;
                    IDX[(size_t)trow * 8 + rank] = F.lane; GWt[(size_t)trow * 8 + rank] = gate; RK[(size_t)trow * 8 + rank] = (int)pos; }
            }
            LDS_WAIT(); asm volatile("" ::: "memory");
        }
        if (BOTH(8)) GRID_BAR();
    }

    if (IN(9)) {
        moe_tables(F);
        const LAS int* tb = (const LAS int*)(F.lds + TB_OFF);
        pg8::MoeOrder S; S.tb = tb; S.TT = tb[64]; S.NCT = 4; S.nsh = 64 * 4; S.nwg = S.TT * 4 + S.nsh; S.G = F.G; S.c = bx; S.lda = DM; S.ldb = DM;
        S.Aexp = (const char*)(ws + WS_H1F8); S.tok = (const int*)(ws + WS_TOK); S.Bexp = (const char*)(ws + WS_WEGU); S.bstride = (size_t)1024 * 2048;
        S.Ash = (const char*)(ws + WS_H1F8); S.Bsh = (const char*)(ws + WS_WSGU); S.gather = true;
        pg8::EpiGU E{ws + WS_HID, ws + WS_HIDS};
        REPS(9) pg8::gemm_phase<pg8::EpiGU, pg8::MoeOrder, true, true>(F.lds, pg8::GemmK{DM, DM, DM}, S, E);
        if (BOTH(9)) GRID_BAR();
    }

    if (IN(10)) {
        moe_tables(F);
        const LAS int* tb = (const LAS int*)(F.lds + TB_OFF);
        pg8::MoeOrder S; S.tb = tb; S.TT = tb[64]; S.NCT = 8; S.nsh = 64 * 8; S.nwg = S.TT * 8 + S.nsh; S.G = F.G; S.c = bx; S.lda = EFF; S.ldb = EFF;
        S.Aexp = (const char*)(ws + WS_HID); S.tok = nullptr; S.Bexp = (const char*)(ws + WS_WED); S.bstride = (size_t)2048 * 512;
        S.Ash = (const char*)(ws + WS_HIDS); S.Bsh = (const char*)(ws + WS_WSD); S.gather = false;
        pg8::EpiDown E{(bf16_t*)(ws + WS_C), (bf16_t*)(ws + WS_CS)};
        { const int sg = F.vcu & 3;
          if (0 && sg) { const unsigned long long t0 = __builtin_amdgcn_s_memrealtime(); while (__builtin_amdgcn_s_memrealtime() - t0 < (unsigned long long)(sg * 500)) __builtin_amdgcn_s_sleep(8); } }
        REPS(10) pg8::gemm_phase<pg8::EpiDown, pg8::MoeOrder, true, true>(F.lds, pg8::GemmK{EFF, EFF, EFF}, S, E);
        if (BOTH(10)) GRID_BAR();
    }

    if (IN(11)) {
        moe_tables(F);
        const LAS int* tb = (const LAS int*)(F.lds + TB_OFF);
        const bf16_t* H1 = (const bf16_t*)(ws + WS_XN); const bf16_t* CS = (const bf16_t*)(ws + WS_CS); const bf16_t* C = (const bf16_t*)(ws + WS_C);
        const int* IDX = (const int*)(ws + WS_IDX); const float* GWt = (const float*)(ws + WS_GW); const int* RK = (const int*)(ws + WS_RK);
        const float* lg_ = args.in[27]; const float* lb_ = args.in[28]; float* out = args.out;
        REPS(11)
        for (int row = gw; row < MX; row += NGW) {
            const i32x4 e0 = *(const i32x4*)(IDX + (size_t)row * 8), e1 = *(const i32x4*)(IDX + (size_t)row * 8 + 4);
            const i32x4 r0 = *(const i32x4*)(RK + (size_t)row * 8), r1 = *(const i32x4*)(RK + (size_t)row * 8 + 4);
            const f32x4 w0 = *(const f32x4*)(GWt + (size_t)row * 8), w1 = *(const f32x4*)(GWt + (size_t)row * 8 + 4);
            int slot[8]; float wk[8];
            slot[0] = tb[65 + e0[0]] + r0[0]; slot[1] = tb[65 + e0[1]] + r0[1]; slot[2] = tb[65 + e0[2]] + r0[2]; slot[3] = tb[65 + e0[3]] + r0[3];
            slot[4] = tb[65 + e1[0]] + r1[0]; slot[5] = tb[65 + e1[1]] + r1[1]; slot[6] = tb[65 + e1[2]] + r1[2]; slot[7] = tb[65 + e1[3]] + r1[3];
            wk[0] = w0[0]; wk[1] = w0[1]; wk[2] = w0[2]; wk[3] = w0[3]; wk[4] = w1[0]; wk[5] = w1[1]; wk[6] = w1[2]; wk[7] = w1[3];
            float acc[4][8];
#pragma unroll
            for (int j = 0; j < 4; ++j) { int lo_ = (j * 64 + F.lane) * 8; asm volatile("" : "+v"(lo_)); const size_t off = (size_t)row * DM + (size_t)lo_;
                const u32x4 hw = *(const u32x4*)(H1 + off), sw = *(const u32x4*)(CS + off);
                u32x4 cw[8];
#pragma unroll
                for (int k = 0; k < 8; ++k) cw[k] = *(const u32x4*)(C + (size_t)slot[k] * DM + (size_t)lo_);
                acc[j][0] = ALPHA * bf_lo(hw.x) + bf_lo(sw.x); acc[j][1] = ALPHA * bf_hi(hw.x) + bf_hi(sw.x); acc[j][2] = ALPHA * bf_lo(hw.y) + bf_lo(sw.y); acc[j][3] = ALPHA * bf_hi(hw.y) + bf_hi(sw.y);
                acc[j][4] = ALPHA * bf_lo(hw.z) + bf_lo(sw.z); acc[j][5] = ALPHA * bf_hi(hw.z) + bf_hi(sw.z); acc[j][6] = ALPHA * bf_lo(hw.w) + bf_lo(sw.w); acc[j][7] = ALPHA * bf_hi(hw.w) + bf_hi(sw.w);
#pragma unroll
                for (int k = 0; k < 8; ++k) { acc[j][0] += wk[k] * bf_lo(cw[k].x); acc[j][1] += wk[k] * bf_hi(cw[k].x); acc[j][2] += wk[k] * bf_lo(cw[k].y); acc[j][3] += wk[k] * bf_hi(cw[k].y);
                    acc[j][4] += wk[k] * bf_lo(cw[k].z); acc[j][5] += wk[k] * bf_hi(cw[k].z); acc[j][6] += wk[k] * bf_lo(cw[k].w); acc[j][7] += wk[k] * bf_hi(cw[k].w); }
                asm volatile("" ::: "memory"); }
            float s = 0.f;
#pragma unroll
            for (int j = 0; j < 4; ++j)
#pragma unroll
                for (int e = 0; e < 8; ++e) s += acc[j][e];
            const float mean = wave_sum(s) * (1.f / DM); float s2 = 0.f;
#pragma unroll
            for (int j = 0; j < 4; ++j)
#pragma unroll
                for (int e = 0; e < 8; ++e) { acc[j][e] -= mean; s2 += acc[j][e] * acc[j][e]; }
            const float rstd = 1.f / sqrtf(wave_sum(s2) * (1.f / DM) + LN_EPS);
#pragma unroll
            for (int j = 0; j < 4; ++j) { int c0 = (j * 64 + F.lane) * 8; asm volatile("" : "+v"(c0));
                const f32x4 g0 = *(const f32x4*)(lg_ + c0), g1 = *(const f32x4*)(lg_ + c0 + 4), b0 = *(const f32x4*)(lb_ + c0), b1 = *(const f32x4*)(lb_ + c0 + 4);
                f32x4 o0, o1;
#pragma unroll
                for (int e = 0; e < 4; ++e) { o0[e] = acc[j][e] * rstd * g0[e] + b0[e]; o1[e] = acc[j][4 + e] * rstd * g1[e] + b1[e]; }
                *(f32x4*)(out + (size_t)row * DM + c0) = o0; *(f32x4*)(out + (size_t)row * DM + c0 + 4) = o1; }
        }
    }
#undef IN
#undef BOTH
#undef GRID_BAR
}

#ifndef PH_MASK
#define PH_MASK 0xFFFu
#endif
typedef void (*kern_t)(Args);
template <unsigned MASK> static bool prep_kernel(kern_t& k) {
    k = hymba_fwd<MASK>;
    if (hipFuncSetAttribute((const void*)hymba_fwd<MASK>, hipFuncAttributeMaxDynamicSharedMemorySize, LDS_BYTES) != hipSuccess) { fprintf(stderr, "kernel_launch: hipFuncSetAttribute failed (mask %x)\n", MASK); return false; }
    return true;
}
extern "C" void kernel_launch(void* const* d_in, const int* in_sizes, int n_in, void* d_out, int out_size, void* d_ws, size_t ws_size, hipStream_t stream) {
    static int grid = 0; static kern_t kerns[N_PHASES];
    if (grid == 0) {
        if (n_in != 29 || in_sizes[0] != MX * DM || out_size != MX * DM || ws_size < WS_END) {
            fprintf(stderr, "kernel_launch: unexpected shapes (n_in %d, in0 %d, out %d, ws %zu; need ws >= %zu); nothing launched\n", n_in, n_in > 0 ? in_sizes[0] : -1, out_size, ws_size, (size_t)WS_END); grid = -1; return; }
        int dev = 0, cus = 0;
        if (hipGetDevice(&dev) != hipSuccess || hipDeviceGetAttribute(&cus, hipDeviceAttributeMultiprocessorCount, dev) != hipSuccess) { fprintf(stderr, "kernel_launch: device query failed\n"); grid = -1; return; }
        bool ok = true;
        if constexpr (N_LAUNCHES == 1) ok = prep_kernel<PH_MASK>(kerns[0]);
        else { ok = ok && prep_kernel<0x001u>(kerns[0]) && prep_kernel<0x002u>(kerns[1]) && prep_kernel<0x004u>(kerns[2]) && prep_kernel<0x008u>(kerns[3]) && prep_kernel<0x010u>(kerns[4]) && prep_kernel<0x020u>(kerns[5])
                       && prep_kernel<0x040u>(kerns[6]) && prep_kernel<0x080u>(kerns[7]) && prep_kernel<0x100u>(kerns[8]) && prep_kernel<0x200u>(kerns[9]) && prep_kernel<0x400u>(kerns[10]) && prep_kernel<0x800u>(kerns[11]); }
        if (!ok) { grid = -1; return; }
        (void)hipGetLastError();
        grid = cus;
    }
    if (grid < 0) return;
    if (hipMemsetAsync((char*)d_ws + WS_CTL, 0, CTL_ZERO_BYTES, stream) != hipSuccess) { fprintf(stderr, "kernel_launch: memset failed\n"); return; }
    Args a{};
    for (int i = 0; i < 29; ++i) a.in[i] = (const float*)d_in[i];
    a.out = (float*)d_out; a.ws = (unsigned char*)d_ws;
    for (int li = 0; li < N_LAUNCHES; ++li) {
        if (N_LAUNCHES != 1 && !((PH_MASK >> li) & 1u)) continue;
        a.ph_lo = (N_LAUNCHES == 1) ? 0 : li; a.ph_hi = (N_LAUNCHES == 1) ? N_PHASES : li + 1;
        hipLaunchKernelGGL(kerns[li], dim3(grid), dim3(NWAVES * 64), LDS_BYTES, stream, a);
        const hipError_t le = hipPeekAtLastError();
        if (le != hipSuccess) { fprintf(stderr, "kernel_launch: launch %d failed: %s\n", li, hipGetErrorName(le)); break; }
    }
}
```

```cpp
#include <hip/hip_runtime.h>
#include <cstdio>
#include <cstdint>

#ifndef MK_N_LAUNCHES
#define MK_N_LAUNCHES 1
#endif

#define LAS __attribute__((address_space(3)))
#define GAS __attribute__((address_space(1)))
typedef unsigned short bf16_t;
typedef short bf16x8 __attribute__((ext_vector_type(8)));
typedef short s16x4 __attribute__((ext_vector_type(4)));
typedef float f32x2 __attribute__((ext_vector_type(2)));
typedef float f32x4 __attribute__((ext_vector_type(4)));
typedef float f32x16 __attribute__((ext_vector_type(16)));
typedef unsigned u32x2 __attribute__((ext_vector_type(2)));
typedef unsigned u32x4 __attribute__((ext_vector_type(4)));
typedef int i32x4 __attribute__((ext_vector_type(4)));
typedef int i32x8 __attribute__((ext_vector_type(8)));

constexpr int BATCH = 2, SEQ = 8192, DM = 2048, NMETA = 16;
constexpr int MX = BATCH * SEQ;
constexpr int MIN_ROWS = MX + 256;
constexpr int NHEAD = 8, HD = 128, NGRP = 64, NST = 64;
constexpr int KVR = 64 + SEQ;
constexpr int NCHK = KVR / 32;
constexpr int UGK = 640;
constexpr int NEXP = 64, TOPK = 8, EFF = 512;
constexpr float LN_EPS = 1e-5f;
constexpr float ALPHA = 1.189207115002721f;
constexpr float ROUTED_SCALE = 2.5f;
constexpr float LOG2E = 1.4426950408889634f;
constexpr float QSCALE = 0.08838834764831845f * 1.4426950408889634f;
constexpr float W8SCALE = 256.f;
constexpr float H8SCALE = 8.f;
constexpr float C8SCALE = 16.f;

constexpr size_t MiB = 1u << 20;
constexpr size_t WS_CTL = 0, CTL_ZERO_BYTES = 1 * MiB;
constexpr size_t WS_LOGF = 1 * MiB;
constexpr size_t WS_CUM = 2 * MiB;
constexpr size_t WS_IDX = 3 * MiB;
constexpr size_t WS_GW = 3 * MiB + 512 * 1024;
constexpr size_t WS_RK = 4 * MiB;
constexpr size_t WS_WR = 4 * MiB + 512 * 1024;
constexpr size_t WS_TOK = 5 * MiB;
constexpr size_t WS_ST = 9 * MiB;
constexpr size_t WS_XN = 16 * MiB;
constexpr size_t WS_WED = 81 * MiB;
constexpr size_t WS_WSD = 209 * MiB;
constexpr size_t WS_WSGU = 211 * MiB;
constexpr size_t WS_WGLU = 215 * MiB;
constexpr size_t WS_WOUT = 217 * MiB;
constexpr size_t WS_WIN = 225 * MiB;
constexpr size_t WS_HID = 241 * MiB;
constexpr size_t WS_H1F8 = 310 * MiB;
constexpr size_t WS_YC = 241 * MiB;
constexpr size_t WS_YB = 305 * MiB;
constexpr size_t WS_Q = 337 * MiB;
constexpr size_t WS_HIDS = 370 * MiB;
constexpr size_t WS_CS = 386 * MiB;
constexpr size_t WS_C = 450 * MiB;
constexpr size_t WS_WEGU = 450 * MiB;
constexpr size_t WS_Z = 706 * MiB;
constexpr size_t WS_K = 834 * MiB;
constexpr size_t WS_V = 867 * MiB;
constexpr size_t WS_UG = 900 * MiB;
constexpr size_t WS_OPY = 941 * MiB;
constexpr size_t WS_OPE = 981 * MiB;
constexpr size_t WS_E = 997 * MiB;
constexpr size_t WS_END = 1013 * MiB;
static_assert(WS_HID + (size_t)(131072 + 256) * 512 * 2 <= WS_HIDS && WS_Q + (size_t)MX * 1024 * 2 <= WS_HIDS, "map");
static_assert(WS_K + (size_t)2 * KVR * 1024 * 2 <= WS_V && WS_V + (size_t)2 * KVR * 1024 * 2 <= WS_UG, "map");
static_assert(WS_UG + (size_t)64 * 2 * NCHK * UGK * 2 <= WS_OPY && WS_C + (size_t)131072 * 2048 * 2 <= WS_END, "map");
static_assert(WS_XN + (size_t)MIN_ROWS * 2048 * 2 <= WS_WED, "map");
constexpr int CW_TMO = 0, CW_CODE = 1;
constexpr int CW_CNT = 1024;
constexpr int CW_KMAX = 5120;
constexpr int CW_QMAX = 5184;
constexpr int CW_BAR = 8192;
constexpr float T_SKIP = 40.f;

constexpr int RING_BYTES = 139264;
constexpr int LDSCTL_OFF = RING_BYTES;
constexpr int MISC_OFF = LDSCTL_OFF + 64;
constexpr int TB_OFF = LDSCTL_OFF + 1024;
constexpr int LDS_BYTES = 147456;

__device__ __forceinline__ unsigned cvt_pk_bf16(float lo, float hi) { unsigned r; asm volatile("v_cvt_pk_bf16_f32 %0, %1, %2" : "=v"(r) : "v"(lo), "v"(hi)); return r; }
__device__ __forceinline__ float bf_lo(unsigned w) { return __uint_as_float(w << 16); }
__device__ __forceinline__ float bf_hi(unsigned w) { return __uint_as_float(w & 0xffff0000u); }
__device__ __forceinline__ float fast_sigmoid(float x) { return __builtin_amdgcn_rcpf(1.f + __builtin_amdgcn_exp2f(-x * LOG2E)); }
__device__ __forceinline__ float wave_sum(float v) {
#pragma unroll
    for (int o = 1; o < 64; o <<= 1) v += __shfl_xor(v, o);
    return v;
}
#define LDS_WAIT() asm volatile("s_waitcnt lgkmcnt(0)" ::: "memory")
#define VM_WAIT() asm volatile("s_waitcnt vmcnt(0)" ::: "memory")

namespace pg8 {
constexpr int BM = 256, BK = 64, HALF = 128, HTB = HALF * BK * 2, STAGE_BYTES = 8 * HTB, NXCD = 8, WGM = 8;
__host__ __device__ __forceinline__ int lds_byte(int r, int c) { const int st = (r >> 4) * 2 + (c >> 5), rr = r & 15, cc = c & 31, ob = rr * 64 + cc * 2; return st * 1024 + (ob ^ (((ob >> 9) & 1) << 5)); }
__host__ __device__ __forceinline__ void stage_rc(int b, int& R, int& C) { const int st = b / 1024, sb = b % 1024, swz = sb ^ (((sb >> 9) & 1) << 5); R = (st >> 1) * 16 + swz / 64; C = (st & 1) * 32 + (swz % 64) / 2; }
__host__ __device__ __forceinline__ int perm32(int rho) { const int n = rho >> 4, i = rho & 15; return 8 * (i >> 2) + 4 * n + (i & 3); }

struct Unit { const char* A; const char* B; const int* rows; int r0, c0, valid, aux; };
struct GemmK { int K, lda, ldb; };

template <class Epi, class Sched, bool ALIGN_EPI, bool F8 = false>
__device__ __forceinline__ void gemm_phase(LAS unsigned char* lds, const GemmK g, const Sched& S, const Epi& E) {
    const int tid = threadIdx.x, wid = __builtin_amdgcn_readfirstlane(tid >> 6), lane = tid & 63, wr = wid >> 2, wc = wid & 3, fr = lane & 15, fq = lane >> 4;
    constexpr unsigned ES = F8 ? 1u : 2u;
    const int K = g.K, nt = (K * (int)ES) / (BK * 2);
    unsigned voffB0[2], voffB1[2];
#pragma unroll
    for (int i = 0; i < 2; ++i) { int R, C; stage_rc(tid * 16 + i * 8192, R, C);
        int Rb0, Rb1;
        if constexpr ((int)Epi::PERM == 2) { const int wc_ = R >> 5, rho = R & 31, n_ = rho >> 4, ii = rho & 15; Rb0 = 64 * wc_ + 16 * (ii >> 2) + 4 * n_ + (ii & 3); Rb1 = Rb0 + 8; }
        else { Rb0 = (int)Epi::PERM ? ((R & ~31) + perm32(R & 31)) : R; Rb1 = Rb0 + HALF; }
        voffB0[i] = (unsigned)(Rb0 * g.ldb) * ES + (unsigned)C * 2u; voffB1[i] = (unsigned)(Rb1 * g.ldb) * ES + (unsigned)C * 2u; }
    const size_t kstep = (size_t)(BK * 2);
    const unsigned ldsw = (unsigned)wid * 1024u;
    const int aoff = lds_byte(wr * 64 + fr, fq * (F8 ? 16 : 8)), boff = lds_byte(wc * 32 + fr, fq * (F8 ? 16 : 8));
    constexpr int KSTR = F8 ? 16 : 1024;
    int f8scale = 0x7f7f7f7f; asm volatile("" : "+v"(f8scale));
#define PG8_SA(b, h) (((b) * 2 + (h)) * HTB)
#define PG8_SB(b, h) ((4 + (b) * 2 + (h)) * HTB)
#define PG8_STAGE(bufoff, gbase, voff) do { _Pragma("unroll") for (int _i = 0; _i < 2; ++_i) \
        __builtin_amdgcn_global_load_lds((const unsigned*)((const char*)(gbase) + (voff)[_i]), (LAS unsigned*)(lds + (bufoff) + ldsw + _i * 8192), 16, 0, 0); } while (0)
#define PG8_LDA(dst, b, h) do { _Pragma("unroll") for (int m = 0; m < 4; ++m) _Pragma("unroll") for (int k = 0; k < 2; ++k) dst[m][k] = *(const LAS bf16x8*)(lds + PG8_SA(b, h) + aoff + m * 2048 + k * KSTR); } while (0)
#define PG8_LDB(dst, b, h) do { _Pragma("unroll") for (int n = 0; n < 2; ++n) _Pragma("unroll") for (int k = 0; k < 2; ++k) dst[n][k] = *(const LAS bf16x8*)(lds + PG8_SB(b, h) + boff + n * 2048 + k * KSTR); } while (0)
#define PG8_CAT8(x0, x1) __builtin_shufflevector(__builtin_bit_cast(i32x4, x0), __builtin_bit_cast(i32x4, x1), 0, 1, 2, 3, 4, 5, 6, 7)
#define PG8_MMA(ai, bj, At, Bt) do { __builtin_amdgcn_s_setprio(1); if constexpr (F8) { _Pragma("unroll") for (int m = 0; m < 4; ++m) _Pragma("unroll") for (int n = 0; n < 2; ++n) \
        asm volatile("v_mfma_scale_f32_16x16x128_f8f6f4 %0, %1, %2, %0, %3, %3 op_sel_hi:[0,0,0]" : "+v"(acc[ai][bj][m][n]) : "v"(PG8_CAT8(Bt[n][0], Bt[n][1])), "v"(PG8_CAT8(At[m][0], At[m][1])), "v"(f8scale)); } \
      else { _Pragma("unroll") for (int m = 0; m < 4; ++m) _Pragma("unroll") for (int n = 0; n < 2; ++n) _Pragma("unroll") for (int k = 0; k < 2; ++k) \
        acc[ai][bj][m][n] = __builtin_amdgcn_mfma_f32_16x16x32_bf16(Bt[n][k], At[m][k], acc[ai][bj][m][n], 0, 0, 0); } __builtin_amdgcn_s_setprio(0); } while (0)
#define PG8_WAIT_V(n) asm volatile("s_waitcnt vmcnt(" #n ")" ::: "memory")
#define PG8_WAIT_L(n) asm volatile("s_waitcnt lgkmcnt(" #n ")" ::: "memory")
#define PG8_BAR __builtin_amdgcn_s_barrier()
#define PG8_SCHED __builtin_amdgcn_sched_barrier(0)
#define PG8_VOFFA(u, v0, v1) do { int t_ = tid; asm volatile("" : "+v"(t_)); _Pragma("unroll") for (int _i = 0; _i < 2; ++_i) { int R_, C_; stage_rc(t_ * 16 + _i * 8192, R_, C_);     \
        v0[_i] = S.a_off(u, R_) + (unsigned)C_ * 2u; v1[_i] = S.a_off(u, R_ + HALF) + (unsigned)C_ * 2u; } } while (0)
    Unit cur, nxt; int ui = 0;
    if (!S.next(0, cur)) return;
    f32x4 acc[2][2][4][2];
#pragma unroll
    for (int a = 0; a < 2; ++a)
#pragma unroll
        for (int b = 0; b < 2; ++b)
#pragma unroll
            for (int m = 0; m < 4; ++m)
#pragma unroll
                for (int n = 0; n < 2; ++n) acc[a][b][m][n] = (f32x4){0.f, 0.f, 0.f, 0.f};
    bf16x8 At[4][2], B0[2][2], B1[2][2];
    const char* cA = cur.A; const char* cB = cur.B;
    unsigned vA0[2], vA1[2], nA0[2], nA1[2];
    PG8_VOFFA(cur, vA0, vA1);
    PG8_STAGE(PG8_SB(0, 0), cB, voffB0); PG8_STAGE(PG8_SB(0, 1), cB, voffB1); PG8_STAGE(PG8_SA(0, 0), cA, vA0); PG8_STAGE(PG8_SA(0, 1), cA, vA1);
    if (wr == 1) PG8_BAR;
    PG8_WAIT_V(2); PG8_BAR;
    PG8_STAGE(PG8_SB(1, 0), cB + kstep, voffB0); PG8_STAGE(PG8_SA(1, 0), cA + kstep, vA0); PG8_STAGE(PG8_SB(1, 1), cB + kstep, voffB1);
    PG8_WAIT_V(6); PG8_BAR;
    for (;;) {
        const bool has_next = S.next(ui + 1, nxt);
        const char* nA = has_next ? nxt.A : cA; const char* nB = has_next ? nxt.B : cB;
        if (has_next) { PG8_VOFFA(nxt, nA0, nA1); } else { nA0[0] = vA0[0]; nA0[1] = vA0[1]; nA1[0] = vA1[0]; nA1[1] = vA1[1]; }
#pragma unroll 1
        for (int t = 0; t < nt; t += 2) {
            const bool last = (t == nt - 2);
            const char* a1 = cA + (size_t)(t + 1) * kstep;
            const char* a2 = last ? nA : cA + (size_t)(t + 2) * kstep; const char* b2 = last ? nB : cB + (size_t)(t + 2) * kstep;
            const char* a3 = a2 + kstep; const char* b3 = b2 + kstep;
            unsigned w0[2], w1[2];
            w0[0] = last ? nA0[0] : vA0[0]; w0[1] = last ? nA0[1] : vA0[1]; w1[0] = last ? nA1[0] : vA1[0]; w1[1] = last ? nA1[1] : vA1[1];
            PG8_LDB(B0, 0, 0); PG8_LDB(B1, 0, 1); PG8_SCHED; PG8_LDA(At, 0, 0); PG8_STAGE(PG8_SA(1, 1), a1, vA1);
            PG8_WAIT_V(8); PG8_WAIT_L(0); PG8_BAR; PG8_MMA(0, 0, At, B0); PG8_MMA(0, 1, At, B1); PG8_BAR; PG8_SCHED;
            PG8_LDA(At, 0, 1); PG8_STAGE(PG8_SB(0, 0), b2, voffB0); PG8_STAGE(PG8_SB(0, 1), b2, voffB1); PG8_STAGE(PG8_SA(0, 0), a2, w0);
            PG8_WAIT_V(8); PG8_WAIT_L(0); PG8_BAR; PG8_MMA(1, 0, At, B0); PG8_MMA(1, 1, At, B1); PG8_BAR; PG8_SCHED;
            PG8_LDB(B0, 1, 0); PG8_LDB(B1, 1, 1); PG8_SCHED; PG8_LDA(At, 1, 0); PG8_STAGE(PG8_SA(0, 1), a2, w1);
            PG8_WAIT_V(8); PG8_WAIT_L(0); PG8_BAR; PG8_MMA(0, 0, At, B0); PG8_MMA(0, 1, At, B1); PG8_BAR; PG8_SCHED;
            PG8_LDA(At, 1, 1); PG8_STAGE(PG8_SB(1, 0), b3, voffB0); PG8_STAGE(PG8_SB(1, 1), b3, voffB1); PG8_STAGE(PG8_SA(1, 0), a3, w0);
            PG8_WAIT_V(8); PG8_WAIT_L(0); PG8_BAR; PG8_MMA(1, 0, At, B0); PG8_MMA(1, 1, At, B1); PG8_BAR; PG8_SCHED;
        }
        if constexpr (ALIGN_EPI) { if (wr == 0) PG8_BAR; }
        if constexpr (F8) asm volatile("s_nop 15\n\ts_nop 7" ::: "memory");
        E(acc, cur, wr, wc, fr, fq);
        if (!has_next) break;
#pragma unroll
        for (int a = 0; a < 2; ++a)
#pragma unroll
            for (int b = 0; b < 2; ++b)
#pragma unroll
                for (int m = 0; m < 4; ++m)
#pragma unroll
                    for (int n = 0; n < 2; ++n) acc[a][b][m][n] = (f32x4){0.f, 0.f, 0.f, 0.f};
        cur = nxt; cA = nA; cB = nB; ++ui;
        vA0[0] = nA0[0]; vA0[1] = nA0[1]; vA1[0] = nA1[0]; vA1[1] = nA1[1];
        if constexpr (ALIGN_EPI) { if (wr == 1) PG8_BAR; }
    }
    PG8_WAIT_V(0);
    if constexpr (!ALIGN_EPI) { if (wr == 0) PG8_BAR; }
    PG8_BAR;
#undef PG8_SA
#undef PG8_SB
#undef PG8_STAGE
#undef PG8_LDA
#undef PG8_LDB
#undef PG8_MMA
#undef PG8_CAT8
#undef PG8_WAIT_V
#undef PG8_WAIT_L
#undef PG8_BAR
#undef PG8_SCHED
#undef PG8_VOFFA
}

__device__ __forceinline__ int xcd_remap(int L, int nwg) { const int q = nwg / NXCD, r = nwg % NXCD, xcd = L % NXCD, off = L / NXCD; return (xcd < r ? xcd * (q + 1) : r * (q + 1) + (xcd - r) * q) + off; }

struct DenseOrder {
    const char* A; const char* B; int lda, ldb, nM, nN, nwg, G, c;
    __device__ __forceinline__ void init(const void* A_, const void* B_, int lda_, int ldb_, int M, int N, int G_, int c_) { A = (const char*)A_; B = (const char*)B_; lda = lda_ * 2; ldb = ldb_ * 2; nM = M / BM; nN = N / BM; nwg = nM * nN; G = G_; c = c_; }
    __device__ __forceinline__ bool next(int i, Unit& u) const {
        const long L = (long)i * G + c; if (L >= nwg) return false;
        const int wgid = xcd_remap((int)L, nwg);
        const int nig = WGM * nN, gid = wgid / nig, fm = gid * WGM, gsz = (nM - fm) < WGM ? (nM - fm) : WGM;
        const int pm = fm + ((wgid % nig) % gsz), pn = (wgid % nig) / gsz;
        u.A = A + (size_t)pm * BM * lda; u.B = B + (size_t)pn * BM * ldb; u.rows = nullptr; u.r0 = pm * BM; u.c0 = pn; u.valid = BM; u.aux = 0; return true;
    }
    __device__ __forceinline__ unsigned a_off(const Unit&, int R) const { return (unsigned)R * (unsigned)lda; }
};
struct EOrder {
    const char* UG; const char* OPE; int G, c;
    __device__ __forceinline__ bool next(int i, Unit& u) const {
        const int L = i * G + c; if (L >= 128) return false;
        const int g = L >> 1, b = L & 1;
        u.A = UG + ((size_t)((g * 2 + b) * NCHK + 1)) * UGK * 2; u.B = OPE + (size_t)g * 256 * 512 * 2; u.rows = nullptr; u.r0 = (g * 2 + b) * 256; u.c0 = 0; u.valid = BM; u.aux = g; return true;
    }
    __device__ __forceinline__ unsigned a_off(const Unit&, int R) const { return (unsigned)R * (unsigned)(UGK * 2); }
};
struct YOrder {
    const char* UG; const char* OPY; int G, c;
    __device__ __forceinline__ bool next(int i, Unit& u) const {
        const int L = i * G + c; if (L >= 256) return false;
        const int g = L >> 2, b = (L >> 1) & 1, pn = L & 1;
        u.A = UG + ((size_t)((g * 2 + b) * NCHK + 2)) * UGK * 2; u.B = OPY + ((size_t)g * 512 + pn * 256) * UGK * 2; u.rows = nullptr; u.r0 = b; u.c0 = pn; u.valid = BM; u.aux = g; return true;
    }
    __device__ __forceinline__ unsigned a_off(const Unit&, int R) const { return (unsigned)R * (unsigned)(UGK * 2); }
};
struct OneUnit {
    Unit u; unsigned rowbytes;
    __device__ __forceinline__ bool next(int i, Unit& uu) const { if (i > 0) return false; uu = u; return true; }
    __device__ __forceinline__ unsigned a_off(const Unit&, int R) const { return (unsigned)R * rowbytes; }
};
struct MoeOrder {
    const LAS int* tb;
    int TT, NCT, nsh, nwg, G, c, lda, ldb;
    const char* Aexp; const int* tok; const char* Bexp; size_t bstride; const char* Ash; const char* Bsh; bool gather;
    __device__ __forceinline__ bool next(int i, Unit& u) const {
        const long L = (long)i * G + c; if (L >= nwg) return false;
        const int wgid = xcd_remap((int)L, nwg);
        if (wgid < TT * NCT) {
            const int gr = wgid / NCT, ct = wgid - gr * NCT;
            int lo = 0, hi = NEXP;
            while (hi - lo > 1) { const int mid = (lo + hi) >> 1; if (tb[mid] <= gr) lo = mid; else hi = mid; }
            const int e = lo, rt = gr - tb[e], cn = tb[130 + e], cp = tb[65 + e];
            int valid = cn - rt * BM; valid = valid > BM ? BM : valid;
            if (gather) { u.A = Aexp; u.rows = tok + (size_t)e * MX + rt * BM; }
            else { u.A = Aexp + (size_t)(cp + rt * BM) * lda; u.rows = nullptr; }
            u.B = Bexp + (size_t)e * bstride + (size_t)ct * BM * ldb; u.r0 = cp + rt * BM; u.c0 = ct; u.valid = valid; u.aux = 0;
        } else {
            const int s = wgid - TT * NCT, pm = s / NCT, ct = s - pm * NCT;
            u.A = Ash + (size_t)pm * BM * lda; u.rows = nullptr; u.B = Bsh + (size_t)ct * BM * ldb; u.r0 = pm * BM; u.c0 = ct; u.valid = BM; u.aux = 1;
        }
        return true;
    }
    __device__ __forceinline__ unsigned a_off(const Unit& u, int R) const {
        if (u.rows) { const int i = R < u.valid ? R : u.valid - 1; return (unsigned)u.rows[i] * (unsigned)lda; }
        return (unsigned)R * (unsigned)lda;
    }
};

#define EPI_LOOP_ROWS for (int ai = 0; ai < 2; ++ai) _Pragma("unroll") for (int m = 0; m < 4; ++m)
__device__ __forceinline__ u32x4 pack8(f32x4 v0, f32x4 v1) { u32x4 w; w.x = cvt_pk_bf16(v0[0], v0[1]); w.y = cvt_pk_bf16(v0[2], v0[3]); w.z = cvt_pk_bf16(v1[0], v1[1]); w.w = cvt_pk_bf16(v1[2], v1[3]); return w; }

struct EpiInProj {
    static constexpr int PERM = 1;
    bf16_t* UG; bf16_t* Q; bf16_t* Kb; bf16_t* Vb;
    __device__ __forceinline__ void operator()(const f32x4 (&acc)[2][2][4][2], const Unit& u, int wr, int wc, int fr, int fq) const {
        const int pn = u.c0, sect = pn >> 2;
        const float sc = sect == 1 ? QSCALE : 1.f;
#pragma unroll
        EPI_LOOP_ROWS { const int rt = ai * HALF + wr * 64 + m * 16 + fr; const int row = u.r0 + rt, b = row >> 13, s = row & (SEQ - 1);
#pragma unroll
            for (int bj = 0; bj < 2; ++bj) {
                const int col = (pn & 3) * 256 + bj * HALF + wc * 32 + 8 * fq;
                const u32x4 w = pack8(acc[ai][bj][m][0] * sc, acc[ai][bj][m][1] * sc);
                if (sect == 0) { const int gch = col >> 4, half = (col >> 3) & 1;
                    *(u32x4*)(UG + ((size_t)((gch * 2 + b) * NCHK + 2 + (s >> 5)) * UGK + (s & 31) * 16 + 8 * half)) = w; }
                else if (sect == 1) *(u32x4*)(Q + (size_t)row * 1024 + col) = w;
                else { bf16_t* dst = sect == 2 ? Kb : Vb; *(u32x4*)(dst + ((size_t)b * KVR + 64 + s) * 1024 + col) = w; }
            }
        }
    }
};
struct EpiE {
    static constexpr int PERM = 0;
    float* E;
    __device__ __forceinline__ void operator()(const f32x4 (&acc)[2][2][4][2], const Unit& u, int wr, int wc, int fr, int fq) const {
#pragma unroll
        EPI_LOOP_ROWS { const int rt = ai * HALF + wr * 64 + m * 16 + fr;
#pragma unroll
            for (int n = 0; n < 2; ++n) *(f32x4*)(E + (size_t)(u.r0 + rt) * 128 + wc * 32 + 16 * n + 4 * fq) = acc[ai][0][m][n]; }
    }
};
__device__ __forceinline__ float gelu_tanh(float v) { const float t = 1.5957691216057308f * (v + 0.044715f * v * v * v); return v * fast_sigmoid(t); }
struct EpiY {
    static constexpr int PERM = 1;
    bf16_t* YB;
    __device__ __forceinline__ void operator()(const f32x4 (&acc)[2][2][4][2], const Unit& u, int wr, int wc, int fr, int fq) const {
        const int b = u.r0, g = u.aux;
#pragma unroll
        EPI_LOOP_ROWS { const int rt = ai * HALF + wr * 64 + m * 16 + fr;
#pragma unroll
            for (int bj = 0; bj < 2; ++bj) { const int col = u.c0 * 256 + bj * HALF + wc * 32 + 8 * fq, t = col >> 4, h0 = col & 15;
                f32x4 v0 = acc[ai][bj][m][0], v1 = acc[ai][bj][m][1];
#pragma unroll
                for (int e = 0; e < 4; ++e) { v0[e] = gelu_tanh(v0[e]); v1[e] = gelu_tanh(v1[e]); }
                *(u32x4*)(YB + ((size_t)b * SEQ + 32 * rt + t) * 1024 + g * 16 + h0) = pack8(v0, v1); }
            asm volatile("" ::: "memory"); }
    }
};
struct EpiGlu {
    static constexpr int PERM = 1;
    const bf16_t* YB; const float* bias; bf16_t* YC;
    __device__ __forceinline__ void operator()(const f32x4 (&acc)[2][2][4][2], const Unit& u, int wr, int wc, int fr, int fq) const {
#pragma unroll
        for (int bj = 0; bj < 2; ++bj) { const int col = u.c0 * 256 + bj * HALF + wc * 32 + 8 * fq;
            const f32x4 b0 = *(const f32x4*)(bias + col), b1 = *(const f32x4*)(bias + col + 4);
#pragma unroll
            EPI_LOOP_ROWS { const int row = u.r0 + ai * HALF + wr * 64 + m * 16 + fr;
                const u32x4 yw = *(const u32x4*)(YB + (size_t)row * 1024 + col);
                f32x4 v0 = acc[ai][bj][m][0] + b0, v1 = acc[ai][bj][m][1] + b1;
                v0[0] = bf_lo(yw.x) * fast_sigmoid(v0[0]); v0[1] = bf_hi(yw.x) * fast_sigmoid(v0[1]); v0[2] = bf_lo(yw.y) * fast_sigmoid(v0[2]); v0[3] = bf_hi(yw.y) * fast_sigmoid(v0[3]);
                v1[0] = bf_lo(yw.z) * fast_sigmoid(v1[0]); v1[1] = bf_hi(yw.z) * fast_sigmoid(v1[1]); v1[2] = bf_lo(yw.w) * fast_sigmoid(v1[2]); v1[3] = bf_hi(yw.w) * fast_sigmoid(v1[3]);
                *(u32x4*)(YC + (size_t)row * 2048 + col) = pack8(v0, v1); } }
    }
};
struct EpiOut {
    static constexpr int PERM = 0;
    const bf16_t* XN; float* Z; float* ST;
    __device__ __forceinline__ void operator()(const f32x4 (&acc)[2][2][4][2], const Unit& u, int wr, int wc, int fr, int fq) const {
#pragma unroll
        EPI_LOOP_ROWS { const int row = u.r0 + ai * HALF + wr * 64 + m * 16 + fr; float s = 0.f, q = 0.f;
#pragma unroll
            for (int bj = 0; bj < 2; ++bj)
#pragma unroll
                for (int n = 0; n < 2; ++n) { const int col = u.c0 * 256 + bj * HALF + wc * 32 + 16 * n + 4 * fq;
                    const u32x2 hw = *(const u32x2*)(XN + (size_t)row * 2048 + col);
                    f32x4 z = acc[ai][bj][m][n];
                    z[0] += ALPHA * bf_lo(hw.x); z[1] += ALPHA * bf_hi(hw.x); z[2] += ALPHA * bf_lo(hw.y); z[3] += ALPHA * bf_hi(hw.y);
                    s += (z[0] + z[1]) + (z[2] + z[3]); q += (z[0] * z[0] + z[1] * z[1]) + (z[2] * z[2] + z[3] * z[3]);
                    *(f32x4*)(Z + (size_t)row * 2048 + col) = z; }
            s += __shfl_xor(s, 16); s += __shfl_xor(s, 32); q += __shfl_xor(q, 16); q += __shfl_xor(q, 32);
            if (fq == 0) *(f32x2*)(ST + ((size_t)row * 32 + u.c0 * 4 + wc) * 2) = (f32x2){s, q}; }
    }
};
__device__ __forceinline__ float clamp448(float v) { return __builtin_fminf(__builtin_fmaxf(v, -448.f), 448.f); }
__device__ __forceinline__ u32x2 pack8_fp8(f32x4 v0, f32x4 v1) {
    int lo = 0, hi = 0;
    lo = __builtin_amdgcn_cvt_pk_fp8_f32(clamp448(v0[0]), clamp448(v0[1]), lo, false); lo = __builtin_amdgcn_cvt_pk_fp8_f32(clamp448(v0[2]), clamp448(v0[3]), lo, true);
    hi = __builtin_amdgcn_cvt_pk_fp8_f32(clamp448(v1[0]), clamp448(v1[1]), hi, false); hi = __builtin_amdgcn_cvt_pk_fp8_f32(clamp448(v1[2]), clamp448(v1[3]), hi, true);
    return (u32x2){(unsigned)lo, (unsigned)hi};
}
struct EpiGU {
    static constexpr int PERM = 1;
    unsigned char* HID; unsigned char* HIDS;
    __device__ __forceinline__ void operator()(const f32x4 (&acc)[2][2][4][2], const Unit& u, int wr, int wc, int fr, int fq) const {
        unsigned char* dst = u.aux ? HIDS : HID; constexpr float WI = 1.f / W8SCALE;
#pragma unroll
        EPI_LOOP_ROWS { const int rt = ai * HALF + wr * 64 + m * 16 + fr;
            if (rt < u.valid) { f32x4 h0, h1;
#pragma unroll
                for (int e = 0; e < 4; ++e) { const float g0 = acc[ai][0][m][0][e] * WI, g1 = acc[ai][0][m][1][e] * WI;
                    h0[e] = g0 * fast_sigmoid(g0) * (acc[ai][1][m][0][e] * (WI * H8SCALE)); h1[e] = g1 * fast_sigmoid(g1) * (acc[ai][1][m][1][e] * (WI * H8SCALE)); }
                *(u32x2*)(dst + (size_t)(u.r0 + rt) * EFF + u.c0 * HALF + wc * 32 + 8 * fq) = pack8_fp8(h0, h1); } }
    }
};
struct EpiDown {
    static constexpr int PERM = 2;
    unsigned char* C; unsigned char* CS;
    __device__ __forceinline__ void operator()(const f32x4 (&acc)[2][2][4][2], const Unit& u, int wr, int wc, int fr, int fq) const {
        unsigned char* dst = u.aux ? CS : C; constexpr float SC = C8SCALE / (W8SCALE * H8SCALE);
#pragma unroll
        EPI_LOOP_ROWS { const int rt = ai * HALF + wr * 64 + m * 16 + fr;
            if (rt < u.valid) { const u32x2 lo = pack8_fp8(acc[ai][0][m][0] * SC, acc[ai][0][m][1] * SC), hi = pack8_fp8(acc[ai][1][m][0] * SC, acc[ai][1][m][1] * SC);
                *(u32x4*)(dst + (size_t)(u.r0 + rt) * 2048 + u.c0 * 256 + wc * 64 + 16 * fq) = (u32x4){lo.x, lo.y, hi.x, hi.y}; } }
    }
};
}

namespace att {
constexpr int D = 128, NW = 8, QBLK = 32, KVBLK = 64, QB = NW * QBLK;
constexpr int PQ = 1024, PKV = 1024, PO = 2048;
constexpr int SHM_V = KVBLK * D * 2, SHM_K = KVBLK * D * 2;
constexpr int OFF_WS = 2 * SHM_V + 2 * SHM_K, OFF_CUM = OFF_WS + NW * 64 * 4, LDS_BYTES = OFF_CUM + 2 * 64 * 4;
constexpr float THR2 = 8.f * 1.4426950408889634f;
constexpr unsigned WINF = 0x7fffffffu;
#define KSWZ(row, colB) ((row) * 256 + ((colB) ^ (((row) & 7) << 4)))
#define SBAR() __builtin_amdgcn_sched_barrier(0)
__device__ __forceinline__ int v_st(int k, int c) { const int kk = (k & ~0xC) | ((k & 4) << 1) | ((k & 8) >> 1); return ((kk >> 3) * 4 + (c >> 5)) * 512 + ((kk & 7) * 32 + (c & 31)) * 2; }
__device__ __forceinline__ int v_rd_base(int lane) { return ((lane & 3) << 3) | (((lane >> 2) & 3) << 6) | (((lane >> 4) & 1) << 5) | (((lane >> 5) & 1) << 8); }
constexpr int v_rd_off(int d0, int ks, int half) { return d0 * 512 + ks * 4096 + half * 2048; }
__device__ __forceinline__ int crow(int r, int hi) { return (r & 3) + 8 * (r >> 2) + 4 * hi; }
__device__ __forceinline__ unsigned cvtpk(float lo, float hi) { unsigned r; asm volatile("v_cvt_pk_bf16_f32 %0, %1, %2" : "=v"(r) : "v"(lo), "v"(hi)); return r; }
__device__ __forceinline__ bf16x8 ld8(const bf16_t* p) { return *reinterpret_cast<const bf16x8*>(p); }
__device__ __forceinline__ void mask_tile(f32x16& p0, f32x16& p1, int dq, unsigned W) {
    const float NEG = -__builtin_inff();
#pragma unroll
    for (int r = 0; r < 16; ++r) { const int c = (r & 3) + 8 * (r >> 2);
        if ((unsigned)(dq - c) >= W) p0[r] = NEG;
        if ((unsigned)(dq - c - 32) >= W) p1[r] = NEG; }
}
__device__ __forceinline__ void partialSM(f32x16& p0, f32x16& p1, float& m_reg, float& mn, float& alpha) {
    float pmax = p0[0];
#pragma unroll
    for (int r = 1; r < 16; ++r) pmax = fmaxf(pmax, p0[r]);
#pragma unroll
    for (int r = 0; r < 16; ++r) pmax = fmaxf(pmax, p1[r]);
    { auto rr = __builtin_amdgcn_permlane32_swap(__float_as_uint(pmax), __float_as_uint(pmax), false, false);
      pmax = fmaxf(__uint_as_float(rr[0]), __uint_as_float(rr[1])); }
    if (__builtin_expect(__all((pmax - m_reg) <= THR2), 1)) { mn = m_reg; alpha = 1.f; }
    else { mn = fmaxf(m_reg, pmax); alpha = __builtin_amdgcn_exp2f(m_reg - mn); m_reg = mn; }
#pragma unroll
    for (int r = 0; r < 16; ++r) p0[r] = p0[r] - mn;
#pragma unroll
    for (int r = 0; r < 16; ++r) p1[r] = p1[r] - mn;
#pragma unroll
    for (int r = 0; r < 16; ++r) p0[r] = __builtin_amdgcn_exp2f(p0[r]);
}
__device__ __forceinline__ void finishSM(f32x16& p0, f32x16& p1, float alpha, float& l_reg, bf16x8& pa0, bf16x8& pa1, bf16x8& pa2, bf16x8& pa3) {
#pragma unroll
    for (int r = 0; r < 16; ++r) p1[r] = __builtin_amdgcn_exp2f(p1[r]);
    float ps = 0;
#pragma unroll
    for (int r = 0; r < 16; ++r) ps += p0[r];
#pragma unroll
    for (int r = 0; r < 16; ++r) ps += p1[r];
    { auto rr = __builtin_amdgcn_permlane32_swap(__float_as_uint(ps), __float_as_uint(ps), false, false);
      ps = __uint_as_float(rr[0]) + __uint_as_float(rr[1]); }
    l_reg = l_reg * alpha + ps;
#define PK4(P, B_, OUT) do { unsigned a0 = cvtpk(P[B_+0], P[B_+1]), a1 = cvtpk(P[B_+2], P[B_+3]);                          \
        unsigned b0 = cvtpk(P[B_+4], P[B_+5]), b1 = cvtpk(P[B_+6], P[B_+7]);                                             \
        auto r0 = __builtin_amdgcn_permlane32_swap(a0, b0, false, false); auto r1 = __builtin_amdgcn_permlane32_swap(a1, b1, false, false); \
        u32x4 w = {r0[0], r1[0], r0[1], r1[1]}; OUT = *reinterpret_cast<bf16x8*>(&w); } while (0)
    PK4(p0, 0, pa0); PK4(p0, 8, pa1); PK4(p1, 0, pa2); PK4(p1, 8, pa3);
#undef PK4
}
template <int KB>
__device__ __forceinline__ void qkt(f32x16& p0, f32x16& p1, const LAS char* K_lds, const LAS float* cumL, int r32, int hi, const bf16x8* qr) {
    { int l_ = r32 + 32 * hi; asm volatile("" : "+v"(l_)); r32 = l_ & 31; hi = l_ >> 5; }
    const LAS float* cb = cumL + KB * 64 + 4 * hi;
#pragma unroll
    for (int g = 0; g < 4; ++g) { const f32x4 a = *(const LAS f32x4*)(cb + 8 * g), b = *(const LAS f32x4*)(cb + 32 + 8 * g);
        p0[4 * g] = a[0]; p0[4 * g + 1] = a[1]; p0[4 * g + 2] = a[2]; p0[4 * g + 3] = a[3];
        p1[4 * g] = b[0]; p1[4 * g + 1] = b[1]; p1[4 * g + 2] = b[2]; p1[4 * g + 3] = b[3]; }
    const LAS char* kb[4];
#pragma unroll
    for (int dd = 0; dd < 4; ++dd) kb[dd] = K_lds + KB * SHM_K + KSWZ(r32, (dd * 16 + hi * 8) * 2);
#pragma unroll
    for (int d0 = 0; d0 < 8; ++d0) { const LAS char* a = kb[d0 & 3] + (d0 >> 2) * 128;
        bf16x8 b0 = *reinterpret_cast<const LAS bf16x8*>(a);
        bf16x8 b1 = *reinterpret_cast<const LAS bf16x8*>(a + 32 * 256);
        p0 = __builtin_amdgcn_mfma_f32_32x32x16_bf16(b0, qr[d0], p0, 0, 0, 0);
        p1 = __builtin_amdgcn_mfma_f32_32x32x16_bf16(b1, qr[d0], p1, 0, 0, 0); }
}
template <int VB>
__device__ __forceinline__ void pv_tile(f32x16* o, int vb0, bf16x8 pa0, bf16x8 pa1, bf16x8 pa2, bf16x8 pa3) {
#define TRRD(dst, off) asm volatile("ds_read_b64_tr_b16 %0, %1 offset:%2" : "=&v"(dst) : "v"(vb0), "i"(off) : "memory")
#define PV_D0(d0) do { s16x4 l0, l1, l2, l3, h0, h1, h2, h3; constexpr int b_ = VB * SHM_V + v_rd_off(d0, 0, 0); \
        TRRD(l0, b_); TRRD(h0, b_ + 2048); TRRD(l1, b_ + 4096); TRRD(h1, b_ + 6144); TRRD(l2, b_ + 8192); TRRD(h2, b_ + 10240); TRRD(l3, b_ + 12288); TRRD(h3, b_ + 14336); \
        asm volatile("s_waitcnt lgkmcnt(0)" ::: "memory"); SBAR();   \
        o[d0] = __builtin_amdgcn_mfma_f32_32x32x16_bf16(pa0, (bf16x8){l0[0], l0[1], l0[2], l0[3], h0[0], h0[1], h0[2], h0[3]}, o[d0], 0, 0, 0);   \
        o[d0] = __builtin_amdgcn_mfma_f32_32x32x16_bf16(pa1, (bf16x8){l1[0], l1[1], l1[2], l1[3], h1[0], h1[1], h1[2], h1[3]}, o[d0], 0, 0, 0);   \
        o[d0] = __builtin_amdgcn_mfma_f32_32x32x16_bf16(pa2, (bf16x8){l2[0], l2[1], l2[2], l2[3], h2[0], h2[1], h2[2], h2[3]}, o[d0], 0, 0, 0);   \
        o[d0] = __builtin_amdgcn_mfma_f32_32x32x16_bf16(pa3, (bf16x8){l3[0], l3[1], l3[2], l3[3], h3[0], h3[1], h3[2], h3[3]}, o[d0], 0, 0, 0); } while (0)
    PV_D0(0); PV_D0(1); PV_D0(2); PV_D0(3);
#undef PV_D0
#undef TRRD
}
struct BlockRef { const bf16_t* Q; const bf16_t* K; const bf16_t* V; bf16_t* O; const float* nck; int P0; int j_lo; };
struct Seam { bf16x8 qr[8]; bf16x8 st_v0, st_v1, st_k0, st_k1; };
#define ROWP(p, k0, rr) ((p) + (size_t)((k0) + (rr)) * PKV + sc)
#define VMW() asm volatile("s_waitcnt vmcnt(0)" ::: "memory")
#define VMWN(n) asm volatile("s_waitcnt vmcnt(%0)" :: "i"(n) : "memory")
#define SLOAD_H(BR, k0, CB) do { S.st_v0 = ld8(ROWP((BR).V, k0, sr)); S.st_v1 = ld8(ROWP((BR).V, k0, 32 + sr));              \
                             S.st_k0 = ld8(ROWP((BR).K, k0, sr)); S.st_k1 = ld8(ROWP((BR).K, k0, 32 + sr)); \
                             if (wid == 0) __builtin_amdgcn_global_load_lds((const unsigned*)((BR).nck + (k0) + lane), (LAS unsigned*)(cumL + (CB) * 64), 4, 0, 0); } while (0)
#define SWRITE_HK(bf) do { int t_ = tid; asm volatile("" : "+v"(t_)); const int kws_ = KSWZ(t_ >> 4, (t_ & 15) * 16); \
                           *(LAS bf16x8*)(K_lds + (bf) * SHM_K + kws_) = S.st_k0; *(LAS bf16x8*)(K_lds + (bf) * SHM_K + kws_ + 32 * 256) = S.st_k1; } while (0)
#define SWRITE_HV(bf) do { int t_ = tid; asm volatile("" : "+v"(t_)); const int vs0_ = v_st(t_ >> 4, (t_ & 15) * 8), vs1_ = v_st(32 + (t_ >> 4), (t_ & 15) * 8); \
                           *(LAS bf16x8*)(V_lds + (bf) * SHM_V + vs0_) = S.st_v0; *(LAS bf16x8*)(V_lds + (bf) * SHM_V + vs1_) = S.st_v1; } while (0)
__device__ __forceinline__ void fox_prime(const BlockRef& cur, LAS char* lds, Seam& S) {
    const int tid = threadIdx.x, wid = __builtin_amdgcn_readfirstlane(tid >> 6), lane = tid & 63, r32 = lane & 31, hi = lane >> 5;
    const int sr = tid >> 4, sc = (tid & 15) * 8; LAS char* K_lds = lds + 2 * SHM_V; LAS float* cumL = (LAS float*)(lds + OFF_CUM);
    const int kb0 = cur.j_lo * KVBLK;
#pragma unroll
    for (int d0 = 0; d0 < 8; ++d0) S.qr[d0] = ld8(cur.Q + (size_t)(wid * QBLK + r32) * PQ + d0 * 16 + hi * 8);
    SLOAD_H(cur, kb0, 0); VMW(); SWRITE_HK(0);
    __syncthreads();
}
__device__ __forceinline__ void fox_block(const BlockRef& cur, const BlockRef& nxt, int skv, LAS char* lds, Seam& S) {
    const int tid = threadIdx.x, wid = __builtin_amdgcn_readfirstlane(tid >> 6), lane = tid & 63, r32 = lane & 31, hi = lane >> 5;
    const int j_lo = cur.j_lo;
    int j_hi = (cur.P0 + QB - 1) / KVBLK + 1; if (j_hi > skv / KVBLK) j_hi = skv / KVBLK;
    const int NT = j_hi - j_lo;
    const int kbn = nxt.j_lo * KVBLK;
    const int qlo = cur.P0 + wid * QBLK;
    LAS char* V_lds = lds; LAS char* K_lds = lds + 2 * SHM_V; LAS float* cumL = (LAS float*)(lds + OFF_CUM);
    LAS float* ws = (LAS float*)(lds + OFF_WS) + wid * 64; LAS float* li_l = ws; LAS float* al_l = ws + 32;
    float m_reg = -1e30f, l_reg = 0; f32x16 o[4] = {};
    const int sr = tid >> 4, sc = (tid & 15) * 8;
    const int vb0 = (int)(unsigned)(uintptr_t)V_lds + v_rd_base(lane);
#define RESC(a) do { if (__any((a) < 1.f)) { if (hi == 0) al_l[r32] = (a); asm volatile("s_waitcnt lgkmcnt(0)" ::: "memory");              \
                     _Pragma("unroll") for (int d_ = 0; d_ < 4; ++d_) _Pragma("unroll") for (int r = 0; r < 16; ++r) o[d_][r] *= al_l[crow(r, hi)]; } } while (0)
#define KBASE(t) ((j_lo + (t)) * KVBLK)
#define MASKT(P0_, P1_, t) do { const int kb_ = KBASE(t); if (kb_ + KVBLK - 1 > qlo) { int lc_ = lane; asm volatile("" : "+v"(lc_)); mask_tile(P0_, P1_, qlo + (lc_ & 31) - 4 * (lc_ >> 5) - kb_, WINF); } } while (0)
    constexpr int NQL = 8;
#define SEAM_K0() do { VMWN(NQL); SWRITE_HK(0); SBAR(); } while (0)
    f32x16 pA0, pA1, pB0, pB1; float mnA, mnB, alA, alB; bf16x8 pa0, pa1, pa2, pa3;
    SWRITE_HV(0); SBAR();
    if (NT > 1) { SLOAD_H(cur, KBASE(1), 1); }
    SBAR(); qkt<0>(pA0, pA1, K_lds, cumL, r32, hi, S.qr);
    MASKT(pA0, pA1, 0); partialSM(pA0, pA1, m_reg, mnA, alA);
    if (NT > 1) { VMW(); SWRITE_HV(1); SWRITE_HK(1); }
    __syncthreads();
#define HALF_STEP(PX0, PX1, mnX, alX, PY0, PY1, alY, t, KB, VB, SB) do {                                                      \
        SBAR(); qkt<KB>(PX0, PX1, K_lds, cumL, r32, hi, S.qr);                                                                \
        finishSM(PY0, PY1, alY, l_reg, pa0, pa1, pa2, pa3); SBAR();                                                           \
        if ((t) + 1 < NT) { SLOAD_H(cur, KBASE((t) + 1), SB); SBAR(); }                                                           \
        pv_tile<VB>(o, vb0, pa0, pa1, pa2, pa3); MASKT(PX0, PX1, (t)); partialSM(PX0, PX1, m_reg, mnX, alX);                  \
        __syncthreads();                                                                                                      \
        if ((t) + 1 < NT) { VMW(); SWRITE_HV(SB); SWRITE_HK(SB); }                                       \
        RESC(alX); __syncthreads(); } while (0)
    for (int t = 1; t + 1 < NT; t += 2) {
        HALF_STEP(pB0, pB1, mnB, alB, pA0, pA1, alA, t, 1, 0, 0);
        HALF_STEP(pA0, pA1, mnA, alA, pB0, pB1, alB, t + 1, 0, 1, 1);
    }
    const bool even = (NT & 1) == 0;
    if (even) { SBAR(); qkt<1>(pB0, pB1, K_lds, cumL, r32, hi, S.qr); SBAR(); }
    SLOAD_H(nxt, kbn, 0); SBAR();
    { int lc_ = lane; asm volatile("" : "+v"(lc_)); const bf16_t* qp_ = nxt.Q + (size_t)(wid * QBLK + (lc_ & 31)) * PQ + (lc_ >> 5) * 8;
#pragma unroll
    for (int d0 = 0; d0 < 8; ++d0) S.qr[d0] = ld8(qp_ + d0 * 16); }
    SBAR();
    finishSM(pA0, pA1, alA, l_reg, pa0, pa1, pa2, pa3); SBAR();
    pv_tile<0>(o, vb0, pa0, pa1, pa2, pa3);
    if (even) { MASKT(pB0, pB1, NT - 1); partialSM(pB0, pB1, m_reg, mnB, alB); __syncthreads(); RESC(alB);
        finishSM(pB0, pB1, alB, l_reg, pa0, pa1, pa2, pa3); SBAR(); pv_tile<1>(o, vb0, pa0, pa1, pa2, pa3); }
    SBAR(); SEAM_K0();
    if (hi == 0) li_l[r32] = l_reg; asm volatile("s_waitcnt lgkmcnt(0)" ::: "memory");
    float rli[16];
#pragma unroll
    for (int r = 0; r < 16; ++r) rli[r] = __builtin_amdgcn_rcpf(li_l[crow(r, hi)]);
    { int lc_ = lane; asm volatile("" : "+v"(lc_)); const int r32c = lc_ & 31, hic = lc_ >> 5;
    bf16_t* Ow = cur.O + (size_t)(wid * QBLK + 4 * hic) * PO + r32c;
#pragma unroll
    for (int r = 0; r < 16; ++r) { const int orow = (r & 3) + 8 * (r >> 2);
#pragma unroll
        for (int d0 = 0; d0 < 4; ++d0) { const float v = o[d0][r] * rli[r];
            const float vn = __shfl_xor(v, 1);
            if ((r32c & 1) == 0) *(unsigned*)(Ow + (size_t)orow * PO + d0 * 32) = cvtpk(v, vn); } } }
    __syncthreads();
#undef RESC
#undef KBASE
#undef MASKT
#undef SEAM_K0
#undef HALF_STEP
}
#undef ROWP
#undef VMW
#undef VMWN
#undef SLOAD_H
#undef SWRITE_HK
#undef SWRITE_HV
#undef SBAR
#undef KSWZ
}

typedef GAS unsigned gu32;
#define RLX_AGENT __ATOMIC_RELAXED, __HIP_MEMORY_SCOPE_AGENT
#define XB_TMO      128
#define XB_XCNT(j)  (256  + 64 * (j))
#define XB_XSUB(j)  (1280 + 64 * (j))
#define XB_XGEN(j)  (2304 + 64 * (j))
#define XB_TOP      3328
#define XB_TOPGEN   3392
#define XCD_BAR_WORDS 3456
#define XB_SPIN_CAP (1u << 20)
__device__ __forceinline__ unsigned xb_ld(unsigned* p)              { return __hip_atomic_load(p, __ATOMIC_RELAXED, __HIP_MEMORY_SCOPE_AGENT); }
__device__ __forceinline__ unsigned xb_add(unsigned* p, unsigned v) { return __hip_atomic_fetch_add(p, v, __ATOMIC_RELAXED, __HIP_MEMORY_SCOPE_AGENT); }
__device__ __forceinline__ unsigned xb_xcc_id() { return (unsigned)__builtin_amdgcn_s_getreg((3 << 11) | 20) & 0xFu; }
#define XB_SPIN(cond, bar) do { unsigned _sp = 0; while (cond) { __builtin_amdgcn_s_sleep(1); \
    if ((++_sp & 255u) == 0u) { if (xb_ld(&(bar)[XB_TMO])) break; if (_sp > XB_SPIN_CAP) { atomicAdd(&(bar)[XB_TMO], 1u); break; } } } } while (0)
struct XcdBarrier { unsigned* bar; unsigned x; volatile LAS unsigned* st; };
__device__ __forceinline__ XcdBarrier xcd_barrier_post(unsigned* bar, volatile LAS unsigned* st) {
    XcdBarrier b; b.bar = bar; b.x = xb_xcc_id(); b.st = st;
    if (threadIdx.x == 0) (void)xb_add(&bar[XB_XCNT(b.x)], 1u);
    return b;
}
__device__ __forceinline__ void xcd_barrier_complete(unsigned* bar, unsigned x, unsigned& nloc, unsigned& nx) {
    const unsigned G = gridDim.x * gridDim.y * gridDim.z;
    unsigned sum, cnt, mine, sp = 0u;
    for (;;) {
        sum = 0u; cnt = 0u; mine = 0u;
#pragma unroll
        for (unsigned j = 0; j < 16; ++j) { const unsigned c = xb_ld(&bar[XB_XCNT(j)]); sum += c; cnt += (c > 0u) ? 1u : 0u; mine = (j == x) ? c : mine; }
        if (sum == G) break;
        __builtin_amdgcn_s_sleep(1);
        if ((++sp & 255u) == 0u) { if (xb_ld(&bar[XB_TMO])) break; if (sp > XB_SPIN_CAP) { atomicAdd(&bar[XB_TMO], 1u); break; } }
    }
    nloc = mine > 0u ? mine : 1u; nx = cnt > 0u ? cnt : 1u;
}
__device__ __forceinline__ void xcd_barrier(const XcdBarrier& b) {
    asm volatile("s_waitcnt vmcnt(0)" ::: "memory");
    __syncthreads();
    if (threadIdx.x == 0) {
        unsigned* bar = b.bar;
        __builtin_amdgcn_s_waitcnt(0);
        unsigned nloc = b.st[0], nx = b.st[1];
        if (nloc == 0u) { xcd_barrier_complete(bar, b.x, nloc, nx); b.st[0] = nloc; b.st[1] = nx; }
        const unsigned old = xb_add(&bar[XB_XSUB(b.x)], 1u);
        const unsigned gen = old / nloc;
        if (old + 1u == (gen + 1u) * nloc) {
            __builtin_amdgcn_fence(__ATOMIC_RELEASE, "agent");
            asm volatile("s_waitcnt vmcnt(0)" ::: "memory");
            const unsigned og = xb_add(&bar[XB_TOP], 1u);
            const unsigned tg = og / nx;
            if (og + 1u == (tg + 1u) * nx) xb_add(&bar[XB_TOPGEN], 1u);
            else XB_SPIN(xb_ld(&bar[XB_TOPGEN]) == tg, bar);
            __builtin_amdgcn_fence(__ATOMIC_ACQUIRE, "agent");
            xb_add(&bar[XB_XGEN(b.x)], 1u);
            asm volatile("s_waitcnt vmcnt(0)" ::: "memory");
        } else {
            XB_SPIN(xb_ld(&bar[XB_XGEN(b.x)]) == gen, bar);
            __builtin_amdgcn_fence(__ATOMIC_ACQUIRE, "agent");
            asm volatile("s_waitcnt vmcnt(0)" ::: "memory");
        }
    }
    __syncthreads();
}

constexpr int NWAVES = 8;
constexpr int N_PHASES = 12;
constexpr int N_LAUNCHES = MK_N_LAUNCHES;
static_assert(N_LAUNCHES == 1 || N_LAUNCHES == N_PHASES, "MK_N_LAUNCHES is 1 (one dispatch) or 12 (one dispatch per phase)");
struct Args { const float* in[29]; float* out; unsigned char* ws; int ph_lo, ph_hi; };
struct Frame {
    LAS unsigned char* lds; volatile LAS unsigned* MISC; gu32* ctl; unsigned char* ws;
    int tid, lane, wave, vcu, G;
};

struct TileRef { const float* src; void* dst; int ld_src, ld_dst, f8; };
__device__ __forceinline__ void p0_tile_load(const TileRef& t, f32x4 (&v)[16], int lane) {
    const int c4 = lane & 7, r8 = lane >> 3;
#pragma unroll
    for (int it = 0; it < 16; ++it) v[it] = *(const f32x4*)(t.src + (size_t)(it * 8 + r8) * t.ld_src + 4 * c4);
}
__device__ __forceinline__ void p0_tile_store(const TileRef& t, const f32x4 (&v)[16], LAS float* scr, int lane) {
    const int c4 = lane & 7, r8 = lane >> 3;
#pragma unroll
    for (int it = 0; it < 16; ++it) { const int r = it * 8 + r8;
#pragma unroll
        for (int e = 0; e < 4; ++e) scr[(4 * c4 + e) * 132 + r] = v[it][e]; }
    LDS_WAIT(); asm volatile("" ::: "memory");
    const int kc = lane & 15, n4 = lane >> 4;
#pragma unroll
    for (int it = 0; it < 8; ++it) { const int n = it * 4 + n4;
        const f32x4 a = *(const LAS f32x4*)(scr + n * 132 + 8 * kc), b = *(const LAS f32x4*)(scr + n * 132 + 8 * kc + 4);
        if (t.f8) { int lo = 0, hi = 0;
            lo = __builtin_amdgcn_cvt_pk_fp8_f32(a[0] * W8SCALE, a[1] * W8SCALE, lo, false); lo = __builtin_amdgcn_cvt_pk_fp8_f32(a[2] * W8SCALE, a[3] * W8SCALE, lo, true);
            hi = __builtin_amdgcn_cvt_pk_fp8_f32(b[0] * W8SCALE, b[1] * W8SCALE, hi, false); hi = __builtin_amdgcn_cvt_pk_fp8_f32(b[2] * W8SCALE, b[3] * W8SCALE, hi, true);
            *(u32x2*)((unsigned char*)t.dst + (size_t)n * t.ld_dst + 8 * kc) = (u32x2){(unsigned)lo, (unsigned)hi}; }
        else { u32x4 w; w.x = cvt_pk_bf16(a[0], a[1]); w.y = cvt_pk_bf16(a[2], a[3]); w.z = cvt_pk_bf16(b[0], b[1]); w.w = cvt_pk_bf16(b[2], b[3]);
            *(u32x4*)((bf16_t*)t.dst + (size_t)n * t.ld_dst + 8 * kc) = w; } }
    LDS_WAIT(); asm volatile("" ::: "memory");
}
template <int MODE, int F8>
__device__ __forceinline__ TileRef p0_mat_ref(const float* src, int ldsrc, int K, int N, void* dst, int which, int it) {
    const int nblk = N / 32, kb = it / nblk, nb = it - kb * nblk, k0 = 128 * kb, n0 = 32 * nb;
    const int drow = MODE == 0 ? n0 : ((n0 >> 7) * 256 + which * 128 + (n0 & 127));
    TileRef t; t.src = src + (size_t)k0 * ldsrc + n0; t.ld_src = ldsrc; t.f8 = F8; t.ld_dst = K;
    t.dst = F8 ? (void*)((unsigned char*)dst + (size_t)drow * K + k0) : (void*)((bf16_t*)dst + (size_t)drow * K + k0); return t;
}
__device__ __forceinline__ void p0_prologue(Frame& F, const __attribute__((address_space(4))) Args& a) {
    unsigned char* ws = F.ws;
    const int gw = F.vcu * NWAVES + F.wave, NGW = F.G * NWAVES;
    {
        LAS float* scr = (LAS float*)(F.lds + F.wave * 16896);
        constexpr int I_EXP = 256;
        constexpr int N_EG = NEXP * I_EXP, N_EU = N_EG, N_ED = N_EG;
        constexpr int I_IN = 16 * 128, I_OUT = 16 * 64, I_GLU = 8 * 32, I_R = 16 * 2, I_SG = 16 * 16, I_SU = 16 * 16, I_SD = 4 * 64;
        constexpr int NITEMS = N_EG + N_EU + N_ED + I_IN + I_OUT + I_GLU + I_R + I_SG + I_SU + I_SD;
        unsigned char* Wegu = ws + WS_WEGU; unsigned char* Wed = ws + WS_WED;
#define P0_REF(T, it_) do { int r = (it_); \
            if (r < N_EG) { const int e = r / I_EXP; T = p0_mat_ref<1, 1>(a.in[21] + (size_t)e * 2048 * 512, 512, 2048, 512, Wegu + (size_t)e * 1024 * 2048, 0, r % I_EXP); break; } r -= N_EG; \
            if (r < N_EU) { const int e = r / I_EXP; T = p0_mat_ref<1, 1>(a.in[22] + (size_t)e * 2048 * 512, 512, 2048, 512, Wegu + (size_t)e * 1024 * 2048, 1, r % I_EXP); break; } r -= N_EU; \
            if (r < N_ED) { const int e = r / I_EXP; T = p0_mat_ref<0, 1>(a.in[23] + (size_t)e * 512 * 2048, 2048, 512, 2048, Wed + (size_t)e * 2048 * 512, 0, r % I_EXP); break; } r -= N_ED; \
            if (r < I_IN) { T = p0_mat_ref<0, 0>(a.in[4], 4104, 2048, 4096, (bf16_t*)(ws + WS_WIN), 0, r); break; } r -= I_IN; \
            if (r < I_OUT) { T = p0_mat_ref<0, 0>(a.in[16], 2048, 2048, 2048, (bf16_t*)(ws + WS_WOUT), 0, r); break; } r -= I_OUT; \
            if (r < I_GLU) { T = p0_mat_ref<0, 0>(a.in[14], 1024, 1024, 1024, (bf16_t*)(ws + WS_WGLU), 0, r); break; } r -= I_GLU; \
            if (r < I_R) { T = p0_mat_ref<0, 0>(a.in[19], 64, 2048, 64, (bf16_t*)(ws + WS_WR), 0, r); break; } r -= I_R; \
            if (r < I_SG) { T = p0_mat_ref<1, 1>(a.in[24], 512, 2048, 512, (ws + WS_WSGU), 0, r); break; } r -= I_SG; \
            if (r < I_SU) { T = p0_mat_ref<1, 1>(a.in[25], 512, 2048, 512, (ws + WS_WSGU), 1, r); break; } r -= I_SU; \
            T = p0_mat_ref<0, 1>(a.in[26], 2048, 512, 2048, (ws + WS_WSD), 0, r); } while (0)
        int it = gw;
        if (it < NITEMS) {
            TileRef tc, tn; f32x4 vc[16], vn[16];
            P0_REF(tc, it); p0_tile_load(tc, vc, F.lane);
            for (;;) {
                const int itn = it + NGW; const bool more = itn < NITEMS;
                if (more) { P0_REF(tn, itn); p0_tile_load(tn, vn, F.lane); }
                p0_tile_store(tc, vc, scr, F.lane);
                if (!more) break;
#pragma unroll
                for (int i = 0; i < 16; ++i) vc[i] = vn[i];
                tc = tn; it = itn;
            }
        }
#undef P0_REF
    }
    __syncthreads();
    if (F.vcu < NGRP) {
        const int g = F.vcu, t = F.tid;
        LAS float* apr = (LAS float*)F.lds;
        LAS float* api = apr + 64 * 33;
        LAS float* bbr = api + 64 * 33;
        LAS float* bbi = bbr + 1024;
        LAS float* cr = bbi + 1024;
        LAS float* ci = cr + 1024;
        LAS float* kg = ci + 1024;
        LAS float* dsk = kg + 8192;
        const float* a_re = a.in[6]; const float* a_im = a.in[7]; const float* log_dt = a.in[8];
        const float* b_re = a.in[9]; const float* b_im = a.in[10]; const float* c_re = a.in[11]; const float* c_im = a.in[12]; const float* dsk_g = a.in[13];
        if (t < 64) { const int p = t; const float ar = a_re[g * 64 + p], ai = a_im[g * 64 + p], dt = expf(log_dt[g]);
            for (int tau = 0; tau <= 32; ++tau) { const float m = expf((float)tau * dt * ar); float s, c; sincosf((float)tau * dt * ai, &s, &c); apr[p * 33 + tau] = m * c; api[p * 33 + tau] = m * s; }
            const float abr = apr[p * 33 + 1] - 1.f, abi = api[p * 33 + 1], den = ar * ar + ai * ai;
            const float cre = (abr * ar + abi * ai) / den, cim = (abi * ar - abr * ai) / den;
            for (int h = 0; h < 16; ++h) { const float br = b_re[(g * 64 + p) * 16 + h], bi = b_im[(g * 64 + p) * 16 + h]; bbr[p * 16 + h] = cre * br - cim * bi; bbi[p * 16 + h] = cre * bi + cim * br; } }
        for (int idx = t; idx < 1024; idx += 512) { cr[idx] = c_re[g * 1024 + idx]; ci[idx] = c_im[g * 1024 + idx]; }
        if (t < 16) dsk[t] = dsk_g[g * 16 + t];
        __syncthreads();
        for (int idx = t; idx < 8192; idx += 512) { const int tau = idx >> 8, hp = (idx >> 4) & 15, h = idx & 15; float acc = 0.f;
            for (int p = 0; p < 64; ++p) { const float c_r = cr[hp * 64 + p], c_i = ci[hp * 64 + p], pr = apr[p * 33 + tau], pi = api[p * 33 + tau];
                const float gr = c_r * pr - c_i * pi, gi = c_r * pi + c_i * pr; acc += gr * bbr[p * 16 + h] - gi * bbi[p * 16 + h]; }
            if (tau == 0 && hp == h) acc += dsk[h];
            kg[idx] = acc; }
        __syncthreads();
        bf16_t* OPY = (bf16_t*)(ws + WS_OPY) + (size_t)g * 512 * UGK;
        for (int it = t; it < 512 * 80; it += 512) { const int n = it / 80, ch = it - n * 80, tt = n >> 4, hp = n & 15; float v[8];
            if (ch < 64) { const int j = ch >> 1, h0 = (ch & 1) * 8;
#pragma unroll
                for (int e = 0; e < 8; ++e) v[e] = (tt >= j) ? kg[(tt - j) * 256 + hp * 16 + h0 + e] : 0.f; }
            else { const int q = ch - 64;
#pragma unroll
                for (int e2 = 0; e2 < 4; ++e2) { const int p = q * 4 + e2; const float c_r = cr[hp * 64 + p], c_i = ci[hp * 64 + p], pr = apr[p * 33 + tt + 1], pi = api[p * 33 + tt + 1];
                    v[2 * e2] = c_r * pr - c_i * pi; v[2 * e2 + 1] = -(c_r * pi + c_i * pr); } }
            u32x4 w; w.x = cvt_pk_bf16(v[0], v[1]); w.y = cvt_pk_bf16(v[2], v[3]); w.z = cvt_pk_bf16(v[4], v[5]); w.w = cvt_pk_bf16(v[6], v[7]);
            *(u32x4*)(OPY + (size_t)n * UGK + ch * 8) = w; }
        bf16_t* OPE = (bf16_t*)(ws + WS_OPE) + (size_t)g * 256 * 512;
        for (int it = t; it < 256 * 64; it += 512) { const int n = it >> 6, ch = it & 63; float v[8];
            if (n < 128) { const int p = n >> 1, ri = n & 1, j = ch >> 1, h0 = (ch & 1) * 8; const float pr = apr[p * 33 + 31 - j], pi = api[p * 33 + 31 - j];
#pragma unroll
                for (int e = 0; e < 8; ++e) { const float br = bbr[p * 16 + h0 + e], bi = bbi[p * 16 + h0 + e]; v[e] = ri == 0 ? (pr * br - pi * bi) : (pr * bi + pi * br); } }
            else {
#pragma unroll
                for (int e = 0; e < 8; ++e) v[e] = 0.f; }
            u32x4 w; w.x = cvt_pk_bf16(v[0], v[1]); w.y = cvt_pk_bf16(v[2], v[3]); w.z = cvt_pk_bf16(v[4], v[5]); w.w = cvt_pk_bf16(v[6], v[7]);
            *(u32x4*)(OPE + (size_t)n * 512 + ch * 8) = w; }
    }
    __syncthreads();
    {
        const int gt = F.vcu * 512 + F.tid, NGT = F.G * 512; const u32x4 z4 = {0u, 0u, 0u, 0u};
        for (int i = gt; i < 2 * 2 * 48 * 128; i += NGT) { const int ch = i & 127, r = (i >> 7) % 48, b = ((i >> 7) / 48) & 1, kv = (i >> 7) / 96;
            bf16_t* base = (bf16_t*)(ws + (kv ? WS_V : WS_K)); *(u32x4*)(base + ((size_t)b * KVR + r) * 1024 + ch * 8) = z4; }
        for (int i = gt; i < 128 * 32; i += NGT) { const int ch = i & 31, gb = i >> 5;
            *(u32x4*)((bf16_t*)(ws + WS_UG) + ((size_t)gb * NCHK + 1) * UGK + ch * 8) = z4; }
        for (int i = gt; i < 16 * 48; i += NGT) { const int r = i % 48, bh = i / 48; ((float*)(ws + WS_LOGF))[(size_t)bh * KVR + r] = 0.f; }
    }
    {
        LAS float* wf = (LAS float*)F.lds;
        for (int i = F.tid; i < 8 * 2048; i += 512) { const int h = i & 7, k = i >> 3; wf[h * 2048 + k] = a.in[4][(size_t)k * 4104 + 4096 + h]; }
        __syncthreads();
        const float* x = a.in[0]; const float* meta = a.in[1]; const float* lg = a.in[2]; const float* lb = a.in[3]; const float* bfg = a.in[5];
        bf16_t* XN = (bf16_t*)(ws + WS_XN); float* logf_ = (float*)(ws + WS_LOGF);
        for (int row = gw; row < MX + NMETA; row += NGW) {
            const float* src = row < MX ? x + (size_t)row * DM : meta + (size_t)(row - MX) * DM;
            f32x4 v[8]; float s = 0.f;
#pragma unroll
            for (int j = 0; j < 8; ++j) { v[j] = ((const f32x4*)src)[j * 64 + F.lane]; s += (v[j][0] + v[j][1]) + (v[j][2] + v[j][3]); }
            const float mean = wave_sum(s) * (1.f / DM); float s2 = 0.f;
#pragma unroll
            for (int j = 0; j < 8; ++j) { v[j] = v[j] - mean; s2 += (v[j][0] * v[j][0] + v[j][1] * v[j][1]) + (v[j][2] * v[j][2] + v[j][3] * v[j][3]); }
            const float rstd = 1.f / sqrtf(wave_sum(s2) * (1.f / DM) + LN_EPS);
            float fl[8];
#pragma unroll
            for (int h = 0; h < 8; ++h) fl[h] = 0.f;
#pragma unroll
            for (int j = 0; j < 8; ++j) { const f32x4 g4 = ((const f32x4*)lg)[j * 64 + F.lane], b4 = ((const f32x4*)lb)[j * 64 + F.lane];
                v[j] = v[j] * rstd * g4 + b4;
                *(u32x2*)(XN + (size_t)row * DM + j * 256 + F.lane * 4) = (u32x2){cvt_pk_bf16(v[j][0], v[j][1]), cvt_pk_bf16(v[j][2], v[j][3])};
#pragma unroll
                for (int h = 0; h < 8; ++h) { const f32x4 w4 = *(const LAS f32x4*)(wf + h * 2048 + j * 256 + F.lane * 4); fl[h] += (v[j][0] * w4[0] + v[j][1] * w4[1]) + (v[j][2] * w4[2] + v[j][3] * w4[3]); } }
#pragma unroll
            for (int h = 0; h < 8; ++h) fl[h] = wave_sum(fl[h]);
            if (F.lane < 8) { const int h = F.lane;
                float val = h == 0 ? fl[0] : h == 1 ? fl[1] : h == 2 ? fl[2] : h == 3 ? fl[3] : h == 4 ? fl[4] : h == 5 ? fl[5] : h == 6 ? fl[6] : fl[7];
                val += bfg[h];
                const float lf = fminf(val, 0.f) - log1pf(expf(-fabsf(val)));
                if (row < MX) { const int b = row >> 13, sx = row & (SEQ - 1); logf_[(size_t)(b * 8 + h) * KVR + 64 + sx] = lf; }
                else { const int i = row - MX; logf_[(size_t)(0 * 8 + h) * KVR + 48 + i] = lf; logf_[(size_t)(1 * 8 + h) * KVR + 48 + i] = lf; } }
        }
    }
    {
        __syncthreads();
        LAS float* hm = (LAS float*)F.lds;
        const float* meta = a.in[1]; const float* lg = a.in[2]; const float* lb = a.in[3]; const float* w_in = a.in[4];
#pragma unroll 1
        for (int rr = 0; rr < 2; ++rr) { const int row = F.wave * 2 + rr; const float* src = meta + (size_t)row * DM;
            f32x4 v[8]; float s = 0.f;
#pragma unroll
            for (int j = 0; j < 8; ++j) { v[j] = ((const f32x4*)src)[j * 64 + F.lane]; s += (v[j][0] + v[j][1]) + (v[j][2] + v[j][3]); }
            const float mean = wave_sum(s) * (1.f / DM); float s2 = 0.f;
#pragma unroll
            for (int j = 0; j < 8; ++j) { v[j] = v[j] - mean; s2 += (v[j][0] * v[j][0] + v[j][1] * v[j][1]) + (v[j][2] * v[j][2] + v[j][3] * v[j][3]); }
            const float rstd = 1.f / sqrtf(wave_sum(s2) * (1.f / DM) + LN_EPS);
#pragma unroll
            for (int j = 0; j < 8; ++j) { const f32x4 g4 = ((const f32x4*)lg)[j * 64 + F.lane], b4 = ((const f32x4*)lb)[j * 64 + F.lane];
                *(LAS f32x4*)(hm + row * 2048 + j * 256 + F.lane * 4) = v[j] * rstd * g4 + b4; } }
        __syncthreads();
        for (int c = F.vcu; c < 256; c += F.G) {
            const int col0 = 16 * c, sect = col0 >> 10; if (sect == 1) continue;
            const int r = F.tid >> 5, ks = F.tid & 31;
            f32x4 a0 = {0.f, 0.f, 0.f, 0.f}, a1 = a0, a2 = a0, a3 = a0;
#pragma unroll 4
            for (int i = 0; i < 64; ++i) { const int k = ks + 32 * i; const float h = hm[r * 2048 + k]; const f32x4* wp = (const f32x4*)(w_in + (size_t)k * 4104 + col0);
                a0 += h * wp[0]; a1 += h * wp[1]; a2 += h * wp[2]; a3 += h * wp[3]; }
#pragma unroll
            for (int o = 1; o < 32; o <<= 1) {
#pragma unroll
                for (int e = 0; e < 4; ++e) { a0[e] += __shfl_xor(a0[e], o); a1[e] += __shfl_xor(a1[e], o); a2[e] += __shfl_xor(a2[e], o); a3[e] += __shfl_xor(a3[e], o); } }
            if (ks == 0) { const int colsec = col0 & 1023;
                const u32x4 w0 = {cvt_pk_bf16(a0[0], a0[1]), cvt_pk_bf16(a0[2], a0[3]), cvt_pk_bf16(a1[0], a1[1]), cvt_pk_bf16(a1[2], a1[3])};
                const u32x4 w1 = {cvt_pk_bf16(a2[0], a2[1]), cvt_pk_bf16(a2[2], a2[3]), cvt_pk_bf16(a3[0], a3[1]), cvt_pk_bf16(a3[2], a3[3])};
#pragma unroll
                for (int b = 0; b < 2; ++b) { bf16_t* dst;
                    if (sect == 0) dst = (bf16_t*)(ws + WS_UG) + ((size_t)(((colsec >> 4) * 2 + b) * NCHK + 1)) * UGK + (16 + r) * 16;
                    else dst = (bf16_t*)(ws + (sect == 2 ? WS_K : WS_V)) + ((size_t)b * KVR + 48 + r) * 1024 + colsec;
                    *(u32x4*)dst = w0; *(u32x4*)(dst + 8) = w1; } }
        }
    }
}

__device__ __forceinline__ void p1_cumsum(Frame& F, int seq) {
    const float* lf = (const float*)(F.ws + WS_LOGF) + (size_t)seq * KVR; float* cum = (float*)(F.ws + WS_CUM) + (size_t)seq * KVR;
    LAS float* part = (LAS float*)F.lds;
    constexpr int PER = 17; const int i0 = F.tid * PER; float s = 0.f;
    for (int k = 0; k < PER; ++k) { const int i = i0 + k; if (i < KVR) s += lf[i]; }
    part[F.tid] = s; __syncthreads();
    float pre = 0.f; for (int j = 0; j < F.tid; ++j) pre += part[j];
    for (int k = 0; k < PER; ++k) { const int i = i0 + k; if (i < KVR) { pre += lf[i]; cum[i] = (i < 48) ? -__builtin_inff() : -pre * LOG2E; } }
    __syncthreads();
}

__device__ __forceinline__ void moe_tables(Frame& F) {
    LAS int* tb = (LAS int*)(F.lds + TB_OFF);
    if (F.tid < NEXP) tb[130 + F.tid] = (int)__hip_atomic_load(F.ctl + CW_CNT + 64 * F.tid, RLX_AGENT);
    __syncthreads();
    if (F.tid == 0) { int tp = 0, cp = 0; for (int e = 0; e < NEXP; ++e) { tb[e] = tp; tb[65 + e] = cp; const int c = tb[130 + e]; tp += (c + 255) >> 8; cp += c; } tb[64] = tp; tb[129] = cp; }
    __syncthreads();
}

template <unsigned MASK>
__global__ void __launch_bounds__(NWAVES * 64, 2) hymba_fwd(Args args_) {
    extern __shared__ __attribute__((aligned(16))) unsigned char lds[];
    (void)args_;
    const __attribute__((address_space(4))) Args& args = *(const __attribute__((address_space(4))) Args*)__builtin_amdgcn_kernarg_segment_ptr();
    Frame F;
    F.lds = (LAS unsigned char*)lds;
    F.MISC = (volatile LAS unsigned*)(F.lds + MISC_OFF);
    F.tid = threadIdx.x; F.lane = F.tid & 63; F.wave = __builtin_amdgcn_readfirstlane(F.tid >> 6);
    F.G = gridDim.x; { const int bx = blockIdx.x; F.vcu = (F.G % 8 == 0) ? (bx % 8) * (F.G / 8) + bx / 8 : bx; }
    unsigned char* ws = args.ws; F.ws = ws;
    F.ctl = (gu32*)(ws + WS_CTL);
    for (int u = F.tid; u < (LDS_BYTES - LDSCTL_OFF) / 4; u += NWAVES * 64) ((LAS unsigned*)(F.lds + LDSCTL_OFF))[u] = 0u;
    __syncthreads();
    XcdBarrier bar; bar.bar = (unsigned*)(F.ctl + CW_BAR); bar.x = 0; bar.st = nullptr;
    if (N_LAUNCHES == 1) bar = xcd_barrier_post((unsigned*)(F.ctl + CW_BAR), F.MISC + 8);
#define GRID_BAR() do { if (N_LAUNCHES == 1) xcd_barrier(bar); } while (0)
    const int lo = args.ph_lo, hi = args.ph_hi;
#define IN(k) (((MASK >> (k)) & 1u) && lo <= (k) && (k) < hi)
#define BOTH(k) (IN(k) && IN((k) + 1))
#ifndef REP_PH
#define REP_PH -1
#endif
#define REPS(k) for (int rep_ = 0; rep_ < ((REP_PH) == (k) ? 2 : 1); ++rep_)
    const int gw = F.vcu * NWAVES + F.wave, NGW = F.G * NWAVES;
    const int bx = (int)blockIdx.x;

    if (IN(0)) { REPS(0) { p0_prologue(F, args); __syncthreads(); } if (BOTH(0)) GRID_BAR(); }

    if (IN(1)) {
        if (F.vcu < 16) p1_cumsum(F, F.vcu);
        pg8::DenseOrder S; S.init(ws + WS_XN, ws + WS_WIN, DM, DM, MX, 4096, F.G, bx);
        pg8::EpiInProj E{(bf16_t*)(ws + WS_UG), (bf16_t*)(ws + WS_Q), (bf16_t*)(ws + WS_K), (bf16_t*)(ws + WS_V)};
        REPS(1) pg8::gemm_phase<pg8::EpiInProj, pg8::DenseOrder, true>(F.lds, pg8::GemmK{DM, DM, DM}, S, E);
        if (BOTH(1)) GRID_BAR();
    }

    if (IN(2)) {
        REPS(2)
        for (int L = bx; L < 256; L += F.G) {
            const int g = L >> 2, b = (L >> 1) & 1, pn = L & 1, gb = g * 2 + b;
            { pg8::OneUnit S; S.u.A = (const char*)(ws + WS_UG) + ((size_t)(gb * NCHK + 1)) * UGK * 2; S.u.B = (const char*)(ws + WS_OPE) + (size_t)g * 256 * 512 * 2; S.u.rows = nullptr;
              S.u.r0 = gb * 256; S.u.c0 = 0; S.u.valid = 256; S.u.aux = g; S.rowbytes = UGK * 2;
              pg8::EpiE E{(float*)(ws + WS_E)};
              pg8::gemm_phase<pg8::EpiE, pg8::OneUnit, false>(F.lds, pg8::GemmK{512, UGK, 512}, S, E); }
            VM_WAIT(); __syncthreads();
            if (F.wave == 0) {
                __builtin_amdgcn_fence(__ATOMIC_ACQUIRE, "agent");
                const int p = F.lane;
                const float dt = expf(args.in[8][g]), ar = args.in[6][g * 64 + p], ai = args.in[7][g * 64 + p];
                const float mag = expf(32.f * dt * ar); float sn, cs; sincosf(32.f * dt * ai, &sn, &cs);
                const float a_r = mag * cs, a_i = mag * sn;
                const float* Eb = (const float*)(ws + WS_E) + (size_t)gb * 256 * 128 + 2 * p;
                bf16_t* Ub = (bf16_t*)(ws + WS_UG) + (size_t)gb * NCHK * UGK + 512 + 2 * p;
                float sr = 0.f, si = 0.f;
#pragma unroll 16
                for (int r = 0; r < 256; ++r) { const f32x2 e = *(const f32x2*)(Eb + (size_t)r * 128);
                    const float nr = a_r * sr - a_i * si + e[0], ni = a_r * si + a_i * sr + e[1]; sr = nr; si = ni;
                    *(unsigned*)(Ub + (size_t)(r + 2) * UGK) = cvt_pk_bf16(sr, si); }
            } else {
                const bf16_t* Qb = (const bf16_t*)(ws + WS_Q); const bf16_t* Kb = (const bf16_t*)(ws + WS_K);
                for (int it = (L * 7 + F.wave - 1); it < 1024 + 1032; it += 256 * 7) {
                    const bool isq = it < 1024; const int row0 = (isq ? it : it - 1024) * 16;
                    const bf16_t* base = (isq ? Qb : Kb) + (size_t)row0 * 1024 + F.lane * 8;
                    float mx0 = 0.f, mx1 = 0.f;
#pragma unroll 4
                    for (int r = 0; r < 16; ++r) {
#pragma unroll
                        for (int half = 0; half < 2; ++half) { const u32x4 w = *(const u32x4*)(base + (size_t)r * 1024 + half * 512);
                            float ss = bf_lo(w.x) * bf_lo(w.x) + bf_hi(w.x) * bf_hi(w.x) + bf_lo(w.y) * bf_lo(w.y) + bf_hi(w.y) * bf_hi(w.y) + bf_lo(w.z) * bf_lo(w.z) + bf_hi(w.z) * bf_hi(w.z) + bf_lo(w.w) * bf_lo(w.w) + bf_hi(w.w) * bf_hi(w.w);
                            ss += __shfl_xor(ss, 1); ss += __shfl_xor(ss, 2); ss += __shfl_xor(ss, 4); ss += __shfl_xor(ss, 8);
                            if (half == 0) mx0 = fmaxf(mx0, ss); else mx1 = fmaxf(mx1, ss); } }
                    if ((F.lane & 15) == 0) { const int g4 = F.lane >> 4;
                        if (isq) { const int bb = row0 >> 13, qb = (row0 & (SEQ - 1)) >> 8;
                            __hip_atomic_fetch_max(F.ctl + CW_QMAX + ((bb * 8 + g4) * 32 + qb), __float_as_uint(mx0), RLX_AGENT);
                            __hip_atomic_fetch_max(F.ctl + CW_QMAX + ((bb * 8 + 4 + g4) * 32 + qb), __float_as_uint(mx1), RLX_AGENT); }
                        else { const int bb = row0 / KVR;
                            __hip_atomic_fetch_max(F.ctl + CW_KMAX + (bb * 8 + g4), __float_as_uint(mx0), RLX_AGENT);
                            __hip_atomic_fetch_max(F.ctl + CW_KMAX + (bb * 8 + 4 + g4), __float_as_uint(mx1), RLX_AGENT); } }
                }
            }
            VM_WAIT(); __syncthreads();
            if (F.tid == 0) { __builtin_amdgcn_fence(__ATOMIC_ACQUIRE, "agent"); VM_WAIT(); }
            __syncthreads();
            { pg8::OneUnit S; S.u.A = (const char*)(ws + WS_UG) + ((size_t)(gb * NCHK + 2)) * UGK * 2; S.u.B = (const char*)(ws + WS_OPY) + ((size_t)g * 512 + pn * 256) * UGK * 2; S.u.rows = nullptr;
              S.u.r0 = b; S.u.c0 = pn; S.u.valid = 256; S.u.aux = g; S.rowbytes = UGK * 2;
              pg8::EpiY E{(bf16_t*)(ws + WS_YB)};
              pg8::gemm_phase<pg8::EpiY, pg8::OneUnit, false>(F.lds, pg8::GemmK{UGK, UGK, UGK}, S, E); }
        }
        if (BOTH(2)) GRID_BAR();
    }

    if (IN(5)) {
        pg8::DenseOrder S; S.init(ws + WS_YB, ws + WS_WGLU, 1024, 1024, MX, 1024, F.G, bx);
        pg8::EpiGlu E{(const bf16_t*)(ws + WS_YB), args.in[15], (bf16_t*)(ws + WS_YC)};
        REPS(5) pg8::gemm_phase<pg8::EpiGlu, pg8::DenseOrder, true>(F.lds, pg8::GemmK{1024, 1024, 1024}, S, E);
    }

    if (IN(6)) {
        const bf16_t* Qb = (const bf16_t*)(ws + WS_Q); const bf16_t* Kb = (const bf16_t*)(ws + WS_K); const bf16_t* Vb = (const bf16_t*)(ws + WS_V);
        bf16_t* YC = (bf16_t*)(ws + WS_YC); const float* nck = (const float*)(ws + WS_CUM);
        LAS char* al = (LAS char*)F.lds;
        LAS unsigned* skey = (LAS unsigned*)(F.lds + 71680);
        att::Seam S;
#define MKREF(R, key_) do { const int id_ = (int)((key_) & 511u), bh_ = id_ >> 5, qb_ = id_ & 31, b_ = bh_ >> 3, h_ = bh_ & 7; (R).Q = Qb + ((size_t)b_ * SEQ + (size_t)qb_ * 256) * 1024 + h_ * 128; \
        (R).K = Kb + (size_t)b_ * KVR * 1024 + h_ * 128; (R).V = Vb + (size_t)b_ * KVR * 1024 + h_ * 128; (R).O = YC + ((size_t)b_ * SEQ + (size_t)qb_ * 256) * 2048 + 1024 + h_ * 128; \
        (R).nck = nck + (size_t)bh_ * KVR; (R).P0 = 64 + qb_ * 256; (R).j_lo = (int)(((key_) >> 10) & 1023u); } while (0)
        REPS(6) {
        { const int id = F.tid, bh = id >> 5, qb = id & 31, P0 = 64 + qb * 256; const float* nk = nck + (size_t)bh * KVR;
          const float q2 = __uint_as_float(__hip_atomic_load(F.ctl + CW_QMAX + id, RLX_AGENT)), k2 = __uint_as_float(__hip_atomic_load(F.ctl + CW_KMAX + bh, RLX_AGENT));
          const float thr = nk[P0] - T_SKIP - 2.f * sqrtf(q2 * k2) * 1.001f;
          int lo_ = 0, hi_ = 4 * qb + 1;
          while (lo_ < hi_) { const int mid = (lo_ + hi_) >> 1; if (nk[64 * mid + 63] < thr) lo_ = mid + 1; else hi_ = mid; }
          skey[id] = ((unsigned)(4 * qb + 5 - lo_) << 20) | ((unsigned)lo_ << 10) | (unsigned)id; }
        for (int k = 2; k <= 512; k <<= 1)
            for (int j = k >> 1; j > 0; j >>= 1) { __syncthreads(); const int ixj = F.tid ^ j;
                if (ixj > F.tid) { const unsigned a = skey[F.tid], b = skey[ixj]; const bool up = (F.tid & k) == 0;
                    if (up ? (a < b) : (a > b)) { skey[F.tid] = b; skey[ixj] = a; } } }
        __syncthreads();
        int pi = F.vcu;
        if (pi < 256) {
            int pass = 0; att::BlockRef cur, nxt;
            { const unsigned key = skey[511 - pi]; MKREF(cur, key); }
            att::fox_prime(cur, al, S);
            for (;;) {
                const bool more_pass = pass == 0, more_item = pi + F.G < 256, last = !more_pass && !more_item;
                int pin = pi, passn = pass + 1;
                if (!more_pass) { passn = 0; pin = more_item ? pi + F.G : pi; }
                if (last) nxt = cur; else { const unsigned key = skey[passn ? pin : 511 - pin]; MKREF(nxt, key); }
                att::fox_block(cur, nxt, KVR, al, S);
                if (last) break;
                cur = nxt; pass = passn; pi = pin;
            }
        }
        __syncthreads();
        }
#undef MKREF
        if (BOTH(6)) GRID_BAR();
    }

    if (IN(7)) {
        pg8::DenseOrder S; S.init(ws + WS_YC, ws + WS_WOUT, 2048, 2048, MX, 2048, F.G, bx);
        pg8::EpiOut E{(const bf16_t*)(ws + WS_XN), (float*)(ws + WS_Z), (float*)(ws + WS_ST)};
        REPS(7) pg8::gemm_phase<pg8::EpiOut, pg8::DenseOrder, true>(F.lds, pg8::GemmK{2048, 2048, 2048}, S, E);
        if (BOTH(7)) GRID_BAR();
    }

    if (IN(8)) {
        const float* Z = (const float*)(ws + WS_Z); const float* ST = (const float*)(ws + WS_ST); bf16_t* H1 = (bf16_t*)(ws + WS_XN); unsigned char* H1F8 = ws + WS_H1F8;
        const bf16_t* WR = (const bf16_t*)(ws + WS_WR); const float* lg_ = args.in[17]; const float* lb_ = args.in[18]; const float* rbias = args.in[20];
        int* IDX = (int*)(ws + WS_IDX); float* GWt = (float*)(ws + WS_GW); int* RK = (int*)(ws + WS_RK); int* TOK = (int*)(ws + WS_TOK);
        LAS float* lgs = (LAS float*)(F.lds + F.wave * 4352);
        const int r16 = F.lane & 15, kq = F.lane >> 4;
        const float my_bias = rbias[F.lane];
        for (int rb = gw; rb < MX / 16; rb += NGW) {
            const int row = rb * 16 + r16;
            float s = 0.f, q = 0.f;
#pragma unroll
            for (int i = 0; i < 4; ++i) { const f32x4 t4 = *(const f32x4*)(ST + (size_t)row * 64 + kq * 16 + i * 4); s += t4[0] + t4[2]; q += t4[1] + t4[3]; }
            s += __shfl_xor(s, 16); s += __shfl_xor(s, 32); q += __shfl_xor(q, 16); q += __shfl_xor(q, 32);
            const float mean = s * (1.f / DM), var = fmaxf(q * (1.f / DM) - mean * mean, 0.f), rstd = 1.f / sqrtf(var + LN_EPS);
            f32x4 acc[4];
#pragma unroll
            for (int nb = 0; nb < 4; ++nb) acc[nb] = (f32x4){0.f, 0.f, 0.f, 0.f};
#pragma unroll 2
            for (int ks = 0; ks < 64; ++ks) { const int k0 = ks * 32 + kq * 8;
                const f32x4 z0 = *(const f32x4*)(Z + (size_t)row * DM + k0), z1 = *(const f32x4*)(Z + (size_t)row * DM + k0 + 4);
                const f32x4 g0 = *(const f32x4*)(lg_ + k0), g1 = *(const f32x4*)(lg_ + k0 + 4), b0 = *(const f32x4*)(lb_ + k0), b1 = *(const f32x4*)(lb_ + k0 + 4);
                const f32x4 y0 = (z0 - mean) * rstd * g0 + b0, y1 = (z1 - mean) * rstd * g1 + b1;
                const u32x4 w = pg8::pack8(y0, y1);
                *(u32x4*)(H1 + (size_t)row * DM + k0) = w;
                *(u32x2*)(H1F8 + (size_t)row * DM + k0) = pg8::pack8_fp8(y0, y1);
                const bf16x8 af = __builtin_bit_cast(bf16x8, w);
#pragma unroll
                for (int nb = 0; nb < 4; ++nb) { const bf16x8 bfm = *(const bf16x8*)(WR + (size_t)(nb * 16 + r16) * DM + k0);
                    acc[nb] = __builtin_amdgcn_mfma_f32_16x16x32_bf16(af, bfm, acc[nb], 0, 0, 0); } }
#pragma unroll
            for (int nb = 0; nb < 4; ++nb)
#pragma unroll
                for (int rg = 0; rg < 4; ++rg) lgs[(kq * 4 + rg) * 65 + nb * 16 + r16] = acc[nb][rg];
            LDS_WAIT(); asm volatile("" ::: "memory");
            for (int r = 0; r < 16; ++r) {
                const int trow = rb * 16 + r;
                const float score = fast_sigmoid(lgs[r * 65 + F.lane]);
                const float sel = score + my_bias;
                float m1 = sel; m1 = fmaxf(m1, __shfl_xor(m1, 1)); m1 = fmaxf(m1, __shfl_xor(m1, 2)); m1 = fmaxf(m1, __shfl_xor(m1, 4));
                int i1 = (sel == m1) ? F.lane : 1000; i1 = min(i1, __shfl_xor(i1, 1)); i1 = min(i1, __shfl_xor(i1, 2)); i1 = min(i1, __shfl_xor(i1, 4));
                float m2 = (F.lane == i1) ? -__builtin_inff() : sel; m2 = fmaxf(m2, __shfl_xor(m2, 1)); m2 = fmaxf(m2, __shfl_xor(m2, 2)); m2 = fmaxf(m2, __shfl_xor(m2, 4));
                const float gs = m1 + m2; const int mygrp = F.lane >> 3;
                int gcount = 0;
#pragma unroll
                for (int j = 0; j < 8; ++j) { const float gj = __shfl(gs, 8 * j); gcount += (gj > gs || (gj == gs && j < mygrp)) ? 1 : 0; }
                const bool cand = gcount < 4;
                const float cs = cand ? sel : -__builtin_inff();
                int rank = 0;
#pragma unroll 8
                for (int j = 0; j < 64; ++j) { const float cj = __shfl(cs, j); rank += (cj > cs || (cj == cs && j < F.lane)) ? 1 : 0; }
                const bool chosen = cand && rank < TOPK;
                const float tot = wave_sum(chosen ? score : 0.f);
                if (chosen) { const float gate = score / tot * ROUTED_SCALE;
                    const unsigned pos = __hip_atomic_fetch_add(F.ctl + CW_CNT + 64 * F.lane, 1u, RLX_AGENT);
                    TOK[(size_t)F.lane * MX + pos] = trow;
                    IDX[(size_t)trow * 8 + rank] = F.lane; GWt[(size_t)trow * 8 + rank] = gate; RK[(size_t)trow * 8 + rank] = (int)pos; }
            }
            LDS_WAIT(); asm volatile("" ::: "memory");
        }
        if (BOTH(8)) GRID_BAR();
    }

    if (IN(9)) {
        moe_tables(F);
        const LAS int* tb = (const LAS int*)(F.lds + TB_OFF);
        pg8::MoeOrder S; S.tb = tb; S.TT = tb[64]; S.NCT = 4; S.nsh = 64 * 4; S.nwg = S.TT * 4 + S.nsh; S.G = F.G; S.c = bx; S.lda = DM; S.ldb = DM;
        S.Aexp = (const char*)(ws + WS_H1F8); S.tok = (const int*)(ws + WS_TOK); S.Bexp = (const char*)(ws + WS_WEGU); S.bstride = (size_t)1024 * 2048;
        S.Ash = (const char*)(ws + WS_H1F8); S.Bsh = (const char*)(ws + WS_WSGU); S.gather = true;
        pg8::EpiGU E{ws + WS_HID, ws + WS_HIDS};
        REPS(9) pg8::gemm_phase<pg8::EpiGU, pg8::MoeOrder, true, true>(F.lds, pg8::GemmK{DM, DM, DM}, S, E);
        if (BOTH(9)) GRID_BAR();
    }

    if (IN(10)) {
        moe_tables(F);
        const LAS int* tb = (const LAS int*)(F.lds + TB_OFF);
        pg8::MoeOrder S; S.tb = tb; S.TT = tb[64]; S.NCT = 8; S.nsh = 64 * 8; S.nwg = S.TT * 8 + S.nsh; S.G = F.G; S.c = bx; S.lda = EFF; S.ldb = EFF;
        S.Aexp = (const char*)(ws + WS_HID); S.tok = nullptr; S.Bexp = (const char*)(ws + WS_WED); S.bstride = (size_t)2048 * 512;
        S.Ash = (const char*)(ws + WS_HIDS); S.Bsh = (const char*)(ws + WS_WSD); S.gather = false;
        pg8::EpiDown E{ws + WS_C, ws + WS_CS};
        { const int sg = F.vcu & 3;
          if (0 && sg) { const unsigned long long t0 = __builtin_amdgcn_s_memrealtime(); while (__builtin_amdgcn_s_memrealtime() - t0 < (unsigned long long)(sg * 500)) __builtin_amdgcn_s_sleep(8); } }
        REPS(10) pg8::gemm_phase<pg8::EpiDown, pg8::MoeOrder, true, true>(F.lds, pg8::GemmK{EFF, EFF, EFF}, S, E);
        if (BOTH(10)) GRID_BAR();
    }

    if (IN(11)) {
        moe_tables(F);
        const LAS int* tb = (const LAS int*)(F.lds + TB_OFF);
        const bf16_t* H1 = (const bf16_t*)(ws + WS_XN); const unsigned char* CS = ws + WS_CS; const unsigned char* C = ws + WS_C;
        const int* IDX = (const int*)(ws + WS_IDX); const float* GWt = (const float*)(ws + WS_GW); const int* RK = (const int*)(ws + WS_RK);
        const float* lg_ = args.in[27]; const float* lb_ = args.in[28]; float* out = args.out;
        REPS(11)
        for (int row = gw; row < MX; row += NGW) {
            const i32x4 e0 = *(const i32x4*)(IDX + (size_t)row * 8), e1 = *(const i32x4*)(IDX + (size_t)row * 8 + 4);
            const i32x4 r0 = *(const i32x4*)(RK + (size_t)row * 8), r1 = *(const i32x4*)(RK + (size_t)row * 8 + 4);
            const f32x4 w0 = *(const f32x4*)(GWt + (size_t)row * 8), w1 = *(const f32x4*)(GWt + (size_t)row * 8 + 4);
            int slot[8]; float wk[8];
            slot[0] = tb[65 + e0[0]] + r0[0]; slot[1] = tb[65 + e0[1]] + r0[1]; slot[2] = tb[65 + e0[2]] + r0[2]; slot[3] = tb[65 + e0[3]] + r0[3];
            slot[4] = tb[65 + e1[0]] + r1[0]; slot[5] = tb[65 + e1[1]] + r1[1]; slot[6] = tb[65 + e1[2]] + r1[2]; slot[7] = tb[65 + e1[3]] + r1[3];
            constexpr float CI = 1.f / C8SCALE;
            wk[0] = w0[0] * CI; wk[1] = w0[1] * CI; wk[2] = w0[2] * CI; wk[3] = w0[3] * CI; wk[4] = w1[0] * CI; wk[5] = w1[1] * CI; wk[6] = w1[2] * CI; wk[7] = w1[3] * CI;
            float acc[4][8];
#pragma unroll
            for (int j = 0; j < 4; ++j) { int lo_ = (j * 64 + F.lane) * 8; asm volatile("" : "+v"(lo_)); const size_t off = (size_t)row * DM + (size_t)lo_;
                const u32x4 hw = *(const u32x4*)(H1 + off); const u32x2 sw = *(const u32x2*)(CS + off);
                u32x2 cw[8];
#pragma unroll
                for (int k = 0; k < 8; ++k) cw[k] = *(const u32x2*)(C + (size_t)slot[k] * DM + (size_t)lo_);
                { const f32x2 s0 = __builtin_amdgcn_cvt_pk_f32_fp8((int)sw.x, false), s1 = __builtin_amdgcn_cvt_pk_f32_fp8((int)sw.x, true), s2 = __builtin_amdgcn_cvt_pk_f32_fp8((int)sw.y, false), s3 = __builtin_amdgcn_cvt_pk_f32_fp8((int)sw.y, true);
                  acc[j][0] = ALPHA * bf_lo(hw.x) + CI * s0[0]; acc[j][1] = ALPHA * bf_hi(hw.x) + CI * s0[1]; acc[j][2] = ALPHA * bf_lo(hw.y) + CI * s1[0]; acc[j][3] = ALPHA * bf_hi(hw.y) + CI * s1[1];
                  acc[j][4] = ALPHA * bf_lo(hw.z) + CI * s2[0]; acc[j][5] = ALPHA * bf_hi(hw.z) + CI * s2[1]; acc[j][6] = ALPHA * bf_lo(hw.w) + CI * s3[0]; acc[j][7] = ALPHA * bf_hi(hw.w) + CI * s3[1]; }
#pragma unroll
                for (int k = 0; k < 8; ++k) { const f32x2 c0 = __builtin_amdgcn_cvt_pk_f32_fp8((int)cw[k].x, false), c1 = __builtin_amdgcn_cvt_pk_f32_fp8((int)cw[k].x, true), c2 = __builtin_amdgcn_cvt_pk_f32_fp8((int)cw[k].y, false), c3 = __builtin_amdgcn_cvt_pk_f32_fp8((int)cw[k].y, true);
                    acc[j][0] += wk[k] * c0[0]; acc[j][1] += wk[k] * c0[1]; acc[j][2] += wk[k] * c1[0]; acc[j][3] += wk[k] * c1[1];
                    acc[j][4] += wk[k] * c2[0]; acc[j][5] += wk[k] * c2[1]; acc[j][6] += wk[k] * c3[0]; acc[j][7] += wk[k] * c3[1]; }
                asm volatile("" ::: "memory"); }
            float s = 0.f;
#pragma unroll
            for (int j = 0; j < 4; ++j)
#pragma unroll
                for (int e = 0; e < 8; ++e) s += acc[j][e];
            const float mean = wave_sum(s) * (1.f / DM); float s2 = 0.f;
#pragma unroll
            for (int j = 0; j < 4; ++j)
#pragma unroll
                for (int e = 0; e < 8; ++e) { acc[j][e] -= mean; s2 += acc[j][e] * acc[j][e]; }
            const float rstd = 1.f / sqrtf(wave_sum(s2) * (1.f / DM) + LN_EPS);
#pragma unroll
            for (int j = 0; j < 4; ++j) { int c0 = (j * 64 + F.lane) * 8; asm volatile("" : "+v"(c0));
                const f32x4 g0 = *(const f32x4*)(lg_ + c0), g1 = *(const f32x4*)(lg_ + c0 + 4), b0 = *(const f32x4*)(lb_ + c0), b1 = *(const f32x4*)(lb_ + c0 + 4);
                f32x4 o0, o1;
#pragma unroll
                for (int e = 0; e < 4; ++e) { o0[e] = acc[j][e] * rstd * g0[e] + b0[e]; o1[e] = acc[j][4 + e] * rstd * g1[e] + b1[e]; }
                *(f32x4*)(out + (size_t)row * DM + c0) = o0; *(f32x4*)(out + (size_t)row * DM + c0 + 4) = o1; }
        }
    }
#undef IN
#undef BOTH
#undef GRID_BAR
}

#ifndef PH_MASK
#define PH_MASK 0xFFFu
#endif
typedef void (*kern_t)(Args);
template <unsigned MASK> static bool prep_kernel(kern_t& k) {
    k = hymba_fwd<MASK>;
    if (hipFuncSetAttribute((const void*)hymba_fwd<MASK>, hipFuncAttributeMaxDynamicSharedMemorySize, LDS_BYTES) != hipSuccess) { fprintf(stderr, "kernel_launch: hipFuncSetAttribute failed (mask %x)\n", MASK); return false; }
    return true;
}
extern "C" void kernel_launch(void* const* d_in, const int* in_sizes, int n_in, void* d_out, int out_size, void* d_ws, size_t ws_size, hipStream_t stream) {
    static int grid = 0; static kern_t kerns[N_PHASES];
    if (grid == 0) {
        if (n_in != 29 || in_sizes[0] != MX * DM || out_size != MX * DM || ws_size < WS_END) {
            fprintf(stderr, "kernel_launch: unexpected shapes (n_in %d, in0 %d, out %d, ws %zu; need ws >= %zu); nothing launched\n", n_in, n_in > 0 ? in_sizes[0] : -1, out_size, ws_size, (size_t)WS_END); grid = -1; return; }
        int dev = 0, cus = 0;
        if (hipGetDevice(&dev) != hipSuccess || hipDeviceGetAttribute(&cus, hipDeviceAttributeMultiprocessorCount, dev) != hipSuccess) { fprintf(stderr, "kernel_launch: device query failed\n"); grid = -1; return; }
        bool ok = true;
        if constexpr (N_LAUNCHES == 1) ok = prep_kernel<PH_MASK>(kerns[0]);
        else { ok = ok && prep_kernel<0x001u>(kerns[0]) && prep_kernel<0x002u>(kerns[1]) && prep_kernel<0x004u>(kerns[2]) && prep_kernel<0x008u>(kerns[3]) && prep_kernel<0x010u>(kerns[4]) && prep_kernel<0x020u>(kerns[5])
                       && prep_kernel<0x040u>(kerns[6]) && prep_kernel<0x080u>(kerns[7]) && prep_kernel<0x100u>(kerns[8]) && prep_kernel<0x200u>(kerns[9]) && prep_kernel<0x400u>(kerns[10]) && prep_kernel<0x800u>(kerns[11]); }
        if (!ok) { grid = -1; return; }
        (void)hipGetLastError();
        grid = cus;
    }
    if (grid < 0) return;
    if (hipMemsetAsync((char*)d_ws + WS_CTL, 0, CTL_ZERO_BYTES, stream) != hipSuccess) { fprintf(stderr, "kernel_launch: memset failed\n"); return; }
    Args a{};
    for (int i = 0; i < 29; ++i) a.in[i] = (const float*)d_in[i];
    a.out = (float*)d_out; a.ws = (unsigned char*)d_ws;
    for (int li = 0; li < N_LAUNCHES; ++li) {
        if (N_LAUNCHES != 1 && !((PH_MASK >> li) & 1u)) continue;
        a.ph_lo = (N_LAUNCHES == 1) ? 0 : li; a.ph_hi = (N_LAUNCHES == 1) ? N_PHASES : li + 1;
        hipLaunchKernelGGL(kerns[li], dim3(grid), dim3(NWAVES * 64), LDS_BYTES, stream, a);
        const hipError_t le = hipPeekAtLastError();
        if (le != hipSuccess) { fprintf(stderr, "kernel_launch: launch %d failed: %s\n", li, hipGetErrorName(le)); break; }
    }
}
```

```cpp
#include <hip/hip_runtime.h>
#include <cstdio>
#include <cstdint>

#ifndef MK_N_LAUNCHES
#define MK_N_LAUNCHES 1
#endif
#ifndef REP_PH
#define REP_PH -1
#endif

#define LAS __attribute__((address_space(3)))
#define GAS __attribute__((address_space(1)))
typedef unsigned short bf16_t;
typedef short bf16x8 __attribute__((ext_vector_type(8)));
typedef short s16x4 __attribute__((ext_vector_type(4)));
typedef float f32x2 __attribute__((ext_vector_type(2)));
typedef float f32x4 __attribute__((ext_vector_type(4)));
typedef float f32x16 __attribute__((ext_vector_type(16)));
typedef unsigned u32x2 __attribute__((ext_vector_type(2)));
typedef unsigned u32x4 __attribute__((ext_vector_type(4)));
typedef int i32x4 __attribute__((ext_vector_type(4)));
typedef int i32x8 __attribute__((ext_vector_type(8)));

constexpr int BATCH = 2, SEQ = 8192, DM = 2048, NMETA = 16;
constexpr int MX = BATCH * SEQ;
constexpr int MIN_ROWS = MX + 256;
constexpr int NHEAD = 8, HD = 128, NGRP = 64, NST = 64;
constexpr int KVR = 64 + SEQ;
constexpr int NCHK = KVR / 32;
constexpr int UGK = 640;
constexpr int NEXP = 64, TOPK = 8, EFF = 512;
constexpr float LN_EPS = 1e-5f;
constexpr float ALPHA = 1.189207115002721f;
constexpr float ROUTED_SCALE = 2.5f;
constexpr float LOG2E = 1.4426950408889634f;
constexpr float QSCALE = 0.08838834764831845f * 1.4426950408889634f;
constexpr float W8SCALE = 256.f;
constexpr float H8SCALE = 8.f;
constexpr float C8SCALE = 16.f;

constexpr size_t MiB = 1u << 20;
constexpr size_t WS_CTL = 0, CTL_ZERO_BYTES = 1 * MiB;
constexpr size_t WS_LOGF = 1 * MiB;
constexpr size_t WS_CUM = 2 * MiB;
constexpr size_t WS_IDX = 3 * MiB;
constexpr size_t WS_GW = 3 * MiB + 512 * 1024;
constexpr size_t WS_RK = 4 * MiB;
constexpr size_t WS_WR = 4 * MiB + 512 * 1024;
constexpr size_t WS_TOK = 5 * MiB;
constexpr size_t WS_ST = 9 * MiB;
constexpr size_t WS_XN = 16 * MiB;
constexpr size_t WS_WED = 81 * MiB;
constexpr size_t WS_WSD = 209 * MiB;
constexpr size_t WS_WSGU = 211 * MiB;
constexpr size_t WS_WGLU = 215 * MiB;
constexpr size_t WS_WOUT = 217 * MiB;
constexpr size_t WS_WIN = 225 * MiB;
constexpr size_t WS_HID = 241 * MiB;
constexpr size_t WS_H1F8 = 310 * MiB;
constexpr size_t WS_YC = 241 * MiB;
constexpr size_t WS_YB = 305 * MiB;
constexpr size_t WS_Q = 337 * MiB;
constexpr size_t WS_HIDS = 370 * MiB;
constexpr size_t WS_CS = 386 * MiB;
constexpr size_t WS_C = 450 * MiB;
constexpr size_t WS_WEGU = 450 * MiB;
constexpr size_t WS_Z = 706 * MiB;
constexpr size_t WS_K = 834 * MiB;
constexpr size_t WS_V = 867 * MiB;
constexpr size_t WS_UG = 900 * MiB;
constexpr size_t WS_OPY = 941 * MiB;
constexpr size_t WS_OPE = 981 * MiB;
constexpr size_t WS_E = 997 * MiB;
constexpr size_t WS_END = 1013 * MiB;
static_assert(WS_HID + (size_t)(131072 + 256) * 512 * 2 <= WS_HIDS && WS_Q + (size_t)MX * 1024 * 2 <= WS_HIDS, "map");
static_assert(WS_K + (size_t)2 * KVR * 1024 * 2 <= WS_V && WS_V + (size_t)2 * KVR * 1024 * 2 <= WS_UG, "map");
static_assert(WS_UG + (size_t)64 * 2 * NCHK * UGK * 2 <= WS_OPY && WS_C + (size_t)131072 * 2048 * 2 <= WS_END, "map");
static_assert(WS_XN + (size_t)MIN_ROWS * 2048 * 2 <= WS_WED, "map");
constexpr int CW_TMO = 0, CW_CODE = 1;
constexpr int CW_CNT = 1024;
constexpr int CW_KMAX = 5120;
constexpr int CW_QMAX = 5184;
constexpr int CW_BAR = 8192;
constexpr float T_SKIP = 40.f;

constexpr int RING_BYTES = 139264;
constexpr int LDSCTL_OFF = RING_BYTES;
constexpr int MISC_OFF = LDSCTL_OFF + 64;
constexpr int TB_OFF = LDSCTL_OFF + 1024;
constexpr int LDS_BYTES = 147456;

__device__ __forceinline__ unsigned cvt_pk_bf16(float lo, float hi) { unsigned r; asm volatile("v_cvt_pk_bf16_f32 %0, %1, %2" : "=v"(r) : "v"(lo), "v"(hi)); return r; }
__device__ __forceinline__ float bf_lo(unsigned w) { return __uint_as_float(w << 16); }
__device__ __forceinline__ float bf_hi(unsigned w) { return __uint_as_float(w & 0xffff0000u); }
__device__ __forceinline__ float fast_sigmoid(float x) { return __builtin_amdgcn_rcpf(1.f + __builtin_amdgcn_exp2f(-x * LOG2E)); }
__device__ __forceinline__ float wave_sum(float v) {
#pragma unroll
    for (int o = 1; o < 64; o <<= 1) v += __shfl_xor(v, o);
    return v;
}
#define LDS_WAIT() asm volatile("s_waitcnt lgkmcnt(0)" ::: "memory")
#define VM_WAIT() asm volatile("s_waitcnt vmcnt(0)" ::: "memory")

namespace pg8 {
constexpr int BM = 256, BK = 64, HALF = 128, HTB = HALF * BK * 2, STAGE_BYTES = 8 * HTB, NXCD = 8, WGM = 8;
__host__ __device__ __forceinline__ int lds_byte(int r, int c) { const int st = (r >> 4) * 2 + (c >> 5), rr = r & 15, cc = c & 31, ob = rr * 64 + cc * 2; return st * 1024 + (ob ^ (((ob >> 9) & 1) << 5)); }
__host__ __device__ __forceinline__ void stage_rc(int b, int& R, int& C) { const int st = b / 1024, sb = b % 1024, swz = sb ^ (((sb >> 9) & 1) << 5); R = (st >> 1) * 16 + swz / 64; C = (st & 1) * 32 + (swz % 64) / 2; }
__host__ __device__ __forceinline__ int perm32(int rho) { const int n = rho >> 4, i = rho & 15; return 8 * (i >> 2) + 4 * n + (i & 3); }

struct Unit { const char* A; const char* B; const int* rows; int r0, c0, valid, aux; };
struct GemmK { int K, lda, ldb; };

template <class Epi, class Sched, bool ALIGN_EPI, bool F8 = false>
__device__ __forceinline__ void gemm_phase(LAS unsigned char* lds, const GemmK g, const Sched& S, const Epi& E) {
    const int tid = threadIdx.x, wid = __builtin_amdgcn_readfirstlane(tid >> 6), lane = tid & 63, wr = wid >> 2, wc = wid & 3, fr = lane & 15, fq = lane >> 4;
    constexpr unsigned ES = F8 ? 1u : 2u;
    const int K = g.K, nt = (K * (int)ES) / (BK * 2);
    unsigned voffB0[2], voffB1[2];
#pragma unroll
    for (int i = 0; i < 2; ++i) { int R, C; stage_rc(tid * 16 + i * 8192, R, C);
        int Rb0, Rb1;
        if constexpr ((int)Epi::PERM == 2) { const int wc_ = R >> 5, rho = R & 31, n_ = rho >> 4, ii = rho & 15; Rb0 = 64 * wc_ + 16 * (ii >> 2) + 4 * n_ + (ii & 3); Rb1 = Rb0 + 8; }
        else { Rb0 = (int)Epi::PERM ? ((R & ~31) + perm32(R & 31)) : R; Rb1 = Rb0 + HALF; }
        voffB0[i] = (unsigned)(Rb0 * g.ldb) * ES + (unsigned)C * 2u; voffB1[i] = (unsigned)(Rb1 * g.ldb) * ES + (unsigned)C * 2u; }
    const size_t kstep = (size_t)(BK * 2);
    const unsigned ldsw = (unsigned)wid * 1024u;
    const int aoff = lds_byte(wr * 64 + fr, fq * (F8 ? 16 : 8)), boff = lds_byte(wc * 32 + fr, fq * (F8 ? 16 : 8));
    constexpr int KSTR = F8 ? 16 : 1024;
    int f8scale = 0x7f7f7f7f; asm volatile("" : "+v"(f8scale));
#define PG8_SA(b, h) (((b) * 2 + (h)) * HTB)
#define PG8_SB(b, h) ((4 + (b) * 2 + (h)) * HTB)
#define PG8_STAGE(bufoff, gbase, voff) do { _Pragma("unroll") for (int _i = 0; _i < 2; ++_i) \
        __builtin_amdgcn_global_load_lds((const unsigned*)((const char*)(gbase) + (voff)[_i]), (LAS unsigned*)(lds + (bufoff) + ldsw + _i * 8192), 16, 0, 0); } while (0)
#define PG8_LDA(dst, b, h) do { _Pragma("unroll") for (int m = 0; m < 4; ++m) _Pragma("unroll") for (int k = 0; k < 2; ++k) dst[m][k] = *(const LAS bf16x8*)(lds + PG8_SA(b, h) + aoff + m * 2048 + k * KSTR); } while (0)
#define PG8_LDB(dst, b, h) do { _Pragma("unroll") for (int n = 0; n < 2; ++n) _Pragma("unroll") for (int k = 0; k < 2; ++k) dst[n][k] = *(const LAS bf16x8*)(lds + PG8_SB(b, h) + boff + n * 2048 + k * KSTR); } while (0)
#define PG8_CAT8(x0, x1) __builtin_shufflevector(__builtin_bit_cast(i32x4, x0), __builtin_bit_cast(i32x4, x1), 0, 1, 2, 3, 4, 5, 6, 7)
#define PG8_MMA(ai, bj, At, Bt) do { __builtin_amdgcn_s_setprio(1); if constexpr (F8) { _Pragma("unroll") for (int m = 0; m < 4; ++m) _Pragma("unroll") for (int n = 0; n < 2; ++n) \
        asm volatile("v_mfma_scale_f32_16x16x128_f8f6f4 %0, %1, %2, %0, %3, %3 op_sel_hi:[0,0,0]" : "+v"(acc[ai][bj][m][n]) : "v"(PG8_CAT8(Bt[n][0], Bt[n][1])), "v"(PG8_CAT8(At[m][0], At[m][1])), "v"(f8scale)); } \
      else { _Pragma("unroll") for (int m = 0; m < 4; ++m) _Pragma("unroll") for (int n = 0; n < 2; ++n) _Pragma("unroll") for (int k = 0; k < 2; ++k) \
        acc[ai][bj][m][n] = __builtin_amdgcn_mfma_f32_16x16x32_bf16(Bt[n][k], At[m][k], acc[ai][bj][m][n], 0, 0, 0); } __builtin_amdgcn_s_setprio(0); } while (0)
#define PG8_WAIT_V(n) asm volatile("s_waitcnt vmcnt(" #n ")" ::: "memory")
#define PG8_WAIT_L(n) asm volatile("s_waitcnt lgkmcnt(" #n ")" ::: "memory")
#define PG8_BAR __builtin_amdgcn_s_barrier()
#define PG8_SCHED __builtin_amdgcn_sched_barrier(0)
#define PG8_VOFFA(u, v0, v1) do { int t_ = tid; asm volatile("" : "+v"(t_)); _Pragma("unroll") for (int _i = 0; _i < 2; ++_i) { int R_, C_; stage_rc(t_ * 16 + _i * 8192, R_, C_);     \
        v0[_i] = S.a_off(u, R_) + (unsigned)C_ * 2u; v1[_i] = S.a_off(u, R_ + HALF) + (unsigned)C_ * 2u; } } while (0)
    Unit cur, nxt; int ui = 0;
    if (!S.next(0, cur)) return;
    f32x4 acc[2][2][4][2];
#pragma unroll
    for (int a = 0; a < 2; ++a)
#pragma unroll
        for (int b = 0; b < 2; ++b)
#pragma unroll
            for (int m = 0; m < 4; ++m)
#pragma unroll
                for (int n = 0; n < 2; ++n) acc[a][b][m][n] = (f32x4){0.f, 0.f, 0.f, 0.f};
    bf16x8 At[4][2], B0[2][2], B1[2][2];
    const char* cA = cur.A; const char* cB = cur.B;
    unsigned vA0[2], vA1[2], nA0[2], nA1[2];
    PG8_VOFFA(cur, vA0, vA1);
    PG8_STAGE(PG8_SB(0, 0), cB, voffB0); PG8_STAGE(PG8_SB(0, 1), cB, voffB1); PG8_STAGE(PG8_SA(0, 0), cA, vA0); PG8_STAGE(PG8_SA(0, 1), cA, vA1);
    if (wr == 1) PG8_BAR;
    PG8_WAIT_V(2); PG8_BAR;
    PG8_STAGE(PG8_SB(1, 0), cB + kstep, voffB0); PG8_STAGE(PG8_SA(1, 0), cA + kstep, vA0); PG8_STAGE(PG8_SB(1, 1), cB + kstep, voffB1);
    PG8_WAIT_V(6); PG8_BAR;
    for (;;) {
        const bool has_next = S.next(ui + 1, nxt);
        const char* nA = has_next ? nxt.A : cA; const char* nB = has_next ? nxt.B : cB;
        if (has_next) { PG8_VOFFA(nxt, nA0, nA1); } else { nA0[0] = vA0[0]; nA0[1] = vA0[1]; nA1[0] = vA1[0]; nA1[1] = vA1[1]; }
#pragma unroll 1
        for (int t = 0; t < nt; t += 2) {
            const bool last = (t == nt - 2);
            const char* a1 = cA + (size_t)(t + 1) * kstep;
            const char* a2 = last ? nA : cA + (size_t)(t + 2) * kstep; const char* b2 = last ? nB : cB + (size_t)(t + 2) * kstep;
            const char* a3 = a2 + kstep; const char* b3 = b2 + kstep;
            unsigned w0[2], w1[2];
            w0[0] = last ? nA0[0] : vA0[0]; w0[1] = last ? nA0[1] : vA0[1]; w1[0] = last ? nA1[0] : vA1[0]; w1[1] = last ? nA1[1] : vA1[1];
            PG8_LDB(B0, 0, 0); PG8_LDB(B1, 0, 1); PG8_SCHED; PG8_LDA(At, 0, 0); PG8_STAGE(PG8_SA(1, 1), a1, vA1);
            PG8_WAIT_V(8); PG8_WAIT_L(0); PG8_BAR; PG8_MMA(0, 0, At, B0); PG8_MMA(0, 1, At, B1); PG8_BAR; PG8_SCHED;
            PG8_LDA(At, 0, 1); PG8_STAGE(PG8_SB(0, 0), b2, voffB0); PG8_STAGE(PG8_SB(0, 1), b2, voffB1); PG8_STAGE(PG8_SA(0, 0), a2, w0);
            PG8_WAIT_V(8); PG8_WAIT_L(0); PG8_BAR; PG8_MMA(1, 0, At, B0); PG8_MMA(1, 1, At, B1); PG8_BAR; PG8_SCHED;
            PG8_LDB(B0, 1, 0); PG8_LDB(B1, 1, 1); PG8_SCHED; PG8_LDA(At, 1, 0); PG8_STAGE(PG8_SA(0, 1), a2, w1);
            PG8_WAIT_V(8); PG8_WAIT_L(0); PG8_BAR; PG8_MMA(0, 0, At, B0); PG8_MMA(0, 1, At, B1); PG8_BAR; PG8_SCHED;
            PG8_LDA(At, 1, 1); PG8_STAGE(PG8_SB(1, 0), b3, voffB0); PG8_STAGE(PG8_SB(1, 1), b3, voffB1); PG8_STAGE(PG8_SA(1, 0), a3, w0);
            PG8_WAIT_V(8); PG8_WAIT_L(0); PG8_BAR; PG8_MMA(1, 0, At, B0); PG8_MMA(1, 1, At, B1); PG8_BAR; PG8_SCHED;
        }
        if constexpr (ALIGN_EPI) { if (wr == 0) PG8_BAR; }
        if constexpr (F8) asm volatile("s_nop 15\n\ts_nop 7" ::: "memory");
        E(acc, cur, wr, wc, fr, fq);
        if (!has_next) break;
#pragma unroll
        for (int a = 0; a < 2; ++a)
#pragma unroll
            for (int b = 0; b < 2; ++b)
#pragma unroll
                for (int m = 0; m < 4; ++m)
#pragma unroll
                    for (int n = 0; n < 2; ++n) acc[a][b][m][n] = (f32x4){0.f, 0.f, 0.f, 0.f};
        cur = nxt; cA = nA; cB = nB; ++ui;
        vA0[0] = nA0[0]; vA0[1] = nA0[1]; vA1[0] = nA1[0]; vA1[1] = nA1[1];
        if constexpr (ALIGN_EPI) { if (wr == 1) PG8_BAR; }
    }
    PG8_WAIT_V(0);
    if constexpr (!ALIGN_EPI) { if (wr == 0) PG8_BAR; }
    PG8_BAR;
#undef PG8_SA
#undef PG8_SB
#undef PG8_STAGE
#undef PG8_LDA
#undef PG8_LDB
#undef PG8_MMA
#undef PG8_CAT8
#undef PG8_WAIT_V
#undef PG8_WAIT_L
#undef PG8_BAR
#undef PG8_SCHED
#undef PG8_VOFFA
}

__device__ __forceinline__ int xcd_remap(int L, int nwg) { const int q = nwg / NXCD, r = nwg % NXCD, xcd = L % NXCD, off = L / NXCD; return (xcd < r ? xcd * (q + 1) : r * (q + 1) + (xcd - r) * q) + off; }

struct DenseOrder {
    const char* A; const char* B; int lda, ldb, nM, nN, nwg, G, c;
    __device__ __forceinline__ void init(const void* A_, const void* B_, int lda_, int ldb_, int M, int N, int G_, int c_) { A = (const char*)A_; B = (const char*)B_; lda = lda_ * 2; ldb = ldb_ * 2; nM = M / BM; nN = N / BM; nwg = nM * nN; G = G_; c = c_; }
    __device__ __forceinline__ bool next(int i, Unit& u) const {
        const long L = (long)i * G + c; if (L >= nwg) return false;
        const int wgid = xcd_remap((int)L, nwg);
        const int nig = WGM * nN, gid = wgid / nig, fm = gid * WGM, gsz = (nM - fm) < WGM ? (nM - fm) : WGM;
        const int pm = fm + ((wgid % nig) % gsz), pn = (wgid % nig) / gsz;
        u.A = A + (size_t)pm * BM * lda; u.B = B + (size_t)pn * BM * ldb; u.rows = nullptr; u.r0 = pm * BM; u.c0 = pn; u.valid = BM; u.aux = 0; return true;
    }
    __device__ __forceinline__ unsigned a_off(const Unit&, int R) const { return (unsigned)R * (unsigned)lda; }
};
struct EOrder {
    const char* UG; const char* OPE; int G, c;
    __device__ __forceinline__ bool next(int i, Unit& u) const {
        const int L = i * G + c; if (L >= 128) return false;
        const int g = L >> 1, b = L & 1;
        u.A = UG + ((size_t)((g * 2 + b) * NCHK + 1)) * UGK * 2; u.B = OPE + (size_t)g * 256 * 512 * 2; u.rows = nullptr; u.r0 = (g * 2 + b) * 256; u.c0 = 0; u.valid = BM; u.aux = g; return true;
    }
    __device__ __forceinline__ unsigned a_off(const Unit&, int R) const { return (unsigned)R * (unsigned)(UGK * 2); }
};
struct YOrder {
    const char* UG; const char* OPY; int G, c;
    __device__ __forceinline__ bool next(int i, Unit& u) const {
        const int L = i * G + c; if (L >= 256) return false;
        const int g = L >> 2, b = (L >> 1) & 1, pn = L & 1;
        u.A = UG + ((size_t)((g * 2 + b) * NCHK + 2)) * UGK * 2; u.B = OPY + ((size_t)g * 512 + pn * 256) * UGK * 2; u.rows = nullptr; u.r0 = b; u.c0 = pn; u.valid = BM; u.aux = g; return true;
    }
    __device__ __forceinline__ unsigned a_off(const Unit&, int R) const { return (unsigned)R * (unsigned)(UGK * 2); }
};
struct OneUnit {
    Unit u; unsigned rowbytes;
    __device__ __forceinline__ bool next(int i, Unit& uu) const { if (i > 0) return false; uu = u; return true; }
    __device__ __forceinline__ unsigned a_off(const Unit&, int R) const { return (unsigned)R * rowbytes; }
};
struct MoeOrder {
    const LAS int* tb;
    int TT, NCT, nsh, nwg, G, c, lda, ldb;
    const char* Aexp; const int* tok; const char* Bexp; size_t bstride; const char* Ash; const char* Bsh; bool gather;
    __device__ __forceinline__ bool next(int i, Unit& u) const {
        const long L = (long)i * G + c; if (L >= nwg) return false;
        const int wgid = xcd_remap((int)L, nwg);
        if (wgid < TT * NCT) {
            const int gr = wgid / NCT, ct = wgid - gr * NCT;
            int lo = 0, hi = NEXP;
            while (hi - lo > 1) { const int mid = (lo + hi) >> 1; if (tb[mid] <= gr) lo = mid; else hi = mid; }
            const int e = lo, rt = gr - tb[e], cn = tb[130 + e], cp = tb[65 + e];
            int valid = cn - rt * BM; valid = valid > BM ? BM : valid;
            if (gather) { u.A = Aexp; u.rows = tok + (size_t)e * MX + rt * BM; }
            else { u.A = Aexp + (size_t)(cp + rt * BM) * lda; u.rows = nullptr; }
            u.B = Bexp + (size_t)e * bstride + (size_t)ct * BM * ldb; u.r0 = cp + rt * BM; u.c0 = ct; u.valid = valid; u.aux = 0;
        } else {
            const int s = wgid - TT * NCT, pm = s / NCT, ct = s - pm * NCT;
            u.A = Ash + (size_t)pm * BM * lda; u.rows = nullptr; u.B = Bsh + (size_t)ct * BM * ldb; u.r0 = pm * BM; u.c0 = ct; u.valid = BM; u.aux = 1;
        }
        return true;
    }
    __device__ __forceinline__ unsigned a_off(const Unit& u, int R) const {
        if (u.rows) { const int i = R < u.valid ? R : u.valid - 1; return (unsigned)u.rows[i] * (unsigned)lda; }
        return (unsigned)R * (unsigned)lda;
    }
};

#define EPI_LOOP_ROWS for (int ai = 0; ai < 2; ++ai) _Pragma("unroll") for (int m = 0; m < 4; ++m)
__device__ __forceinline__ u32x4 pack8(f32x4 v0, f32x4 v1) { u32x4 w; w.x = cvt_pk_bf16(v0[0], v0[1]); w.y = cvt_pk_bf16(v0[2], v0[3]); w.z = cvt_pk_bf16(v1[0], v1[1]); w.w = cvt_pk_bf16(v1[2], v1[3]); return w; }

struct EpiInProj {
    static constexpr int PERM = 1;
    bf16_t* UG; bf16_t* Q; bf16_t* Kb; bf16_t* Vb;
    __device__ __forceinline__ void operator()(const f32x4 (&acc)[2][2][4][2], const Unit& u, int wr, int wc, int fr, int fq) const {
        const int pn = u.c0, sect = pn >> 2;
        const float sc = sect == 1 ? QSCALE : 1.f;
#pragma unroll
        EPI_LOOP_ROWS { const int rt = ai * HALF + wr * 64 + m * 16 + fr; const int row = u.r0 + rt, b = row >> 13, s = row & (SEQ - 1);
#pragma unroll
            for (int bj = 0; bj < 2; ++bj) {
                const int col = (pn & 3) * 256 + bj * HALF + wc * 32 + 8 * fq;
                const u32x4 w = pack8(acc[ai][bj][m][0] * sc, acc[ai][bj][m][1] * sc);
                if (sect == 0) { const int gch = col >> 4, half = (col >> 3) & 1;
                    *(u32x4*)(UG + ((size_t)((gch * 2 + b) * NCHK + 2 + (s >> 5)) * UGK + (s & 31) * 16 + 8 * half)) = w; }
                else if (sect == 1) *(u32x4*)(Q + (size_t)row * 1024 + col) = w;
                else { bf16_t* dst = sect == 2 ? Kb : Vb; *(u32x4*)(dst + ((size_t)b * KVR + 64 + s) * 1024 + col) = w; }
            }
        }
    }
};
struct EpiE {
    static constexpr int PERM = 0;
    float* E;
    __device__ __forceinline__ void operator()(const f32x4 (&acc)[2][2][4][2], const Unit& u, int wr, int wc, int fr, int fq) const {
#pragma unroll
        EPI_LOOP_ROWS { const int rt = ai * HALF + wr * 64 + m * 16 + fr;
#pragma unroll
            for (int n = 0; n < 2; ++n) *(f32x4*)(E + (size_t)(u.r0 + rt) * 128 + wc * 32 + 16 * n + 4 * fq) = acc[ai][0][m][n]; }
    }
};
__device__ __forceinline__ float gelu_tanh(float v) { const float t = 1.5957691216057308f * (v + 0.044715f * v * v * v); return v * fast_sigmoid(t); }
struct EpiY {
    static constexpr int PERM = 1;
    bf16_t* YB;
    __device__ __forceinline__ void operator()(const f32x4 (&acc)[2][2][4][2], const Unit& u, int wr, int wc, int fr, int fq) const {
        const int b = u.r0, g = u.aux;
#pragma unroll
        EPI_LOOP_ROWS { const int rt = ai * HALF + wr * 64 + m * 16 + fr;
#pragma unroll
            for (int bj = 0; bj < 2; ++bj) { const int col = u.c0 * 256 + bj * HALF + wc * 32 + 8 * fq, t = col >> 4, h0 = col & 15;
                f32x4 v0 = acc[ai][bj][m][0], v1 = acc[ai][bj][m][1];
#pragma unroll
                for (int e = 0; e < 4; ++e) { v0[e] = gelu_tanh(v0[e]); v1[e] = gelu_tanh(v1[e]); }
                *(u32x4*)(YB + ((size_t)b * SEQ + 32 * rt + t) * 1024 + g * 16 + h0) = pack8(v0, v1); }
            asm volatile("" ::: "memory"); }
    }
};
struct EpiGlu {
    static constexpr int PERM = 1;
    const bf16_t* YB; const float* bias; bf16_t* YC;
    __device__ __forceinline__ void operator()(const f32x4 (&acc)[2][2][4][2], const Unit& u, int wr, int wc, int fr, int fq) const {
#pragma unroll
        for (int bj = 0; bj < 2; ++bj) { const int col = u.c0 * 256 + bj * HALF + wc * 32 + 8 * fq;
            const f32x4 b0 = *(const f32x4*)(bias + col), b1 = *(const f32x4*)(bias + col + 4);
#pragma unroll
            EPI_LOOP_ROWS { const int row = u.r0 + ai * HALF + wr * 64 + m * 16 + fr;
                const u32x4 yw = *(const u32x4*)(YB + (size_t)row * 1024 + col);
                f32x4 v0 = acc[ai][bj][m][0] + b0, v1 = acc[ai][bj][m][1] + b1;
                v0[0] = bf_lo(yw.x) * fast_sigmoid(v0[0]); v0[1] = bf_hi(yw.x) * fast_sigmoid(v0[1]); v0[2] = bf_lo(yw.y) * fast_sigmoid(v0[2]); v0[3] = bf_hi(yw.y) * fast_sigmoid(v0[3]);
                v1[0] = bf_lo(yw.z) * fast_sigmoid(v1[0]); v1[1] = bf_hi(yw.z) * fast_sigmoid(v1[1]); v1[2] = bf_lo(yw.w) * fast_sigmoid(v1[2]); v1[3] = bf_hi(yw.w) * fast_sigmoid(v1[3]);
                *(u32x4*)(YC + (size_t)row * 2048 + col) = pack8(v0, v1); } }
    }
};
struct EpiOut {
    static constexpr int PERM = 0;
    const bf16_t* XN; float* Z; float* ST;
    __device__ __forceinline__ void operator()(const f32x4 (&acc)[2][2][4][2], const Unit& u, int wr, int wc, int fr, int fq) const {
#pragma unroll
        EPI_LOOP_ROWS { const int row = u.r0 + ai * HALF + wr * 64 + m * 16 + fr; float s = 0.f, q = 0.f;
#pragma unroll
            for (int bj = 0; bj < 2; ++bj)
#pragma unroll
                for (int n = 0; n < 2; ++n) { const int col = u.c0 * 256 + bj * HALF + wc * 32 + 16 * n + 4 * fq;
                    const u32x2 hw = *(const u32x2*)(XN + (size_t)row * 2048 + col);
                    f32x4 z = acc[ai][bj][m][n];
                    z[0] += ALPHA * bf_lo(hw.x); z[1] += ALPHA * bf_hi(hw.x); z[2] += ALPHA * bf_lo(hw.y); z[3] += ALPHA * bf_hi(hw.y);
                    s += (z[0] + z[1]) + (z[2] + z[3]); q += (z[0] * z[0] + z[1] * z[1]) + (z[2] * z[2] + z[3] * z[3]);
                    *(f32x4*)(Z + (size_t)row * 2048 + col) = z; }
            s += __shfl_xor(s, 16); s += __shfl_xor(s, 32); q += __shfl_xor(q, 16); q += __shfl_xor(q, 32);
            if (fq == 0) *(f32x2*)(ST + ((size_t)row * 32 + u.c0 * 4 + wc) * 2) = (f32x2){s, q}; }
    }
};
__device__ __forceinline__ float clamp448(float v) { return __builtin_fminf(__builtin_fmaxf(v, -448.f), 448.f); }
__device__ __forceinline__ u32x2 pack8_fp8(f32x4 v0, f32x4 v1) {
    int lo = 0, hi = 0;
    lo = __builtin_amdgcn_cvt_pk_fp8_f32(clamp448(v0[0]), clamp448(v0[1]), lo, false); lo = __builtin_amdgcn_cvt_pk_fp8_f32(clamp448(v0[2]), clamp448(v0[3]), lo, true);
    hi = __builtin_amdgcn_cvt_pk_fp8_f32(clamp448(v1[0]), clamp448(v1[1]), hi, false); hi = __builtin_amdgcn_cvt_pk_fp8_f32(clamp448(v1[2]), clamp448(v1[3]), hi, true);
    return (u32x2){(unsigned)lo, (unsigned)hi};
}
struct EpiGU {
    static constexpr int PERM = 1;
    unsigned char* HID; unsigned char* HIDS;
    __device__ __forceinline__ void operator()(const f32x4 (&acc)[2][2][4][2], const Unit& u, int wr, int wc, int fr, int fq) const {
        unsigned char* dst = u.aux ? HIDS : HID; constexpr float WI = 1.f / W8SCALE;
#pragma unroll
        EPI_LOOP_ROWS { const int rt = ai * HALF + wr * 64 + m * 16 + fr;
            if (rt < u.valid) { f32x4 h0, h1;
#pragma unroll
                for (int e = 0; e < 4; ++e) { const float g0 = acc[ai][0][m][0][e] * WI, g1 = acc[ai][0][m][1][e] * WI;
                    h0[e] = g0 * fast_sigmoid(g0) * (acc[ai][1][m][0][e] * (WI * H8SCALE)); h1[e] = g1 * fast_sigmoid(g1) * (acc[ai][1][m][1][e] * (WI * H8SCALE)); }
                *(u32x2*)(dst + (size_t)(u.r0 + rt) * EFF + u.c0 * HALF + wc * 32 + 8 * fq) = pack8_fp8(h0, h1); } }
    }
};
struct EpiDown {
    static constexpr int PERM = 2;
    unsigned char* C; unsigned char* CS;
    __device__ __forceinline__ void operator()(const f32x4 (&acc)[2][2][4][2], const Unit& u, int wr, int wc, int fr, int fq) const {
        unsigned char* dst = u.aux ? CS : C; constexpr float SC = C8SCALE / (W8SCALE * H8SCALE);
#pragma unroll
        EPI_LOOP_ROWS { const int rt = ai * HALF + wr * 64 + m * 16 + fr;
            if (rt < u.valid) { const u32x2 lo = pack8_fp8(acc[ai][0][m][0] * SC, acc[ai][0][m][1] * SC), hi = pack8_fp8(acc[ai][1][m][0] * SC, acc[ai][1][m][1] * SC);
                *(u32x4*)(dst + (size_t)(u.r0 + rt) * 2048 + u.c0 * 256 + wc * 64 + 16 * fq) = (u32x4){lo.x, lo.y, hi.x, hi.y}; } }
    }
};
}

namespace att {
constexpr int D = 128, NW = 8, QBLK = 32, KVBLK = 64, QB = NW * QBLK;
constexpr int PQ = 1024, PKV = 1024, PO = 2048;
constexpr int SHM_V = KVBLK * D * 2, SHM_K = KVBLK * D * 2;
constexpr int OFF_WS = 2 * SHM_V + 2 * SHM_K, OFF_CUM = OFF_WS + NW * 64 * 4, LDS_BYTES = OFF_CUM + 2 * 64 * 4;
constexpr float THR2 = 8.f * 1.4426950408889634f;
constexpr unsigned WINF = 0x7fffffffu;
#define KSWZ(row, colB) ((row) * 256 + ((colB) ^ (((row) & 7) << 4)))
#define SBAR() __builtin_amdgcn_sched_barrier(0)
__device__ __forceinline__ int v_st(int k, int c) { const int kk = (k & ~0xC) | ((k & 4) << 1) | ((k & 8) >> 1); return ((kk >> 3) * 4 + (c >> 5)) * 512 + ((kk & 7) * 32 + (c & 31)) * 2; }
__device__ __forceinline__ int v_rd_base(int lane) { return ((lane & 3) << 3) | (((lane >> 2) & 3) << 6) | (((lane >> 4) & 1) << 5) | (((lane >> 5) & 1) << 8); }
constexpr int v_rd_off(int d0, int ks, int half) { return d0 * 512 + ks * 4096 + half * 2048; }
__device__ __forceinline__ int crow(int r, int hi) { return (r & 3) + 8 * (r >> 2) + 4 * hi; }
__device__ __forceinline__ unsigned cvtpk(float lo, float hi) { unsigned r; asm volatile("v_cvt_pk_bf16_f32 %0, %1, %2" : "=v"(r) : "v"(lo), "v"(hi)); return r; }
__device__ __forceinline__ bf16x8 ld8(const bf16_t* p) { return *reinterpret_cast<const bf16x8*>(p); }
__device__ __forceinline__ void mask_tile(f32x16& p0, f32x16& p1, int dq, unsigned W) {
    const float NEG = -__builtin_inff();
#pragma unroll
    for (int r = 0; r < 16; ++r) { const int c = (r & 3) + 8 * (r >> 2);
        if ((unsigned)(dq - c) >= W) p0[r] = NEG;
        if ((unsigned)(dq - c - 32) >= W) p1[r] = NEG; }
}
__device__ __forceinline__ void partialSM(f32x16& p0, f32x16& p1, float& m_reg, float& mn, float& alpha) {
    float pmax = p0[0];
#pragma unroll
    for (int r = 1; r < 16; ++r) pmax = fmaxf(pmax, p0[r]);
#pragma unroll
    for (int r = 0; r < 16; ++r) pmax = fmaxf(pmax, p1[r]);
    { auto rr = __builtin_amdgcn_permlane32_swap(__float_as_uint(pmax), __float_as_uint(pmax), false, false);
      pmax = fmaxf(__uint_as_float(rr[0]), __uint_as_float(rr[1])); }
    if (__builtin_expect(__all((pmax - m_reg) <= THR2), 1)) { mn = m_reg; alpha = 1.f; }
    else { mn = fmaxf(m_reg, pmax); alpha = __builtin_amdgcn_exp2f(m_reg - mn); m_reg = mn; }
#pragma unroll
    for (int r = 0; r < 16; ++r) p0[r] = p0[r] - mn;
#pragma unroll
    for (int r = 0; r < 16; ++r) p1[r] = p1[r] - mn;
#pragma unroll
    for (int r = 0; r < 16; ++r) p0[r] = __builtin_amdgcn_exp2f(p0[r]);
}
__device__ __forceinline__ void finishSM(f32x16& p0, f32x16& p1, float alpha, float& l_reg, bf16x8& pa0, bf16x8& pa1, bf16x8& pa2, bf16x8& pa3) {
#pragma unroll
    for (int r = 0; r < 16; ++r) p1[r] = __builtin_amdgcn_exp2f(p1[r]);
    float ps = 0;
#pragma unroll
    for (int r = 0; r < 16; ++r) ps += p0[r];
#pragma unroll
    for (int r = 0; r < 16; ++r) ps += p1[r];
    { auto rr = __builtin_amdgcn_permlane32_swap(__float_as_uint(ps), __float_as_uint(ps), false, false);
      ps = __uint_as_float(rr[0]) + __uint_as_float(rr[1]); }
    l_reg = l_reg * alpha + ps;
#define PK4(P, B_, OUT) do { unsigned a0 = cvtpk(P[B_+0], P[B_+1]), a1 = cvtpk(P[B_+2], P[B_+3]);                          \
        unsigned b0 = cvtpk(P[B_+4], P[B_+5]), b1 = cvtpk(P[B_+6], P[B_+7]);                                             \
        auto r0 = __builtin_amdgcn_permlane32_swap(a0, b0, false, false); auto r1 = __builtin_amdgcn_permlane32_swap(a1, b1, false, false); \
        u32x4 w = {r0[0], r1[0], r0[1], r1[1]}; OUT = *reinterpret_cast<bf16x8*>(&w); } while (0)
    PK4(p0, 0, pa0); PK4(p0, 8, pa1); PK4(p1, 0, pa2); PK4(p1, 8, pa3);
#undef PK4
}
template <int KB>
__device__ __forceinline__ void qkt(f32x16& p0, f32x16& p1, const LAS char* K_lds, const LAS float* cumL, int r32, int hi, const bf16x8* qr) {
    { int l_ = r32 + 32 * hi; asm volatile("" : "+v"(l_)); r32 = l_ & 31; hi = l_ >> 5; }
    const LAS float* cb = cumL + KB * 64 + 4 * hi;
#pragma unroll
    for (int g = 0; g < 4; ++g) { const f32x4 a = *(const LAS f32x4*)(cb + 8 * g), b = *(const LAS f32x4*)(cb + 32 + 8 * g);
        p0[4 * g] = a[0]; p0[4 * g + 1] = a[1]; p0[4 * g + 2] = a[2]; p0[4 * g + 3] = a[3];
        p1[4 * g] = b[0]; p1[4 * g + 1] = b[1]; p1[4 * g + 2] = b[2]; p1[4 * g + 3] = b[3]; }
    const LAS char* kb[4];
#pragma unroll
    for (int dd = 0; dd < 4; ++dd) kb[dd] = K_lds + KB * SHM_K + KSWZ(r32, (dd * 16 + hi * 8) * 2);
#pragma unroll
    for (int d0 = 0; d0 < 8; ++d0) { const LAS char* a = kb[d0 & 3] + (d0 >> 2) * 128;
        bf16x8 b0 = *reinterpret_cast<const LAS bf16x8*>(a);
        bf16x8 b1 = *reinterpret_cast<const LAS bf16x8*>(a + 32 * 256);
        p0 = __builtin_amdgcn_mfma_f32_32x32x16_bf16(b0, qr[d0], p0, 0, 0, 0);
        p1 = __builtin_amdgcn_mfma_f32_32x32x16_bf16(b1, qr[d0], p1, 0, 0, 0); }
}
template <int VB>
__device__ __forceinline__ void pv_tile(f32x16* o, int vb0, bf16x8 pa0, bf16x8 pa1, bf16x8 pa2, bf16x8 pa3) {
#define TRRD(dst, off) asm volatile("ds_read_b64_tr_b16 %0, %1 offset:%2" : "=&v"(dst) : "v"(vb0), "i"(off) : "memory")
#define PV_D0(d0) do { s16x4 l0, l1, l2, l3, h0, h1, h2, h3; constexpr int b_ = VB * SHM_V + v_rd_off(d0, 0, 0); \
        TRRD(l0, b_); TRRD(h0, b_ + 2048); TRRD(l1, b_ + 4096); TRRD(h1, b_ + 6144); TRRD(l2, b_ + 8192); TRRD(h2, b_ + 10240); TRRD(l3, b_ + 12288); TRRD(h3, b_ + 14336); \
        asm volatile("s_waitcnt lgkmcnt(0)" ::: "memory"); SBAR();   \
        o[d0] = __builtin_amdgcn_mfma_f32_32x32x16_bf16(pa0, (bf16x8){l0[0], l0[1], l0[2], l0[3], h0[0], h0[1], h0[2], h0[3]}, o[d0], 0, 0, 0);   \
        o[d0] = __builtin_amdgcn_mfma_f32_32x32x16_bf16(pa1, (bf16x8){l1[0], l1[1], l1[2], l1[3], h1[0], h1[1], h1[2], h1[3]}, o[d0], 0, 0, 0);   \
        o[d0] = __builtin_amdgcn_mfma_f32_32x32x16_bf16(pa2, (bf16x8){l2[0], l2[1], l2[2], l2[3], h2[0], h2[1], h2[2], h2[3]}, o[d0], 0, 0, 0);   \
        o[d0] = __builtin_amdgcn_mfma_f32_32x32x16_bf16(pa3, (bf16x8){l3[0], l3[1], l3[2], l3[3], h3[0], h3[1], h3[2], h3[3]}, o[d0], 0, 0, 0); } while (0)
    PV_D0(0); PV_D0(1); PV_D0(2); PV_D0(3);
#undef PV_D0
#undef TRRD
}
struct BlockRef { const bf16_t* Q; const bf16_t* K; const bf16_t* V; bf16_t* O; const float* nck; int P0; int j_lo; };
struct Seam { bf16x8 qr[8]; bf16x8 st_v0, st_v1, st_k0, st_k1; };
#define ROWP(p, k0, rr) ((p) + (size_t)((k0) + (rr)) * PKV + sc)
#define VMW() asm volatile("s_waitcnt vmcnt(0)" ::: "memory")
#define VMWN(n) asm volatile("s_waitcnt vmcnt(%0)" :: "i"(n) : "memory")
#define SLOAD_H(BR, k0, CB) do { S.st_v0 = ld8(ROWP((BR).V, k0, sr)); S.st_v1 = ld8(ROWP((BR).V, k0, 32 + sr));              \
                             S.st_k0 = ld8(ROWP((BR).K, k0, sr)); S.st_k1 = ld8(ROWP((BR).K, k0, 32 + sr)); \
                             if (wid == 0) __builtin_amdgcn_global_load_lds((const unsigned*)((BR).nck + (k0) + lane), (LAS unsigned*)(cumL + (CB) * 64), 4, 0, 0); } while (0)
#define SWRITE_HK(bf) do { int t_ = tid; asm volatile("" : "+v"(t_)); const int kws_ = KSWZ(t_ >> 4, (t_ & 15) * 16); \
                           *(LAS bf16x8*)(K_lds + (bf) * SHM_K + kws_) = S.st_k0; *(LAS bf16x8*)(K_lds + (bf) * SHM_K + kws_ + 32 * 256) = S.st_k1; } while (0)
#define SWRITE_HV(bf) do { int t_ = tid; asm volatile("" : "+v"(t_)); const int vs0_ = v_st(t_ >> 4, (t_ & 15) * 8), vs1_ = v_st(32 + (t_ >> 4), (t_ & 15) * 8); \
                           *(LAS bf16x8*)(V_lds + (bf) * SHM_V + vs0_) = S.st_v0; *(LAS bf16x8*)(V_lds + (bf) * SHM_V + vs1_) = S.st_v1; } while (0)
__device__ __forceinline__ void fox_prime(const BlockRef& cur, LAS char* lds, Seam& S) {
    const int tid = threadIdx.x, wid = __builtin_amdgcn_readfirstlane(tid >> 6), lane = tid & 63, r32 = lane & 31, hi = lane >> 5;
    const int sr = tid >> 4, sc = (tid & 15) * 8; LAS char* K_lds = lds + 2 * SHM_V; LAS float* cumL = (LAS float*)(lds + OFF_CUM);
    const int kb0 = cur.j_lo * KVBLK;
#pragma unroll
    for (int d0 = 0; d0 < 8; ++d0) S.qr[d0] = ld8(cur.Q + (size_t)(wid * QBLK + r32) * PQ + d0 * 16 + hi * 8);
    SLOAD_H(cur, kb0, 0); VMW(); SWRITE_HK(0);
    __syncthreads();
}
__device__ __forceinline__ void fox_block(const BlockRef& cur, const BlockRef& nxt, int skv, LAS char* lds, Seam& S) {
    const int tid = threadIdx.x, wid = __builtin_amdgcn_readfirstlane(tid >> 6), lane = tid & 63, r32 = lane & 31, hi = lane >> 5;
    const int j_lo = cur.j_lo;
    int j_hi = (cur.P0 + QB - 1) / KVBLK + 1; if (j_hi > skv / KVBLK) j_hi = skv / KVBLK;
    const int NT = j_hi - j_lo;
    const int kbn = nxt.j_lo * KVBLK;
    const int qlo = cur.P0 + wid * QBLK;
    LAS char* V_lds = lds; LAS char* K_lds = lds + 2 * SHM_V; LAS float* cumL = (LAS float*)(lds + OFF_CUM);
    LAS float* ws = (LAS float*)(lds + OFF_WS) + wid * 64; LAS float* li_l = ws; LAS float* al_l = ws + 32;
    float m_reg = -1e30f, l_reg = 0; f32x16 o[4] = {};
    const int sr = tid >> 4, sc = (tid & 15) * 8;
    const int vb0 = (int)(unsigned)(uintptr_t)V_lds + v_rd_base(lane);
#define RESC(a) do { if (__any((a) < 1.f)) { if (hi == 0) al_l[r32] = (a); asm volatile("s_waitcnt lgkmcnt(0)" ::: "memory");              \
                     _Pragma("unroll") for (int d_ = 0; d_ < 4; ++d_) _Pragma("unroll") for (int r = 0; r < 16; ++r) o[d_][r] *= al_l[crow(r, hi)]; } } while (0)
#define KBASE(t) ((j_lo + (t)) * KVBLK)
#define MASKT(P0_, P1_, t) do { const int kb_ = KBASE(t); if (kb_ + KVBLK - 1 > qlo) { int lc_ = lane; asm volatile("" : "+v"(lc_)); mask_tile(P0_, P1_, qlo + (lc_ & 31) - 4 * (lc_ >> 5) - kb_, WINF); } } while (0)
    constexpr int NQL = 8;
#define SEAM_K0() do { VMWN(NQL); SWRITE_HK(0); SBAR(); } while (0)
    f32x16 pA0, pA1, pB0, pB1; float mnA, mnB, alA, alB; bf16x8 pa0, pa1, pa2, pa3;
    SWRITE_HV(0); SBAR();
    if (NT > 1) { SLOAD_H(cur, KBASE(1), 1); }
    SBAR(); qkt<0>(pA0, pA1, K_lds, cumL, r32, hi, S.qr);
    MASKT(pA0, pA1, 0); partialSM(pA0, pA1, m_reg, mnA, alA);
    if (NT > 1) { VMW(); SWRITE_HV(1); SWRITE_HK(1); }
    __syncthreads();
#define HALF_STEP(PX0, PX1, mnX, alX, PY0, PY1, alY, t, KB, VB, SB) do {                                                      \
        SBAR(); qkt<KB>(PX0, PX1, K_lds, cumL, r32, hi, S.qr);                                                                \
        finishSM(PY0, PY1, alY, l_reg, pa0, pa1, pa2, pa3); SBAR();                                                           \
        if ((t) + 1 < NT) { SLOAD_H(cur, KBASE((t) + 1), SB); SBAR(); }                                                           \
        pv_tile<VB>(o, vb0, pa0, pa1, pa2, pa3); MASKT(PX0, PX1, (t)); partialSM(PX0, PX1, m_reg, mnX, alX);                  \
        __syncthreads();                                                                                                      \
        if ((t) + 1 < NT) { VMW(); SWRITE_HV(SB); SWRITE_HK(SB); }                                       \
        RESC(alX); __syncthreads(); } while (0)
    for (int t = 1; t + 1 < NT; t += 2) {
        HALF_STEP(pB0, pB1, mnB, alB, pA0, pA1, alA, t, 1, 0, 0);
        HALF_STEP(pA0, pA1, mnA, alA, pB0, pB1, alB, t + 1, 0, 1, 1);
    }
    const bool even = (NT & 1) == 0;
    if (even) { SBAR(); qkt<1>(pB0, pB1, K_lds, cumL, r32, hi, S.qr); SBAR(); }
    SLOAD_H(nxt, kbn, 0); SBAR();
    { int lc_ = lane; asm volatile("" : "+v"(lc_)); const bf16_t* qp_ = nxt.Q + (size_t)(wid * QBLK + (lc_ & 31)) * PQ + (lc_ >> 5) * 8;
#pragma unroll
    for (int d0 = 0; d0 < 8; ++d0) S.qr[d0] = ld8(qp_ + d0 * 16); }
    SBAR();
    finishSM(pA0, pA1, alA, l_reg, pa0, pa1, pa2, pa3); SBAR();
    pv_tile<0>(o, vb0, pa0, pa1, pa2, pa3);
    if (even) { MASKT(pB0, pB1, NT - 1); partialSM(pB0, pB1, m_reg, mnB, alB); __syncthreads(); RESC(alB);
        finishSM(pB0, pB1, alB, l_reg, pa0, pa1, pa2, pa3); SBAR(); pv_tile<1>(o, vb0, pa0, pa1, pa2, pa3); }
    SBAR(); SEAM_K0();
    if (hi == 0) li_l[r32] = l_reg; asm volatile("s_waitcnt lgkmcnt(0)" ::: "memory");
    float rli[16];
#pragma unroll
    for (int r = 0; r < 16; ++r) rli[r] = __builtin_amdgcn_rcpf(li_l[crow(r, hi)]);
    { int lc_ = lane; asm volatile("" : "+v"(lc_)); const int r32c = lc_ & 31, hic = lc_ >> 5;
    bf16_t* Ow = cur.O + (size_t)(wid * QBLK + 4 * hic) * PO + r32c;
#pragma unroll
    for (int r = 0; r < 16; ++r) { const int orow = (r & 3) + 8 * (r >> 2);
#pragma unroll
        for (int d0 = 0; d0 < 4; ++d0) { const float v = o[d0][r] * rli[r];
            const float vn = __shfl_xor(v, 1);
            if ((r32c & 1) == 0) *(unsigned*)(Ow + (size_t)orow * PO + d0 * 32) = cvtpk(v, vn); } } }
    __syncthreads();
#undef RESC
#undef KBASE
#undef MASKT
#undef SEAM_K0
#undef HALF_STEP
}
#undef ROWP
#undef VMW
#undef VMWN
#undef SLOAD_H
#undef SWRITE_HK
#undef SWRITE_HV
#undef SBAR
#undef KSWZ
}

typedef GAS unsigned gu32;
#define RLX_AGENT __ATOMIC_RELAXED, __HIP_MEMORY_SCOPE_AGENT
#define XB_TMO      128
#define XB_XCNT(j)  (256  + 64 * (j))
#define XB_XSUB(j)  (1280 + 64 * (j))
#define XB_XGEN(j)  (2304 + 64 * (j))
#define XB_TOP      3328
#define XB_TOPGEN   3392
#define XCD_BAR_WORDS 3456
#define XB_SPIN_CAP (1u << 20)
__device__ __forceinline__ unsigned xb_ld(unsigned* p)              { return __hip_atomic_load(p, __ATOMIC_RELAXED, __HIP_MEMORY_SCOPE_AGENT); }
__device__ __forceinline__ unsigned xb_add(unsigned* p, unsigned v) { return __hip_atomic_fetch_add(p, v, __ATOMIC_RELAXED, __HIP_MEMORY_SCOPE_AGENT); }
__device__ __forceinline__ unsigned xb_xcc_id() { return (unsigned)__builtin_amdgcn_s_getreg((3 << 11) | 20) & 0xFu; }
#define XB_SPIN(cond, bar) do { unsigned _sp = 0; while (cond) { __builtin_amdgcn_s_sleep(1); \
    if ((++_sp & 255u) == 0u) { if (xb_ld(&(bar)[XB_TMO])) break; if (_sp > XB_SPIN_CAP) { atomicAdd(&(bar)[XB_TMO], 1u); break; } } } } while (0)
struct XcdBarrier { unsigned* bar; unsigned x; volatile LAS unsigned* st; };
__device__ __forceinline__ XcdBarrier xcd_barrier_post(unsigned* bar, volatile LAS unsigned* st) {
    XcdBarrier b; b.bar = bar; b.x = xb_xcc_id(); b.st = st;
    if (threadIdx.x == 0) (void)xb_add(&bar[XB_XCNT(b.x)], 1u);
    return b;
}
__device__ __forceinline__ void xcd_barrier_complete(unsigned* bar, unsigned x, unsigned& nloc, unsigned& nx) {
    const unsigned G = gridDim.x * gridDim.y * gridDim.z;
    unsigned sum, cnt, mine, sp = 0u;
    for (;;) {
        sum = 0u; cnt = 0u; mine = 0u;
#pragma unroll
        for (unsigned j = 0; j < 16; ++j) { const unsigned c = xb_ld(&bar[XB_XCNT(j)]); sum += c; cnt += (c > 0u) ? 1u : 0u; mine = (j == x) ? c : mine; }
        if (sum == G) break;
        __builtin_amdgcn_s_sleep(1);
        if ((++sp & 255u) == 0u) { if (xb_ld(&bar[XB_TMO])) break; if (sp > XB_SPIN_CAP) { atomicAdd(&bar[XB_TMO], 1u); break; } }
    }
    nloc = mine > 0u ? mine : 1u; nx = cnt > 0u ? cnt : 1u;
}
__device__ __forceinline__ void xcd_barrier(const XcdBarrier& b) {
    asm volatile("s_waitcnt vmcnt(0)" ::: "memory");
    __syncthreads();
    if (threadIdx.x == 0) {
        unsigned* bar = b.bar;
        __builtin_amdgcn_s_waitcnt(0);
        unsigned nloc = b.st[0], nx = b.st[1];
        if (nloc == 0u) { xcd_barrier_complete(bar, b.x, nloc, nx); b.st[0] = nloc; b.st[1] = nx; }
        const unsigned old = xb_add(&bar[XB_XSUB(b.x)], 1u);
        const unsigned gen = old / nloc;
        if (old + 1u == (gen + 1u) * nloc) {
            __builtin_amdgcn_fence(__ATOMIC_RELEASE, "agent");
            asm volatile("s_waitcnt vmcnt(0)" ::: "memory");
            const unsigned og = xb_add(&bar[XB_TOP], 1u);
            const unsigned tg = og / nx;
            if (og + 1u == (tg + 1u) * nx) xb_add(&bar[XB_TOPGEN], 1u);
            else XB_SPIN(xb_ld(&bar[XB_TOPGEN]) == tg, bar);
            __builtin_amdgcn_fence(__ATOMIC_ACQUIRE, "agent");
            xb_add(&bar[XB_XGEN(b.x)], 1u);
            asm volatile("s_waitcnt vmcnt(0)" ::: "memory");
        } else {
            XB_SPIN(xb_ld(&bar[XB_XGEN(b.x)]) == gen, bar);
            __builtin_amdgcn_fence(__ATOMIC_ACQUIRE, "agent");
            asm volatile("s_waitcnt vmcnt(0)" ::: "memory");
        }
    }
    __syncthreads();
}

constexpr int NWAVES = 8;
constexpr int N_PHASES = 12;
constexpr int N_LAUNCHES = MK_N_LAUNCHES;
static_assert(N_LAUNCHES == 1 || N_LAUNCHES == N_PHASES, "MK_N_LAUNCHES is 1 (one dispatch) or 12 (one dispatch per phase)");
struct Args { const float* in[29]; float* out; unsigned char* ws; int ph_lo, ph_hi; };
struct Frame {
    LAS unsigned char* lds; volatile LAS unsigned* MISC; gu32* ctl; unsigned char* ws;
    int tid, lane, wave, vcu, G;
};

struct TileRef { const float* src; void* dst; int ld_src, ld_dst, f8; };
__device__ __forceinline__ void p0_tile_load(const TileRef& t, f32x4 (&v)[16], int lane) {
    const int c4 = lane & 7, r8 = lane >> 3;
#pragma unroll
    for (int it = 0; it < 16; ++it) v[it] = *(const f32x4*)(t.src + (size_t)(it * 8 + r8) * t.ld_src + 4 * c4);
}
__device__ __forceinline__ void p0_tile_store(const TileRef& t, const f32x4 (&v)[16], LAS float* scr, int lane) {
    const int c4 = lane & 7, r8 = lane >> 3;
#pragma unroll
    for (int it = 0; it < 16; ++it) { const int r = it * 8 + r8;
#pragma unroll
        for (int e = 0; e < 4; ++e) scr[(4 * c4 + e) * 132 + r] = v[it][e]; }
    LDS_WAIT(); asm volatile("" ::: "memory");
    const int kc = lane & 15, n4 = lane >> 4;
#pragma unroll
    for (int it = 0; it < 8; ++it) { const int n = it * 4 + n4;
        const f32x4 a = *(const LAS f32x4*)(scr + n * 132 + 8 * kc), b = *(const LAS f32x4*)(scr + n * 132 + 8 * kc + 4);
        if (t.f8) { int lo = 0, hi = 0;
            lo = __builtin_amdgcn_cvt_pk_fp8_f32(a[0] * W8SCALE, a[1] * W8SCALE, lo, false); lo = __builtin_amdgcn_cvt_pk_fp8_f32(a[2] * W8SCALE, a[3] * W8SCALE, lo, true);
            hi = __builtin_amdgcn_cvt_pk_fp8_f32(b[0] * W8SCALE, b[1] * W8SCALE, hi, false); hi = __builtin_amdgcn_cvt_pk_fp8_f32(b[2] * W8SCALE, b[3] * W8SCALE, hi, true);
            *(u32x2*)((unsigned char*)t.dst + (size_t)n * t.ld_dst + 8 * kc) = (u32x2){(unsigned)lo, (unsigned)hi}; }
        else { u32x4 w; w.x = cvt_pk_bf16(a[0], a[1]); w.y = cvt_pk_bf16(a[2], a[3]); w.z = cvt_pk_bf16(b[0], b[1]); w.w = cvt_pk_bf16(b[2], b[3]);
            *(u32x4*)((bf16_t*)t.dst + (size_t)n * t.ld_dst + 8 * kc) = w; } }
    LDS_WAIT(); asm volatile("" ::: "memory");
}
template <int MODE, int F8>
__device__ __forceinline__ TileRef p0_mat_ref(const float* src, int ldsrc, int K, int N, void* dst, int which, int it) {
    const int nblk = N / 32, kb = it / nblk, nb = it - kb * nblk, k0 = 128 * kb, n0 = 32 * nb;
    const int drow = MODE == 0 ? n0 : ((n0 >> 7) * 256 + which * 128 + (n0 & 127));
    TileRef t; t.src = src + (size_t)k0 * ldsrc + n0; t.ld_src = ldsrc; t.f8 = F8; t.ld_dst = K;
    t.dst = F8 ? (void*)((unsigned char*)dst + (size_t)drow * K + k0) : (void*)((bf16_t*)dst + (size_t)drow * K + k0); return t;
}
__device__ __forceinline__ void p0_prologue(Frame& F, const __attribute__((address_space(4))) Args& a) {
    unsigned char* ws = F.ws;
    const int gw = F.vcu * NWAVES + F.wave, NGW = F.G * NWAVES;
    {
        LAS float* scr = (LAS float*)(F.lds + F.wave * 16896);
        constexpr int I_EXP = 256;
        constexpr int N_EG = NEXP * I_EXP, N_EU = N_EG, N_ED = N_EG;
        constexpr int I_IN = 16 * 128, I_OUT = 16 * 64, I_GLU = 8 * 32, I_R = 16 * 2, I_SG = 16 * 16, I_SU = 16 * 16, I_SD = 4 * 64;
        constexpr int NITEMS = N_EG + N_EU + N_ED + I_IN + I_OUT + I_GLU + I_R + I_SG + I_SU + I_SD;
        unsigned char* Wegu = ws + WS_WEGU; unsigned char* Wed = ws + WS_WED;
#define P0_REF(T, it_) do { int r = (it_); \
            if (r < N_EG) { const int e = r / I_EXP; T = p0_mat_ref<1, 1>(a.in[21] + (size_t)e * 2048 * 512, 512, 2048, 512, Wegu + (size_t)e * 1024 * 2048, 0, r % I_EXP); break; } r -= N_EG; \
            if (r < N_EU) { const int e = r / I_EXP; T = p0_mat_ref<1, 1>(a.in[22] + (size_t)e * 2048 * 512, 512, 2048, 512, Wegu + (size_t)e * 1024 * 2048, 1, r % I_EXP); break; } r -= N_EU; \
            if (r < N_ED) { const int e = r / I_EXP; T = p0_mat_ref<0, 1>(a.in[23] + (size_t)e * 512 * 2048, 2048, 512, 2048, Wed + (size_t)e * 2048 * 512, 0, r % I_EXP); break; } r -= N_ED; \
            if (r < I_IN) { T = p0_mat_ref<0, 0>(a.in[4], 4104, 2048, 4096, (bf16_t*)(ws + WS_WIN), 0, r); break; } r -= I_IN; \
            if (r < I_OUT) { T = p0_mat_ref<0, 0>(a.in[16], 2048, 2048, 2048, (bf16_t*)(ws + WS_WOUT), 0, r); break; } r -= I_OUT; \
            if (r < I_GLU) { T = p0_mat_ref<0, 0>(a.in[14], 1024, 1024, 1024, (bf16_t*)(ws + WS_WGLU), 0, r); break; } r -= I_GLU; \
            if (r < I_R) { T = p0_mat_ref<0, 0>(a.in[19], 64, 2048, 64, (bf16_t*)(ws + WS_WR), 0, r); break; } r -= I_R; \
            if (r < I_SG) { T = p0_mat_ref<1, 1>(a.in[24], 512, 2048, 512, (ws + WS_WSGU), 0, r); break; } r -= I_SG; \
            if (r < I_SU) { T = p0_mat_ref<1, 1>(a.in[25], 512, 2048, 512, (ws + WS_WSGU), 1, r); break; } r -= I_SU; \
            T = p0_mat_ref<0, 1>(a.in[26], 2048, 512, 2048, (ws + WS_WSD), 0, r); } while (0)
        for (int rep_ = 0; rep_ < ((REP_PH) == 20 ? 2 : 1); ++rep_) {
        int it = gw;
        if (it < NITEMS) {
            TileRef tc, tn; f32x4 vc[16], vn[16];
            P0_REF(tc, it); p0_tile_load(tc, vc, F.lane);
            for (;;) {
                const int itn = it + NGW; const bool more = itn < NITEMS;
                if (more) { P0_REF(tn, itn); p0_tile_load(tn, vn, F.lane); }
                p0_tile_store(tc, vc, scr, F.lane);
                if (!more) break;
#pragma unroll
                for (int i = 0; i < 16; ++i) vc[i] = vn[i];
                tc = tn; it = itn;
            }
        }
        }
#undef P0_REF
    }
    __syncthreads();
    if (F.vcu < NGRP) {
        const int g = F.vcu, t = F.tid;
        LAS float* apr = (LAS float*)F.lds;
        LAS float* api = apr + 64 * 33;
        LAS float* bbr = api + 64 * 33;
        LAS float* bbi = bbr + 1024;
        LAS float* cr = bbi + 1024;
        LAS float* ci = cr + 1024;
        LAS float* kg = ci + 1024;
        LAS float* dsk = kg + 8192;
        const float* a_re = a.in[6]; const float* a_im = a.in[7]; const float* log_dt = a.in[8];
        const float* b_re = a.in[9]; const float* b_im = a.in[10]; const float* c_re = a.in[11]; const float* c_im = a.in[12]; const float* dsk_g = a.in[13];
        { const float dt = expf(log_dt[g]);
          for (int idx = t; idx < 64 * 33; idx += 512) { const int p = idx / 33, tau = idx - p * 33; const float ar = a_re[g * 64 + p], ai = a_im[g * 64 + p];
              const float m = expf((float)tau * dt * ar); float s, c; sincosf((float)tau * dt * ai, &s, &c); apr[idx] = m * c; api[idx] = m * s; } }
        for (int idx = t; idx < 1024; idx += 512) { cr[idx] = c_re[g * 1024 + idx]; ci[idx] = c_im[g * 1024 + idx]; }
        if (t < 16) dsk[t] = dsk_g[g * 16 + t];
        __syncthreads();
        for (int idx = t; idx < 1024; idx += 512) { const int p = idx >> 4; const float ar = a_re[g * 64 + p], ai = a_im[g * 64 + p];
            const float abr = apr[p * 33 + 1] - 1.f, abi = api[p * 33 + 1], den = ar * ar + ai * ai;
            const float cre = (abr * ar + abi * ai) / den, cim = (abi * ar - abr * ai) / den;
            const float br = b_re[g * 1024 + idx], bi = b_im[g * 1024 + idx]; bbr[idx] = cre * br - cim * bi; bbi[idx] = cre * bi + cim * br; }
        __syncthreads();
        { const int tau = t >> 4, hp = t & 15;
          float acc[16];
#pragma unroll
          for (int h = 0; h < 16; ++h) acc[h] = 0.f;
          for (int p = 0; p < 64; ++p) { const float c_r = cr[hp * 64 + p], c_i = ci[hp * 64 + p], pr = apr[p * 33 + tau], pi = api[p * 33 + tau];
              const float gr = c_r * pr - c_i * pi, gi = c_r * pi + c_i * pr;
#pragma unroll
              for (int h4 = 0; h4 < 4; ++h4) { const f32x4 br4 = *(const LAS f32x4*)(bbr + p * 16 + 4 * h4), bi4 = *(const LAS f32x4*)(bbi + p * 16 + 4 * h4);
#pragma unroll
                  for (int e = 0; e < 4; ++e) acc[4 * h4 + e] += gr * br4[e] - gi * bi4[e]; } }
#pragma unroll
          for (int h = 0; h < 16; ++h) kg[tau * 256 + hp * 16 + h] = acc[h] + ((tau == 0 && hp == h) ? dsk[h] : 0.f); }
        __syncthreads();
        bf16_t* OPY = (bf16_t*)(ws + WS_OPY) + (size_t)g * 512 * UGK;
        for (int it = t; it < 512 * 80; it += 512) { const int n = it / 80, ch = it - n * 80, tt = n >> 4, hp = n & 15; float v[8];
            if (ch < 64) { const int j = ch >> 1, h0 = (ch & 1) * 8;
#pragma unroll
                for (int e = 0; e < 8; ++e) v[e] = (tt >= j) ? kg[(tt - j) * 256 + hp * 16 + h0 + e] : 0.f; }
            else { const int q = ch - 64;
#pragma unroll
                for (int e2 = 0; e2 < 4; ++e2) { const int p = q * 4 + e2; const float c_r = cr[hp * 64 + p], c_i = ci[hp * 64 + p], pr = apr[p * 33 + tt + 1], pi = api[p * 33 + tt + 1];
                    v[2 * e2] = c_r * pr - c_i * pi; v[2 * e2 + 1] = -(c_r * pi + c_i * pr); } }
            u32x4 w; w.x = cvt_pk_bf16(v[0], v[1]); w.y = cvt_pk_bf16(v[2], v[3]); w.z = cvt_pk_bf16(v[4], v[5]); w.w = cvt_pk_bf16(v[6], v[7]);
            *(u32x4*)(OPY + (size_t)n * UGK + ch * 8) = w; }
        bf16_t* OPE = (bf16_t*)(ws + WS_OPE) + (size_t)g * 256 * 512;
        for (int it = t; it < 256 * 64; it += 512) { const int n = it >> 6, ch = it & 63; float v[8];
            if (n < 128) { const int p = n >> 1, ri = n & 1, j = ch >> 1, h0 = (ch & 1) * 8; const float pr = apr[p * 33 + 31 - j], pi = api[p * 33 + 31 - j];
#pragma unroll
                for (int e = 0; e < 8; ++e) { const float br = bbr[p * 16 + h0 + e], bi = bbi[p * 16 + h0 + e]; v[e] = ri == 0 ? (pr * br - pi * bi) : (pr * bi + pi * br); } }
            else {
#pragma unroll
                for (int e = 0; e < 8; ++e) v[e] = 0.f; }
            u32x4 w; w.x = cvt_pk_bf16(v[0], v[1]); w.y = cvt_pk_bf16(v[2], v[3]); w.z = cvt_pk_bf16(v[4], v[5]); w.w = cvt_pk_bf16(v[6], v[7]);
            *(u32x4*)(OPE + (size_t)n * 512 + ch * 8) = w; }
    }
    __syncthreads();
    {
        const int gt = F.vcu * 512 + F.tid, NGT = F.G * 512; const u32x4 z4 = {0u, 0u, 0u, 0u};
        for (int i = gt; i < 2 * 2 * 48 * 128; i += NGT) { const int ch = i & 127, r = (i >> 7) % 48, b = ((i >> 7) / 48) & 1, kv = (i >> 7) / 96;
            bf16_t* base = (bf16_t*)(ws + (kv ? WS_V : WS_K)); *(u32x4*)(base + ((size_t)b * KVR + r) * 1024 + ch * 8) = z4; }
        for (int i = gt; i < 128 * 32; i += NGT) { const int ch = i & 31, gb = i >> 5;
            *(u32x4*)((bf16_t*)(ws + WS_UG) + ((size_t)gb * NCHK + 1) * UGK + ch * 8) = z4; }
        for (int i = gt; i < 16 * 48; i += NGT) { const int r = i % 48, bh = i / 48; ((float*)(ws + WS_LOGF))[(size_t)bh * KVR + r] = 0.f; }
    }
    {
        LAS float* wf = (LAS float*)F.lds;
        for (int i = F.tid; i < 8 * 2048; i += 512) { const int h = i & 7, k = i >> 3; wf[h * 2048 + k] = a.in[4][(size_t)k * 4104 + 4096 + h]; }
        __syncthreads();
        const float* x = a.in[0]; const float* meta = a.in[1]; const float* lg = a.in[2]; const float* lb = a.in[3]; const float* bfg = a.in[5];
        bf16_t* XN = (bf16_t*)(ws + WS_XN); float* logf_ = (float*)(ws + WS_LOGF);
        for (int row = gw; row < MX + NMETA; row += NGW) {
            const float* src = row < MX ? x + (size_t)row * DM : meta + (size_t)(row - MX) * DM;
            f32x4 v[8]; float s = 0.f;
#pragma unroll
            for (int j = 0; j < 8; ++j) { v[j] = ((const f32x4*)src)[j * 64 + F.lane]; s += (v[j][0] + v[j][1]) + (v[j][2] + v[j][3]); }
            const float mean = wave_sum(s) * (1.f / DM); float s2 = 0.f;
#pragma unroll
            for (int j = 0; j < 8; ++j) { v[j] = v[j] - mean; s2 += (v[j][0] * v[j][0] + v[j][1] * v[j][1]) + (v[j][2] * v[j][2] + v[j][3] * v[j][3]); }
            const float rstd = 1.f / sqrtf(wave_sum(s2) * (1.f / DM) + LN_EPS);
            float fl[8];
#pragma unroll
            for (int h = 0; h < 8; ++h) fl[h] = 0.f;
#pragma unroll
            for (int j = 0; j < 8; ++j) { const f32x4 g4 = ((const f32x4*)lg)[j * 64 + F.lane], b4 = ((const f32x4*)lb)[j * 64 + F.lane];
                v[j] = v[j] * rstd * g4 + b4;
                *(u32x2*)(XN + (size_t)row * DM + j * 256 + F.lane * 4) = (u32x2){cvt_pk_bf16(v[j][0], v[j][1]), cvt_pk_bf16(v[j][2], v[j][3])};
#pragma unroll
                for (int h = 0; h < 8; ++h) { const f32x4 w4 = *(const LAS f32x4*)(wf + h * 2048 + j * 256 + F.lane * 4); fl[h] += (v[j][0] * w4[0] + v[j][1] * w4[1]) + (v[j][2] * w4[2] + v[j][3] * w4[3]); } }
#pragma unroll
            for (int h = 0; h < 8; ++h) fl[h] = wave_sum(fl[h]);
            if (F.lane < 8) { const int h = F.lane;
                float val = h == 0 ? fl[0] : h == 1 ? fl[1] : h == 2 ? fl[2] : h == 3 ? fl[3] : h == 4 ? fl[4] : h == 5 ? fl[5] : h == 6 ? fl[6] : fl[7];
                val += bfg[h];
                const float lf = fminf(val, 0.f) - log1pf(expf(-fabsf(val)));
                if (row < MX) { const int b = row >> 13, sx = row & (SEQ - 1); logf_[(size_t)(b * 8 + h) * KVR + 64 + sx] = lf; }
                else { const int i = row - MX; logf_[(size_t)(0 * 8 + h) * KVR + 48 + i] = lf; logf_[(size_t)(1 * 8 + h) * KVR + 48 + i] = lf; } }
        }
    }
    {
        __syncthreads();
        LAS float* hm = (LAS float*)F.lds;
        const float* meta = a.in[1]; const float* lg = a.in[2]; const float* lb = a.in[3]; const float* w_in = a.in[4];
#pragma unroll 1
        for (int rr = 0; rr < 2; ++rr) { const int row = F.wave * 2 + rr; const float* src = meta + (size_t)row * DM;
            f32x4 v[8]; float s = 0.f;
#pragma unroll
            for (int j = 0; j < 8; ++j) { v[j] = ((const f32x4*)src)[j * 64 + F.lane]; s += (v[j][0] + v[j][1]) + (v[j][2] + v[j][3]); }
            const float mean = wave_sum(s) * (1.f / DM); float s2 = 0.f;
#pragma unroll
            for (int j = 0; j < 8; ++j) { v[j] = v[j] - mean; s2 += (v[j][0] * v[j][0] + v[j][1] * v[j][1]) + (v[j][2] * v[j][2] + v[j][3] * v[j][3]); }
            const float rstd = 1.f / sqrtf(wave_sum(s2) * (1.f / DM) + LN_EPS);
#pragma unroll
            for (int j = 0; j < 8; ++j) { const f32x4 g4 = ((const f32x4*)lg)[j * 64 + F.lane], b4 = ((const f32x4*)lb)[j * 64 + F.lane];
                *(LAS f32x4*)(hm + row * 2048 + j * 256 + F.lane * 4) = v[j] * rstd * g4 + b4; } }
        __syncthreads();
        for (int c = F.vcu; c < 256; c += F.G) {
            const int col0 = 16 * c, sect = col0 >> 10; if (sect == 1) continue;
            const int r = F.tid >> 5, ks = F.tid & 31;
            f32x4 a0 = {0.f, 0.f, 0.f, 0.f}, a1 = a0, a2 = a0, a3 = a0;
#pragma unroll 4
            for (int i = 0; i < 64; ++i) { const int k = ks + 32 * i; const float h = hm[r * 2048 + k]; const f32x4* wp = (const f32x4*)(w_in + (size_t)k * 4104 + col0);
                a0 += h * wp[0]; a1 += h * wp[1]; a2 += h * wp[2]; a3 += h * wp[3]; }
#pragma unroll
            for (int o = 1; o < 32; o <<= 1) {
#pragma unroll
                for (int e = 0; e < 4; ++e) { a0[e] += __shfl_xor(a0[e], o); a1[e] += __shfl_xor(a1[e], o); a2[e] += __shfl_xor(a2[e], o); a3[e] += __shfl_xor(a3[e], o); } }
            if (ks == 0) { const int colsec = col0 & 1023;
                const u32x4 w0 = {cvt_pk_bf16(a0[0], a0[1]), cvt_pk_bf16(a0[2], a0[3]), cvt_pk_bf16(a1[0], a1[1]), cvt_pk_bf16(a1[2], a1[3])};
                const u32x4 w1 = {cvt_pk_bf16(a2[0], a2[1]), cvt_pk_bf16(a2[2], a2[3]), cvt_pk_bf16(a3[0], a3[1]), cvt_pk_bf16(a3[2], a3[3])};
#pragma unroll
                for (int b = 0; b < 2; ++b) { bf16_t* dst;
                    if (sect == 0) dst = (bf16_t*)(ws + WS_UG) + ((size_t)(((colsec >> 4) * 2 + b) * NCHK + 1)) * UGK + (16 + r) * 16;
                    else dst = (bf16_t*)(ws + (sect == 2 ? WS_K : WS_V)) + ((size_t)b * KVR + 48 + r) * 1024 + colsec;
                    *(u32x4*)dst = w0; *(u32x4*)(dst + 8) = w1; } }
        }
    }
}

__device__ __forceinline__ void p1_cumsum(Frame& F, int seq) {
    const float* lf = (const float*)(F.ws + WS_LOGF) + (size_t)seq * KVR; float* cum = (float*)(F.ws + WS_CUM) + (size_t)seq * KVR;
    LAS float* part = (LAS float*)F.lds;
    constexpr int PER = 17; const int i0 = F.tid * PER; float s = 0.f;
    for (int k = 0; k < PER; ++k) { const int i = i0 + k; if (i < KVR) s += lf[i]; }
    part[F.tid] = s; __syncthreads();
    float pre = 0.f; for (int j = 0; j < F.tid; ++j) pre += part[j];
    for (int k = 0; k < PER; ++k) { const int i = i0 + k; if (i < KVR) { pre += lf[i]; cum[i] = (i < 48) ? -__builtin_inff() : -pre * LOG2E; } }
    __syncthreads();
}

__device__ __forceinline__ void moe_tables(Frame& F) {
    LAS int* tb = (LAS int*)(F.lds + TB_OFF);
    if (F.tid < NEXP) tb[130 + F.tid] = (int)__hip_atomic_load(F.ctl + CW_CNT + 64 * F.tid, RLX_AGENT);
    __syncthreads();
    if (F.tid == 0) { int tp = 0, cp = 0; for (int e = 0; e < NEXP; ++e) { tb[e] = tp; tb[65 + e] = cp; const int c = tb[130 + e]; tp += (c + 255) >> 8; cp += c; } tb[64] = tp; tb[129] = cp; }
    __syncthreads();
}

template <unsigned MASK>
__global__ void __launch_bounds__(NWAVES * 64, 2) hymba_fwd(Args args_) {
    extern __shared__ __attribute__((aligned(16))) unsigned char lds[];
    (void)args_;
    const __attribute__((address_space(4))) Args& args = *(const __attribute__((address_space(4))) Args*)__builtin_amdgcn_kernarg_segment_ptr();
    Frame F;
    F.lds = (LAS unsigned char*)lds;
    F.MISC = (volatile LAS unsigned*)(F.lds + MISC_OFF);
    F.tid = threadIdx.x; F.lane = F.tid & 63; F.wave = __builtin_amdgcn_readfirstlane(F.tid >> 6);
    F.G = gridDim.x; { const int bx = blockIdx.x; F.vcu = (F.G % 8 == 0) ? (bx % 8) * (F.G / 8) + bx / 8 : bx; }
    unsigned char* ws = args.ws; F.ws = ws;
    F.ctl = (gu32*)(ws + WS_CTL);
    for (int u = F.tid; u < (LDS_BYTES - LDSCTL_OFF) / 4; u += NWAVES * 64) ((LAS unsigned*)(F.lds + LDSCTL_OFF))[u] = 0u;
    __syncthreads();
    XcdBarrier bar; bar.bar = (unsigned*)(F.ctl + CW_BAR); bar.x = 0; bar.st = nullptr;
    if (N_LAUNCHES == 1) bar = xcd_barrier_post((unsigned*)(F.ctl + CW_BAR), F.MISC + 8);
#define GRID_BAR() do { if (N_LAUNCHES == 1) xcd_barrier(bar); } while (0)
    const int lo = args.ph_lo, hi = args.ph_hi;
#define IN(k) (((MASK >> (k)) & 1u) && lo <= (k) && (k) < hi)
#define BOTH(k) (IN(k) && IN((k) + 1))
#define REPS(k) for (int rep_ = 0; rep_ < ((REP_PH) == (k) ? 2 : 1); ++rep_)
    const int gw = F.vcu * NWAVES + F.wave, NGW = F.G * NWAVES;
    const int bx = (int)blockIdx.x;

    if (IN(0)) { REPS(0) { p0_prologue(F, args); __syncthreads(); } if (BOTH(0)) GRID_BAR(); }

    if (IN(1)) {
        if (F.vcu < 16) p1_cumsum(F, F.vcu);
        pg8::DenseOrder S; S.init(ws + WS_XN, ws + WS_WIN, DM, DM, MX, 4096, F.G, bx);
        pg8::EpiInProj E{(bf16_t*)(ws + WS_UG), (bf16_t*)(ws + WS_Q), (bf16_t*)(ws + WS_K), (bf16_t*)(ws + WS_V)};
        REPS(1) pg8::gemm_phase<pg8::EpiInProj, pg8::DenseOrder, true>(F.lds, pg8::GemmK{DM, DM, DM}, S, E);
        if (BOTH(1)) GRID_BAR();
    }

    if (IN(2)) {
        REPS(2)
        for (int L = bx; L < 256; L += F.G) {
            const int g = L >> 2, b = (L >> 1) & 1, pn = L & 1, gb = g * 2 + b;
            { pg8::OneUnit S; S.u.A = (const char*)(ws + WS_UG) + ((size_t)(gb * NCHK + 1)) * UGK * 2; S.u.B = (const char*)(ws + WS_OPE) + (size_t)g * 256 * 512 * 2; S.u.rows = nullptr;
              S.u.r0 = gb * 256; S.u.c0 = 0; S.u.valid = 256; S.u.aux = g; S.rowbytes = UGK * 2;
              pg8::EpiE E{(float*)(ws + WS_E)};
              for (int r2_ = 0; r2_ < ((REP_PH) == 21 ? 2 : 1); ++r2_) pg8::gemm_phase<pg8::EpiE, pg8::OneUnit, false>(F.lds, pg8::GemmK{512, UGK, 512}, S, E); }
            VM_WAIT(); __syncthreads();
            for (int r2_ = 0; r2_ < ((REP_PH) == 22 ? 2 : 1); ++r2_)
            if (F.wave == 0) {
                __builtin_amdgcn_fence(__ATOMIC_ACQUIRE, "agent");
                const int p = F.lane;
                const float dt = expf(args.in[8][g]), ar = args.in[6][g * 64 + p], ai = args.in[7][g * 64 + p];
                const float mag = expf(32.f * dt * ar); float sn, cs; sincosf(32.f * dt * ai, &sn, &cs);
                const float a_r = mag * cs, a_i = mag * sn;
                const float* Eb = (const float*)(ws + WS_E) + (size_t)gb * 256 * 128 + 2 * p;
                bf16_t* Ub = (bf16_t*)(ws + WS_UG) + (size_t)gb * NCHK * UGK + 512 + 2 * p;
                float sr = 0.f, si = 0.f;
#pragma unroll 1
                for (int r0 = 0; r0 < 256; r0 += 32) { f32x2 ev[32];
#pragma unroll
                    for (int i = 0; i < 32; ++i) ev[i] = *(const f32x2*)(Eb + (size_t)(r0 + i) * 128);
#pragma unroll
                    for (int i = 0; i < 32; ++i) { const float nr = a_r * sr - a_i * si + ev[i][0], ni = a_r * si + a_i * sr + ev[i][1]; sr = nr; si = ni;
                        *(unsigned*)(Ub + (size_t)(r0 + i + 2) * UGK) = cvt_pk_bf16(sr, si); } }
            } else {
                const bf16_t* Qb = (const bf16_t*)(ws + WS_Q); const bf16_t* Kb = (const bf16_t*)(ws + WS_K);
                for (int it = (L * 7 + F.wave - 1); it < 1024 + 1032; it += 256 * 7) {
                    const bool isq = it < 1024; const int row0 = (isq ? it : it - 1024) * 16;
                    const bf16_t* base = (isq ? Qb : Kb) + (size_t)row0 * 1024 + F.lane * 8;
                    float mx0 = 0.f, mx1 = 0.f;
#pragma unroll 4
                    for (int r = 0; r < 16; ++r) {
#pragma unroll
                        for (int half = 0; half < 2; ++half) { const u32x4 w = *(const u32x4*)(base + (size_t)r * 1024 + half * 512);
                            float ss = bf_lo(w.x) * bf_lo(w.x) + bf_hi(w.x) * bf_hi(w.x) + bf_lo(w.y) * bf_lo(w.y) + bf_hi(w.y) * bf_hi(w.y) + bf_lo(w.z) * bf_lo(w.z) + bf_hi(w.z) * bf_hi(w.z) + bf_lo(w.w) * bf_lo(w.w) + bf_hi(w.w) * bf_hi(w.w);
                            ss += __shfl_xor(ss, 1); ss += __shfl_xor(ss, 2); ss += __shfl_xor(ss, 4); ss += __shfl_xor(ss, 8);
                            if (half == 0) mx0 = fmaxf(mx0, ss); else mx1 = fmaxf(mx1, ss); } }
                    if ((F.lane & 15) == 0) { const int g4 = F.lane >> 4;
                        if (isq) { const int bb = row0 >> 13, qb = (row0 & (SEQ - 1)) >> 8;
                            __hip_atomic_fetch_max(F.ctl + CW_QMAX + ((bb * 8 + g4) * 32 + qb), __float_as_uint(mx0), RLX_AGENT);
                            __hip_atomic_fetch_max(F.ctl + CW_QMAX + ((bb * 8 + 4 + g4) * 32 + qb), __float_as_uint(mx1), RLX_AGENT); }
                        else { const int bb = row0 / KVR;
                            __hip_atomic_fetch_max(F.ctl + CW_KMAX + (bb * 8 + g4), __float_as_uint(mx0), RLX_AGENT);
                            __hip_atomic_fetch_max(F.ctl + CW_KMAX + (bb * 8 + 4 + g4), __float_as_uint(mx1), RLX_AGENT); } }
                }
            }
            VM_WAIT(); __syncthreads();
            if (F.tid == 0) { __builtin_amdgcn_fence(__ATOMIC_ACQUIRE, "agent"); VM_WAIT(); }
            __syncthreads();
            { pg8::OneUnit S; S.u.A = (const char*)(ws + WS_UG) + ((size_t)(gb * NCHK + 2)) * UGK * 2; S.u.B = (const char*)(ws + WS_OPY) + ((size_t)g * 512 + pn * 256) * UGK * 2; S.u.rows = nullptr;
              S.u.r0 = b; S.u.c0 = pn; S.u.valid = 256; S.u.aux = g; S.rowbytes = UGK * 2;
              pg8::EpiY E{(bf16_t*)(ws + WS_YB)};
              for (int r2_ = 0; r2_ < ((REP_PH) == 23 ? 2 : 1); ++r2_) pg8::gemm_phase<pg8::EpiY, pg8::OneUnit, false>(F.lds, pg8::GemmK{UGK, UGK, UGK}, S, E); }
        }
        if (BOTH(2)) GRID_BAR();
    }

    if (IN(5)) {
        pg8::DenseOrder S; S.init(ws + WS_YB, ws + WS_WGLU, 1024, 1024, MX, 1024, F.G, bx);
        pg8::EpiGlu E{(const bf16_t*)(ws + WS_YB), args.in[15], (bf16_t*)(ws + WS_YC)};
        REPS(5) pg8::gemm_phase<pg8::EpiGlu, pg8::DenseOrder, true>(F.lds, pg8::GemmK{1024, 1024, 1024}, S, E);
    }

    if (IN(6)) {
        const bf16_t* Qb = (const bf16_t*)(ws + WS_Q); const bf16_t* Kb = (const bf16_t*)(ws + WS_K); const bf16_t* Vb = (const bf16_t*)(ws + WS_V);
        bf16_t* YC = (bf16_t*)(ws + WS_YC); const float* nck = (const float*)(ws + WS_CUM);
        LAS char* al = (LAS char*)F.lds;
        LAS unsigned* skey = (LAS unsigned*)(F.lds + 71680);
        att::Seam S;
#define MKREF(R, key_) do { const int id_ = (int)((key_) & 511u), bh_ = id_ >> 5, qb_ = id_ & 31, b_ = bh_ >> 3, h_ = bh_ & 7; (R).Q = Qb + ((size_t)b_ * SEQ + (size_t)qb_ * 256) * 1024 + h_ * 128; \
        (R).K = Kb + (size_t)b_ * KVR * 1024 + h_ * 128; (R).V = Vb + (size_t)b_ * KVR * 1024 + h_ * 128; (R).O = YC + ((size_t)b_ * SEQ + (size_t)qb_ * 256) * 2048 + 1024 + h_ * 128; \
        (R).nck = nck + (size_t)bh_ * KVR; (R).P0 = 64 + qb_ * 256; (R).j_lo = (int)(((key_) >> 10) & 1023u); } while (0)
        REPS(6) {
        { const int id = F.tid, bh = id >> 5, qb = id & 31, P0 = 64 + qb * 256; const float* nk = nck + (size_t)bh * KVR;
          const float q2 = __uint_as_float(__hip_atomic_load(F.ctl + CW_QMAX + id, RLX_AGENT)), k2 = __uint_as_float(__hip_atomic_load(F.ctl + CW_KMAX + bh, RLX_AGENT));
          const float thr = nk[P0] - T_SKIP - 2.f * sqrtf(q2 * k2) * 1.001f;
          int lo_ = 0, hi_ = 4 * qb + 1;
          while (lo_ < hi_) { const int mid = (lo_ + hi_) >> 1; if (nk[64 * mid + 63] < thr) lo_ = mid + 1; else hi_ = mid; }
          skey[id] = ((unsigned)(4 * qb + 5 - lo_) << 20) | ((unsigned)lo_ << 10) | (unsigned)id; }
        for (int k = 2; k <= 512; k <<= 1)
            for (int j = k >> 1; j > 0; j >>= 1) { __syncthreads(); const int ixj = F.tid ^ j;
                if (ixj > F.tid) { const unsigned a = skey[F.tid], b = skey[ixj]; const bool up = (F.tid & k) == 0;
                    if (up ? (a < b) : (a > b)) { skey[F.tid] = b; skey[ixj] = a; } } }
        __syncthreads();
        int pi = F.vcu;
        if (pi < 256) {
            int pass = 0; att::BlockRef cur, nxt;
            { const unsigned key = skey[511 - pi]; MKREF(cur, key); }
            att::fox_prime(cur, al, S);
            for (;;) {
                const bool more_pass = pass == 0, more_item = pi + F.G < 256, last = !more_pass && !more_item;
                int pin = pi, passn = pass + 1;
                if (!more_pass) { passn = 0; pin = more_item ? pi + F.G : pi; }
                if (last) nxt = cur; else { const unsigned key = skey[passn ? pin : 511 - pin]; MKREF(nxt, key); }
                att::fox_block(cur, nxt, KVR, al, S);
                if (last) break;
                cur = nxt; pass = passn; pi = pin;
            }
        }
        __syncthreads();
        }
#undef MKREF
        if (BOTH(6)) GRID_BAR();
    }

    if (IN(7)) {
        pg8::DenseOrder S; S.init(ws + WS_YC, ws + WS_WOUT, 2048, 2048, MX, 2048, F.G, bx);
        pg8::EpiOut E{(const bf16_t*)(ws + WS_XN), (float*)(ws + WS_Z), (float*)(ws + WS_ST)};
        REPS(7) pg8::gemm_phase<pg8::EpiOut, pg8::DenseOrder, true>(F.lds, pg8::GemmK{2048, 2048, 2048}, S, E);
        if (BOTH(7)) GRID_BAR();
    }

    if (IN(8)) {
        const float* Z = (const float*)(ws + WS_Z); const float* ST = (const float*)(ws + WS_ST); bf16_t* H1 = (bf16_t*)(ws + WS_XN); unsigned char* H1F8 = ws + WS_H1F8;
        const bf16_t* WR = (const bf16_t*)(ws + WS_WR); const float* lg_ = args.in[17]; const float* lb_ = args.in[18]; const float* rbias = args.in[20];
        int* IDX = (int*)(ws + WS_IDX); float* GWt = (float*)(ws + WS_GW); int* RK = (int*)(ws + WS_RK); int* TOK = (int*)(ws + WS_TOK);
        LAS float* lgs = (LAS float*)(F.lds + F.wave * 4352);
        const int r16 = F.lane & 15, kq = F.lane >> 4;
        const float my_bias = rbias[F.lane];
        for (int rb = gw; rb < MX / 16; rb += NGW) {
            const int row = rb * 16 + r16;
            float s = 0.f, q = 0.f;
#pragma unroll
            for (int i = 0; i < 4; ++i) { const f32x4 t4 = *(const f32x4*)(ST + (size_t)row * 64 + kq * 16 + i * 4); s += t4[0] + t4[2]; q += t4[1] + t4[3]; }
            s += __shfl_xor(s, 16); s += __shfl_xor(s, 32); q += __shfl_xor(q, 16); q += __shfl_xor(q, 32);
            const float mean = s * (1.f / DM), var = fmaxf(q * (1.f / DM) - mean * mean, 0.f), rstd = 1.f / sqrtf(var + LN_EPS);
            f32x4 acc[4];
#pragma unroll
            for (int nb = 0; nb < 4; ++nb) acc[nb] = (f32x4){0.f, 0.f, 0.f, 0.f};
#pragma unroll 2
            for (int ks = 0; ks < 64; ++ks) { const int k0 = ks * 32 + kq * 8;
                const f32x4 z0 = *(const f32x4*)(Z + (size_t)row * DM + k0), z1 = *(const f32x4*)(Z + (size_t)row * DM + k0 + 4);
                const f32x4 g0 = *(const f32x4*)(lg_ + k0), g1 = *(const f32x4*)(lg_ + k0 + 4), b0 = *(const f32x4*)(lb_ + k0), b1 = *(const f32x4*)(lb_ + k0 + 4);
                const f32x4 y0 = (z0 - mean) * rstd * g0 + b0, y1 = (z1 - mean) * rstd * g1 + b1;
                const u32x4 w = pg8::pack8(y0, y1);
                *(u32x4*)(H1 + (size_t)row * DM + k0) = w;
                *(u32x2*)(H1F8 + (size_t)row * DM + k0) = pg8::pack8_fp8(y0, y1);
                const bf16x8 af = __builtin_bit_cast(bf16x8, w);
#pragma unroll
                for (int nb = 0; nb < 4; ++nb) { const bf16x8 bfm = *(const bf16x8*)(WR + (size_t)(nb * 16 + r16) * DM + k0);
                    acc[nb] = __builtin_amdgcn_mfma_f32_16x16x32_bf16(af, bfm, acc[nb], 0, 0, 0); } }
#pragma unroll
            for (int nb = 0; nb < 4; ++nb)
#pragma unroll
                for (int rg = 0; rg < 4; ++rg) lgs[(kq * 4 + rg) * 65 + nb * 16 + r16] = acc[nb][rg];
            LDS_WAIT(); asm volatile("" ::: "memory");
            for (int r = 0; r < 16; ++r) {
                const int trow = rb * 16 + r;
                const float score = fast_sigmoid(lgs[r * 65 + F.lane]);
                const float sel = score + my_bias;
                float m1 = sel; m1 = fmaxf(m1, __shfl_xor(m1, 1)); m1 = fmaxf(m1, __shfl_xor(m1, 2)); m1 = fmaxf(m1, __shfl_xor(m1, 4));
                int i1 = (sel == m1) ? F.lane : 1000; i1 = min(i1, __shfl_xor(i1, 1)); i1 = min(i1, __shfl_xor(i1, 2)); i1 = min(i1, __shfl_xor(i1, 4));
                float m2 = (F.lane == i1) ? -__builtin_inff() : sel; m2 = fmaxf(m2, __shfl_xor(m2, 1)); m2 = fmaxf(m2, __shfl_xor(m2, 2)); m2 = fmaxf(m2, __shfl_xor(m2, 4));
                const float gs = m1 + m2; const int mygrp = F.lane >> 3;
                int gcount = 0;
#pragma unroll
                for (int j = 0; j < 8; ++j) { const float gj = __shfl(gs, 8 * j); gcount += (gj > gs || (gj == gs && j < mygrp)) ? 1 : 0; }
                const bool cand = gcount < 4;
                const float cs = cand ? sel : -__builtin_inff();
                int rank = 0;
#pragma unroll 8
                for (int j = 0; j < 64; ++j) { const float cj = __shfl(cs, j); rank += (cj > cs || (cj == cs && j < F.lane)) ? 1 : 0; }
                const bool chosen = cand && rank < TOPK;
                const float tot = wave_sum(chosen ? score : 0.f);
                if (chosen) { const float gate = score / tot * ROUTED_SCALE;
                    const unsigned pos = __hip_atomic_fetch_add(F.ctl + CW_CNT + 64 * F.lane, 1u, RLX_AGENT);
                    TOK[(size_t)F.lane * MX + pos] = trow;
                    IDX[(size_t)trow * 8 + rank] = F.lane; GWt[(size_t)trow * 8 + rank] = gate; RK[(size_t)trow * 8 + rank] = (int)pos; }
            }
            LDS_WAIT(); asm volatile("" ::: "memory");
        }
        if (BOTH(8)) GRID_BAR();
    }

    if (IN(9)) {
        moe_tables(F);
        const LAS int* tb = (const LAS int*)(F.lds + TB_OFF);
        pg8::MoeOrder S; S.tb = tb; S.TT = tb[64]; S.NCT = 4; S.nsh = 64 * 4; S.nwg = S.TT * 4 + S.nsh; S.G = F.G; S.c = bx; S.lda = DM; S.ldb = DM;
        S.Aexp = (const char*)(ws + WS_H1F8); S.tok = (const int*)(ws + WS_TOK); S.Bexp = (const char*)(ws + WS_WEGU); S.bstride = (size_t)1024 * 2048;
        S.Ash = (const char*)(ws + WS_H1F8); S.Bsh = (const char*)(ws + WS_WSGU); S.gather = true;
        pg8::EpiGU E{ws + WS_HID, ws + WS_HIDS};
        REPS(9) pg8::gemm_phase<pg8::EpiGU, pg8::MoeOrder, true, true>(F.lds, pg8::GemmK{DM, DM, DM}, S, E);
        if (BOTH(9)) GRID_BAR();
    }

    if (IN(10)) {
        moe_tables(F);
        const LAS int* tb = (const LAS int*)(F.lds + TB_OFF);
        pg8::MoeOrder S; S.tb = tb; S.TT = tb[64]; S.NCT = 8; S.nsh = 64 * 8; S.nwg = S.TT * 8 + S.nsh; S.G = F.G; S.c = bx; S.lda = EFF; S.ldb = EFF;
        S.Aexp = (const char*)(ws + WS_HID); S.tok = nullptr; S.Bexp = (const char*)(ws + WS_WED); S.bstride = (size_t)2048 * 512;
        S.Ash = (const char*)(ws + WS_HIDS); S.Bsh = (const char*)(ws + WS_WSD); S.gather = false;
        pg8::EpiDown E{ws + WS_C, ws + WS_CS};
        { const int sg = F.vcu & 3;
          if (0 && sg) { const unsigned long long t0 = __builtin_amdgcn_s_memrealtime(); while (__builtin_amdgcn_s_memrealtime() - t0 < (unsigned long long)(sg * 500)) __builtin_amdgcn_s_sleep(8); } }
        REPS(10) pg8::gemm_phase<pg8::EpiDown, pg8::MoeOrder, true, true>(F.lds, pg8::GemmK{EFF, EFF, EFF}, S, E);
        if (BOTH(10)) GRID_BAR();
    }

    if (IN(11)) {
        moe_tables(F);
        const LAS int* tb = (const LAS int*)(F.lds + TB_OFF);
        const bf16_t* H1 = (const bf16_t*)(ws + WS_XN); const unsigned char* CS = ws + WS_CS; const unsigned char* C = ws + WS_C;
        const int* IDX = (const int*)(ws + WS_IDX); const float* GWt = (const float*)(ws + WS_GW); const int* RK = (const int*)(ws + WS_RK);
        const float* lg_ = args.in[27]; const float* lb_ = args.in[28]; float* out = args.out;
        REPS(11)
        for (int row = gw; row < MX; row += NGW) {
            const i32x4 e0 = *(const i32x4*)(IDX + (size_t)row * 8), e1 = *(const i32x4*)(IDX + (size_t)row * 8 + 4);
            const i32x4 r0 = *(const i32x4*)(RK + (size_t)row * 8), r1 = *(const i32x4*)(RK + (size_t)row * 8 + 4);
            const f32x4 w0 = *(const f32x4*)(GWt + (size_t)row * 8), w1 = *(const f32x4*)(GWt + (size_t)row * 8 + 4);
            int slot[8]; float wk[8];
            slot[0] = tb[65 + e0[0]] + r0[0]; slot[1] = tb[65 + e0[1]] + r0[1]; slot[2] = tb[65 + e0[2]] + r0[2]; slot[3] = tb[65 + e0[3]] + r0[3];
            slot[4] = tb[65 + e1[0]] + r1[0]; slot[5] = tb[65 + e1[1]] + r1[1]; slot[6] = tb[65 + e1[2]] + r1[2]; slot[7] = tb[65 + e1[3]] + r1[3];
            constexpr float CI = 1.f / C8SCALE;
            wk[0] = w0[0] * CI; wk[1] = w0[1] * CI; wk[2] = w0[2] * CI; wk[3] = w0[3] * CI; wk[4] = w1[0] * CI; wk[5] = w1[1] * CI; wk[6] = w1[2] * CI; wk[7] = w1[3] * CI;
            float acc[4][8];
#pragma unroll
            for (int j = 0; j < 4; ++j) { int lo_ = (j * 64 + F.lane) * 8; asm volatile("" : "+v"(lo_)); const size_t off = (size_t)row * DM + (size_t)lo_;
                const u32x4 hw = *(const u32x4*)(H1 + off); const u32x2 sw = *(const u32x2*)(CS + off);
                u32x2 cw[8];
#pragma unroll
                for (int k = 0; k < 8; ++k) cw[k] = *(const u32x2*)(C + (size_t)slot[k] * DM + (size_t)lo_);
                { const f32x2 s0 = __builtin_amdgcn_cvt_pk_f32_fp8((int)sw.x, false), s1 = __builtin_amdgcn_cvt_pk_f32_fp8((int)sw.x, true), s2 = __builtin_amdgcn_cvt_pk_f32_fp8((int)sw.y, false), s3 = __builtin_amdgcn_cvt_pk_f32_fp8((int)sw.y, true);
                  acc[j][0] = ALPHA * bf_lo(hw.x) + CI * s0[0]; acc[j][1] = ALPHA * bf_hi(hw.x) + CI * s0[1]; acc[j][2] = ALPHA * bf_lo(hw.y) + CI * s1[0]; acc[j][3] = ALPHA * bf_hi(hw.y) + CI * s1[1];
                  acc[j][4] = ALPHA * bf_lo(hw.z) + CI * s2[0]; acc[j][5] = ALPHA * bf_hi(hw.z) + CI * s2[1]; acc[j][6] = ALPHA * bf_lo(hw.w) + CI * s3[0]; acc[j][7] = ALPHA * bf_hi(hw.w) + CI * s3[1]; }
#pragma unroll
                for (int k = 0; k < 8; ++k) { const f32x2 c0 = __builtin_amdgcn_cvt_pk_f32_fp8((int)cw[k].x, false), c1 = __builtin_amdgcn_cvt_pk_f32_fp8((int)cw[k].x, true), c2 = __builtin_amdgcn_cvt_pk_f32_fp8((int)cw[k].y, false), c3 = __builtin_amdgcn_cvt_pk_f32_fp8((int)cw[k].y, true);
                    acc[j][0] += wk[k] * c0[0]; acc[j][1] += wk[k] * c0[1]; acc[j][2] += wk[k] * c1[0]; acc[j][3] += wk[k] * c1[1];
                    acc[j][4] += wk[k] * c2[0]; acc[j][5] += wk[k] * c2[1]; acc[j][6] += wk[k] * c3[0]; acc[j][7] += wk[k] * c3[1]; }
                asm volatile("" ::: "memory"); }
            float s = 0.f;
#pragma unroll
            for (int j = 0; j < 4; ++j)
#pragma unroll
                for (int e = 0; e < 8; ++e) s += acc[j][e];
            const float mean = wave_sum(s) * (1.f / DM); float s2 = 0.f;
#pragma unroll
            for (int j = 0; j < 4; ++j)
#pragma unroll
                for (int e = 0; e < 8; ++e) { acc[j][e] -= mean; s2 += acc[j][e] * acc[j][e]; }
            const float rstd = 1.f / sqrtf(wave_sum(s2) * (1.f / DM) + LN_EPS);
#pragma unroll
            for (int j = 0; j < 4; ++j) { int c0 = (j * 64 + F.lane) * 8; asm volatile("" : "+v"(c0));
                const f32x4 g0 = *(const f32x4*)(lg_ + c0), g1 = *(const f32x4*)(lg_ + c0 + 4), b0 = *(const f32x4*)(lb_ + c0), b1 = *(const f32x4*)(lb_ + c0 + 4);
                f32x4 o0, o1;
#pragma unroll
                for (int e = 0; e < 4; ++e) { o0[e] = acc[j][e] * rstd * g0[e] + b0[e]; o1[e] = acc[j][4 + e] * rstd * g1[e] + b1[e]; }
                *(f32x4*)(out + (size_t)row * DM + c0) = o0; *(f32x4*)(out + (size_t)row * DM + c0 + 4) = o1; }
        }
    }
#undef IN
#undef BOTH
#undef GRID_BAR
}

#ifndef PH_MASK
#define PH_MASK 0xFFFu
#endif
typedef void (*kern_t)(Args);
template <unsigned MASK> static bool prep_kernel(kern_t& k) {
    k = hymba_fwd<MASK>;
    if (hipFuncSetAttribute((const void*)hymba_fwd<MASK>, hipFuncAttributeMaxDynamicSharedMemorySize, LDS_BYTES) != hipSuccess) { fprintf(stderr, "kernel_launch: hipFuncSetAttribute failed (mask %x)\n", MASK); return false; }
    return true;
}
extern "C" void kernel_launch(void* const* d_in, const int* in_sizes, int n_in, void* d_out, int out_size, void* d_ws, size_t ws_size, hipStream_t stream) {
    static int grid = 0; static kern_t kerns[N_PHASES];
    if (grid == 0) {
        if (n_in != 29 || in_sizes[0] != MX * DM || out_size != MX * DM || ws_size < WS_END) {
            fprintf(stderr, "kernel_launch: unexpected shapes (n_in %d, in0 %d, out %d, ws %zu; need ws >= %zu); nothing launched\n", n_in, n_in > 0 ? in_sizes[0] : -1, out_size, ws_size, (size_t)WS_END); grid = -1; return; }
        int dev = 0, cus = 0;
        if (hipGetDevice(&dev) != hipSuccess || hipDeviceGetAttribute(&cus, hipDeviceAttributeMultiprocessorCount, dev) != hipSuccess) { fprintf(stderr, "kernel_launch: device query failed\n"); grid = -1; return; }
        bool ok = true;
        if constexpr (N_LAUNCHES == 1) ok = prep_kernel<PH_MASK>(kerns[0]);
        else { ok = ok && prep_kernel<0x001u>(kerns[0]) && prep_kernel<0x002u>(kerns[1]) && prep_kernel<0x004u>(kerns[2]) && prep_kernel<0x008u>(kerns[3]) && prep_kernel<0x010u>(kerns[4]) && prep_kernel<0x020u>(kerns[5])
                       && prep_kernel<0x040u>(kerns[6]) && prep_kernel<0x080u>(kerns[7]) && prep_kernel<0x100u>(kerns[8]) && prep_kernel<0x200u>(kerns[9]) && prep_kernel<0x400u>(kerns[10]) && prep_kernel<0x800u>(kerns[11]); }
        if (!ok) { grid = -1; return; }
        (void)hipGetLastError();
        grid = cus;
    }
    if (grid < 0) return;
    if (hipMemsetAsync((char*)d_ws + WS_CTL, 0, CTL_ZERO_BYTES, stream) != hipSuccess) { fprintf(stderr, "kernel_launch: memset failed\n"); return; }
    Args a{};
    for (int i = 0; i < 29; ++i) a.in[i] = (const float*)d_in[i];
    a.out = (float*)d_out; a.ws = (unsigned char*)d_ws;
    for (int li = 0; li < N_LAUNCHES; ++li) {
        if (N_LAUNCHES != 1 && !((PH_MASK >> li) & 1u)) continue;
        a.ph_lo = (N_LAUNCHES == 1) ? 0 : li; a.ph_hi = (N_LAUNCHES == 1) ? N_PHASES : li + 1;
        hipLaunchKernelGGL(kerns[li], dim3(grid), dim3(NWAVES * 64), LDS_BYTES, stream, a);
        const hipError_t le = hipPeekAtLastError();
        if (le != hipSuccess) { fprintf(stderr, "kernel_launch: launch %d failed: %s\n", li, hipGetErrorName(le)); break; }
    }
}
```

```cpp
#include <hip/hip_runtime.h>
#include <cstdio>
#include <cstdint>

#ifndef MK_N_LAUNCHES
#define MK_N_LAUNCHES 1
#endif
#ifndef REP_PH
#define REP_PH -1
#endif

#define LAS __attribute__((address_space(3)))
#define GAS __attribute__((address_space(1)))
typedef unsigned short bf16_t;
typedef short bf16x8 __attribute__((ext_vector_type(8)));
typedef short s16x4 __attribute__((ext_vector_type(4)));
typedef float f32x2 __attribute__((ext_vector_type(2)));
typedef float f32x4 __attribute__((ext_vector_type(4)));
typedef float f32x16 __attribute__((ext_vector_type(16)));
typedef unsigned u32x2 __attribute__((ext_vector_type(2)));
typedef unsigned u32x4 __attribute__((ext_vector_type(4)));
typedef int i32x4 __attribute__((ext_vector_type(4)));
typedef int i32x8 __attribute__((ext_vector_type(8)));

constexpr int BATCH = 2, SEQ = 8192, DM = 2048, NMETA = 16;
constexpr int MX = BATCH * SEQ;
constexpr int MIN_ROWS = MX + 256;
constexpr int NHEAD = 8, HD = 128, NGRP = 64, NST = 64;
constexpr int KVR = 64 + SEQ;
constexpr int NCHK = KVR / 32;
constexpr int UGK = 640;
constexpr int NEXP = 64, TOPK = 8, EFF = 512;
constexpr float LN_EPS = 1e-5f;
constexpr float ALPHA = 1.189207115002721f;
constexpr float ROUTED_SCALE = 2.5f;
constexpr float LOG2E = 1.4426950408889634f;
constexpr float QSCALE = 0.08838834764831845f * 1.4426950408889634f;
constexpr float W8SCALE = 256.f;
constexpr float H8SCALE = 8.f;
constexpr float C8SCALE = 16.f;

constexpr size_t MiB = 1u << 20;
constexpr size_t WS_CTL = 0, CTL_ZERO_BYTES = 1 * MiB;
constexpr size_t WS_LOGF = 1 * MiB;
constexpr size_t WS_CUM = 2 * MiB;
constexpr size_t WS_IDX = 3 * MiB;
constexpr size_t WS_GW = 3 * MiB + 512 * 1024;
constexpr size_t WS_RK = 4 * MiB;
constexpr size_t WS_WR = 4 * MiB + 512 * 1024;
constexpr size_t WS_TOK = 5 * MiB;
constexpr size_t WS_ST = 9 * MiB;
constexpr size_t WS_XN = 16 * MiB;
constexpr size_t WS_WED = 81 * MiB;
constexpr size_t WS_WSD = 209 * MiB;
constexpr size_t WS_WSGU = 211 * MiB;
constexpr size_t WS_WGLU = 215 * MiB;
constexpr size_t WS_WOUT = 217 * MiB;
constexpr size_t WS_WIN = 225 * MiB;
constexpr size_t WS_HID = 241 * MiB;
constexpr size_t WS_H1F8 = 310 * MiB;
constexpr size_t WS_YC = 241 * MiB;
constexpr size_t WS_YB = 305 * MiB;
constexpr size_t WS_Q = 337 * MiB;
constexpr size_t WS_HIDS = 370 * MiB;
constexpr size_t WS_CS = 386 * MiB;
constexpr size_t WS_C = 450 * MiB;
constexpr size_t WS_WEGU = 450 * MiB;
constexpr size_t WS_Z = 706 * MiB;
constexpr size_t WS_K = 834 * MiB;
constexpr size_t WS_V = 867 * MiB;
constexpr size_t WS_UG = 900 * MiB;
constexpr size_t WS_OPY = 941 * MiB;
constexpr size_t WS_OPE = 981 * MiB;
constexpr size_t WS_E = 997 * MiB;
constexpr size_t WS_END = 1013 * MiB;
static_assert(WS_HID + (size_t)(131072 + 256) * 512 * 2 <= WS_HIDS && WS_Q + (size_t)MX * 1024 * 2 <= WS_HIDS, "map");
static_assert(WS_K + (size_t)2 * KVR * 1024 * 2 <= WS_V && WS_V + (size_t)2 * KVR * 1024 * 2 <= WS_UG, "map");
static_assert(WS_UG + (size_t)64 * 2 * NCHK * UGK * 2 <= WS_OPY && WS_C + (size_t)131072 * 2048 * 2 <= WS_END, "map");
static_assert(WS_XN + (size_t)MIN_ROWS * 2048 * 2 <= WS_WED, "map");
constexpr int CW_TMO = 0, CW_CODE = 1;
constexpr int CW_CNT = 1024;
constexpr int CW_KMAX = 5120;
constexpr int CW_QMAX = 5184;
constexpr int CW_BAR = 8192;
constexpr float T_SKIP = 40.f;

constexpr int RING_BYTES = 139264;
constexpr int LDSCTL_OFF = RING_BYTES;
constexpr int MISC_OFF = LDSCTL_OFF + 64;
constexpr int TB_OFF = LDSCTL_OFF + 1024;
constexpr int LDS_BYTES = 147456;

__device__ __forceinline__ unsigned cvt_pk_bf16(float lo, float hi) { unsigned r; asm volatile("v_cvt_pk_bf16_f32 %0, %1, %2" : "=v"(r) : "v"(lo), "v"(hi)); return r; }
__device__ __forceinline__ float bf_lo(unsigned w) { return __uint_as_float(w << 16); }
__device__ __forceinline__ float bf_hi(unsigned w) { return __uint_as_float(w & 0xffff0000u); }
__device__ __forceinline__ float fast_sigmoid(float x) { return __builtin_amdgcn_rcpf(1.f + __builtin_amdgcn_exp2f(-x * LOG2E)); }
__device__ __forceinline__ float wave_sum(float v) {
#pragma unroll
    for (int o = 1; o < 64; o <<= 1) v += __shfl_xor(v, o);
    return v;
}
#define LDS_WAIT() asm volatile("s_waitcnt lgkmcnt(0)" ::: "memory")
#define VM_WAIT() asm volatile("s_waitcnt vmcnt(0)" ::: "memory")

namespace pg8 {
constexpr int BM = 256, BK = 64, HALF = 128, HTB = HALF * BK * 2, STAGE_BYTES = 8 * HTB, NXCD = 8, WGM = 8;
__host__ __device__ __forceinline__ int lds_byte(int r, int c) { const int st = (r >> 4) * 2 + (c >> 5), rr = r & 15, cc = c & 31, ob = rr * 64 + cc * 2; return st * 1024 + (ob ^ (((ob >> 9) & 1) << 5)); }
__host__ __device__ __forceinline__ void stage_rc(int b, int& R, int& C) { const int st = b / 1024, sb = b % 1024, swz = sb ^ (((sb >> 9) & 1) << 5); R = (st >> 1) * 16 + swz / 64; C = (st & 1) * 32 + (swz % 64) / 2; }
__host__ __device__ __forceinline__ int perm32(int rho) { const int n = rho >> 4, i = rho & 15; return 8 * (i >> 2) + 4 * n + (i & 3); }

struct Unit { const char* A; const char* B; const int* rows; int r0, c0, valid, aux; };
struct GemmK { int K, lda, ldb; };

template <class Epi, class Sched, bool ALIGN_EPI, bool F8 = false>
__device__ __forceinline__ void gemm_phase(LAS unsigned char* lds, const GemmK g, const Sched& S, const Epi& E) {
    const int tid = threadIdx.x, wid = __builtin_amdgcn_readfirstlane(tid >> 6), lane = tid & 63, wr = wid >> 2, wc = wid & 3, fr = lane & 15, fq = lane >> 4;
    constexpr unsigned ES = F8 ? 1u : 2u;
    const int K = g.K, nt = (K * (int)ES) / (BK * 2);
    unsigned voffB0[2], voffB1[2];
#pragma unroll
    for (int i = 0; i < 2; ++i) { int R, C; stage_rc(tid * 16 + i * 8192, R, C);
        int Rb0, Rb1;
        if constexpr ((int)Epi::PERM == 2) { const int wc_ = R >> 5, rho = R & 31, n_ = rho >> 4, ii = rho & 15; Rb0 = 64 * wc_ + 16 * (ii >> 2) + 4 * n_ + (ii & 3); Rb1 = Rb0 + 8; }
        else { Rb0 = (int)Epi::PERM ? ((R & ~31) + perm32(R & 31)) : R; Rb1 = Rb0 + HALF; }
        voffB0[i] = (unsigned)(Rb0 * g.ldb) * ES + (unsigned)C * 2u; voffB1[i] = (unsigned)(Rb1 * g.ldb) * ES + (unsigned)C * 2u; }
    const size_t kstep = (size_t)(BK * 2);
    const unsigned ldsw = (unsigned)wid * 1024u;
    const int aoff = lds_byte(wr * 64 + fr, fq * (F8 ? 16 : 8)), boff = lds_byte(wc * 32 + fr, fq * (F8 ? 16 : 8));
    constexpr int KSTR = F8 ? 16 : 1024;
    int f8scale = 0x7f7f7f7f; asm volatile("" : "+v"(f8scale));
#define PG8_SA(b, h) (((b) * 2 + (h)) * HTB)
#define PG8_SB(b, h) ((4 + (b) * 2 + (h)) * HTB)
#define PG8_STAGE(bufoff, gbase, voff) do { _Pragma("unroll") for (int _i = 0; _i < 2; ++_i) \
        __builtin_amdgcn_global_load_lds((const unsigned*)((const char*)(gbase) + (voff)[_i]), (LAS unsigned*)(lds + (bufoff) + ldsw + _i * 8192), 16, 0, 0); } while (0)
#define PG8_LDA(dst, b, h) do { _Pragma("unroll") for (int m = 0; m < 4; ++m) _Pragma("unroll") for (int k = 0; k < 2; ++k) dst[m][k] = *(const LAS bf16x8*)(lds + PG8_SA(b, h) + aoff + m * 2048 + k * KSTR); } while (0)
#define PG8_LDB(dst, b, h) do { _Pragma("unroll") for (int n = 0; n < 2; ++n) _Pragma("unroll") for (int k = 0; k < 2; ++k) dst[n][k] = *(const LAS bf16x8*)(lds + PG8_SB(b, h) + boff + n * 2048 + k * KSTR); } while (0)
#define PG8_CAT8(x0, x1) __builtin_shufflevector(__builtin_bit_cast(i32x4, x0), __builtin_bit_cast(i32x4, x1), 0, 1, 2, 3, 4, 5, 6, 7)
#define PG8_MMA(ai, bj, At, Bt) do { __builtin_amdgcn_s_setprio(1); if constexpr (F8) { _Pragma("unroll") for (int m = 0; m < 4; ++m) _Pragma("unroll") for (int n = 0; n < 2; ++n) \
        asm volatile("v_mfma_scale_f32_16x16x128_f8f6f4 %0, %1, %2, %0, %3, %3 op_sel_hi:[0,0,0]" : "+v"(acc[ai][bj][m][n]) : "v"(PG8_CAT8(Bt[n][0], Bt[n][1])), "v"(PG8_CAT8(At[m][0], At[m][1])), "v"(f8scale)); } \
      else { _Pragma("unroll") for (int m = 0; m < 4; ++m) _Pragma("unroll") for (int n = 0; n < 2; ++n) _Pragma("unroll") for (int k = 0; k < 2; ++k) \
        acc[ai][bj][m][n] = __builtin_amdgcn_mfma_f32_16x16x32_bf16(Bt[n][k], At[m][k], acc[ai][bj][m][n], 0, 0, 0); } __builtin_amdgcn_s_setprio(0); } while (0)
#define PG8_WAIT_V(n) asm volatile("s_waitcnt vmcnt(" #n ")" ::: "memory")
#define PG8_WAIT_L(n) asm volatile("s_waitcnt lgkmcnt(" #n ")" ::: "memory")
#define PG8_BAR __builtin_amdgcn_s_barrier()
#define PG8_SCHED __builtin_amdgcn_sched_barrier(0)
#define PG8_VOFFA(u, v0, v1) do { int t_ = tid; asm volatile("" : "+v"(t_)); _Pragma("unroll") for (int _i = 0; _i < 2; ++_i) { int R_, C_; stage_rc(t_ * 16 + _i * 8192, R_, C_);     \
        v0[_i] = S.a_off(u, R_) + (unsigned)C_ * 2u; v1[_i] = S.a_off(u, R_ + HALF) + (unsigned)C_ * 2u; } } while (0)
    Unit cur, nxt; int ui = 0;
    if (!S.next(0, cur)) return;
    f32x4 acc[2][2][4][2];
#pragma unroll
    for (int a = 0; a < 2; ++a)
#pragma unroll
        for (int b = 0; b < 2; ++b)
#pragma unroll
            for (int m = 0; m < 4; ++m)
#pragma unroll
                for (int n = 0; n < 2; ++n) acc[a][b][m][n] = (f32x4){0.f, 0.f, 0.f, 0.f};
    bf16x8 At[4][2], B0[2][2], B1[2][2];
    const char* cA = cur.A; const char* cB = cur.B;
    unsigned vA0[2], vA1[2], nA0[2], nA1[2];
    PG8_VOFFA(cur, vA0, vA1);
    PG8_STAGE(PG8_SB(0, 0), cB, voffB0); PG8_STAGE(PG8_SB(0, 1), cB, voffB1); PG8_STAGE(PG8_SA(0, 0), cA, vA0); PG8_STAGE(PG8_SA(0, 1), cA, vA1);
    if (wr == 1) PG8_BAR;
    PG8_WAIT_V(2); PG8_BAR;
    PG8_STAGE(PG8_SB(1, 0), cB + kstep, voffB0); PG8_STAGE(PG8_SA(1, 0), cA + kstep, vA0); PG8_STAGE(PG8_SB(1, 1), cB + kstep, voffB1);
    PG8_WAIT_V(6); PG8_BAR;
    for (;;) {
        const bool has_next = S.next(ui + 1, nxt);
        const char* nA = has_next ? nxt.A : cA; const char* nB = has_next ? nxt.B : cB;
        if (has_next) { PG8_VOFFA(nxt, nA0, nA1); } else { nA0[0] = vA0[0]; nA0[1] = vA0[1]; nA1[0] = vA1[0]; nA1[1] = vA1[1]; }
#pragma unroll 1
        for (int t = 0; t < nt; t += 2) {
            const bool last = (t == nt - 2);
            const char* a1 = cA + (size_t)(t + 1) * kstep;
            const char* a2 = last ? nA : cA + (size_t)(t + 2) * kstep; const char* b2 = last ? nB : cB + (size_t)(t + 2) * kstep;
            const char* a3 = a2 + kstep; const char* b3 = b2 + kstep;
            unsigned w0[2], w1[2];
            w0[0] = last ? nA0[0] : vA0[0]; w0[1] = last ? nA0[1] : vA0[1]; w1[0] = last ? nA1[0] : vA1[0]; w1[1] = last ? nA1[1] : vA1[1];
            PG8_LDB(B0, 0, 0); PG8_LDB(B1, 0, 1); PG8_SCHED; PG8_LDA(At, 0, 0); PG8_STAGE(PG8_SA(1, 1), a1, vA1);
            PG8_WAIT_V(8); PG8_WAIT_L(0); PG8_BAR; PG8_MMA(0, 0, At, B0); PG8_MMA(0, 1, At, B1); PG8_BAR; PG8_SCHED;
            PG8_LDA(At, 0, 1); PG8_STAGE(PG8_SB(0, 0), b2, voffB0); PG8_STAGE(PG8_SB(0, 1), b2, voffB1); PG8_STAGE(PG8_SA(0, 0), a2, w0);
            PG8_WAIT_V(8); PG8_WAIT_L(0); PG8_BAR; PG8_MMA(1, 0, At, B0); PG8_MMA(1, 1, At, B1); PG8_BAR; PG8_SCHED;
            PG8_LDB(B0, 1, 0); PG8_LDB(B1, 1, 1); PG8_SCHED; PG8_LDA(At, 1, 0); PG8_STAGE(PG8_SA(0, 1), a2, w1);
            PG8_WAIT_V(8); PG8_WAIT_L(0); PG8_BAR; PG8_MMA(0, 0, At, B0); PG8_MMA(0, 1, At, B1); PG8_BAR; PG8_SCHED;
            PG8_LDA(At, 1, 1); PG8_STAGE(PG8_SB(1, 0), b3, voffB0); PG8_STAGE(PG8_SB(1, 1), b3, voffB1); PG8_STAGE(PG8_SA(1, 0), a3, w0);
            PG8_WAIT_V(8); PG8_WAIT_L(0); PG8_BAR; PG8_MMA(1, 0, At, B0); PG8_MMA(1, 1, At, B1); PG8_BAR; PG8_SCHED;
        }
        if constexpr (ALIGN_EPI) { if (wr == 0) PG8_BAR; }
        if constexpr (F8) asm volatile("s_nop 15\n\ts_nop 7" ::: "memory");
        E(acc, cur, wr, wc, fr, fq);
        if (!has_next) break;
#pragma unroll
        for (int a = 0; a < 2; ++a)
#pragma unroll
            for (int b = 0; b < 2; ++b)
#pragma unroll
                for (int m = 0; m < 4; ++m)
#pragma unroll
                    for (int n = 0; n < 2; ++n) acc[a][b][m][n] = (f32x4){0.f, 0.f, 0.f, 0.f};
        cur = nxt; cA = nA; cB = nB; ++ui;
        vA0[0] = nA0[0]; vA0[1] = nA0[1]; vA1[0] = nA1[0]; vA1[1] = nA1[1];
        if constexpr (ALIGN_EPI) { if (wr == 1) PG8_BAR; }
    }
    PG8_WAIT_V(0);
    if constexpr (!ALIGN_EPI) { if (wr == 0) PG8_BAR; }
    PG8_BAR;
#undef PG8_SA
#undef PG8_SB
#undef PG8_STAGE
#undef PG8_LDA
#undef PG8_LDB
#undef PG8_MMA
#undef PG8_CAT8
#undef PG8_WAIT_V
#undef PG8_WAIT_L
#undef PG8_BAR
#undef PG8_SCHED
#undef PG8_VOFFA
}

__device__ __forceinline__ int xcd_remap(int L, int nwg) { const int q = nwg / NXCD, r = nwg % NXCD, xcd = L % NXCD, off = L / NXCD; return (xcd < r ? xcd * (q + 1) : r * (q + 1) + (xcd - r) * q) + off; }

struct DenseOrder {
    const char* A; const char* B; int lda, ldb, nM, nN, nwg, G, c;
    __device__ __forceinline__ void init(const void* A_, const void* B_, int lda_, int ldb_, int M, int N, int G_, int c_) { A = (const char*)A_; B = (const char*)B_; lda = lda_ * 2; ldb = ldb_ * 2; nM = M / BM; nN = N / BM; nwg = nM * nN; G = G_; c = c_; }
    __device__ __forceinline__ bool next(int i, Unit& u) const {
        const long L = (long)i * G + c; if (L >= nwg) return false;
        const int wgid = xcd_remap((int)L, nwg);
        const int nig = WGM * nN, gid = wgid / nig, fm = gid * WGM, gsz = (nM - fm) < WGM ? (nM - fm) : WGM;
        const int pm = fm + ((wgid % nig) % gsz), pn = (wgid % nig) / gsz;
        u.A = A + (size_t)pm * BM * lda; u.B = B + (size_t)pn * BM * ldb; u.rows = nullptr; u.r0 = pm * BM; u.c0 = pn; u.valid = BM; u.aux = 0; return true;
    }
    __device__ __forceinline__ unsigned a_off(const Unit&, int R) const { return (unsigned)R * (unsigned)lda; }
};
struct EOrder {
    const char* UG; const char* OPE; int G, c;
    __device__ __forceinline__ bool next(int i, Unit& u) const {
        const int L = i * G + c; if (L >= 128) return false;
        const int g = L >> 1, b = L & 1;
        u.A = UG + ((size_t)((g * 2 + b) * NCHK + 1)) * UGK * 2; u.B = OPE + (size_t)g * 256 * 512 * 2; u.rows = nullptr; u.r0 = (g * 2 + b) * 256; u.c0 = 0; u.valid = BM; u.aux = g; return true;
    }
    __device__ __forceinline__ unsigned a_off(const Unit&, int R) const { return (unsigned)R * (unsigned)(UGK * 2); }
};
struct YOrder {
    const char* UG; const char* OPY; int G, c;
    __device__ __forceinline__ bool next(int i, Unit& u) const {
        const int L = i * G + c; if (L >= 256) return false;
        const int g = L >> 2, b = (L >> 1) & 1, pn = L & 1;
        u.A = UG + ((size_t)((g * 2 + b) * NCHK + 2)) * UGK * 2; u.B = OPY + ((size_t)g * 512 + pn * 256) * UGK * 2; u.rows = nullptr; u.r0 = b; u.c0 = pn; u.valid = BM; u.aux = g; return true;
    }
    __device__ __forceinline__ unsigned a_off(const Unit&, int R) const { return (unsigned)R * (unsigned)(UGK * 2); }
};
struct OneUnit {
    Unit u; unsigned rowbytes;
    __device__ __forceinline__ bool next(int i, Unit& uu) const { if (i > 0) return false; uu = u; return true; }
    __device__ __forceinline__ unsigned a_off(const Unit&, int R) const { return (unsigned)R * rowbytes; }
};
struct MoeOrder {
    const LAS int* tb;
    int TT, NCT, nsh, nwg, G, c, lda, ldb;
    const char* Aexp; const int* tok; const char* Bexp; size_t bstride; const char* Ash; const char* Bsh; bool gather;
    __device__ __forceinline__ bool next(int i, Unit& u) const {
        const long L = (long)i * G + c; if (L >= nwg) return false;
        const int wgid = xcd_remap((int)L, nwg);
        if (wgid < TT * NCT) {
            const int gr = wgid / NCT, ct = wgid - gr * NCT;
            int lo = 0, hi = NEXP;
            while (hi - lo > 1) { const int mid = (lo + hi) >> 1; if (tb[mid] <= gr) lo = mid; else hi = mid; }
            const int e = lo, rt = gr - tb[e], cn = tb[130 + e], cp = tb[65 + e];
            int valid = cn - rt * BM; valid = valid > BM ? BM : valid;
            if (gather) { u.A = Aexp; u.rows = tok + (size_t)e * MX + rt * BM; }
            else { u.A = Aexp + (size_t)(cp + rt * BM) * lda; u.rows = nullptr; }
            u.B = Bexp + (size_t)e * bstride + (size_t)ct * BM * ldb; u.r0 = cp + rt * BM; u.c0 = ct; u.valid = valid; u.aux = 0;
        } else {
            const int s = wgid - TT * NCT, pm = s / NCT, ct = s - pm * NCT;
            u.A = Ash + (size_t)pm * BM * lda; u.rows = nullptr; u.B = Bsh + (size_t)ct * BM * ldb; u.r0 = pm * BM; u.c0 = ct; u.valid = BM; u.aux = 1;
        }
        return true;
    }
    __device__ __forceinline__ unsigned a_off(const Unit& u, int R) const {
        if (u.rows) { const int i = R < u.valid ? R : u.valid - 1; return (unsigned)u.rows[i] * (unsigned)lda; }
        return (unsigned)R * (unsigned)lda;
    }
};

#define EPI_LOOP_ROWS for (int ai = 0; ai < 2; ++ai) _Pragma("unroll") for (int m = 0; m < 4; ++m)
__device__ __forceinline__ u32x4 pack8(f32x4 v0, f32x4 v1) { u32x4 w; w.x = cvt_pk_bf16(v0[0], v0[1]); w.y = cvt_pk_bf16(v0[2], v0[3]); w.z = cvt_pk_bf16(v1[0], v1[1]); w.w = cvt_pk_bf16(v1[2], v1[3]); return w; }

struct EpiInProj {
    static constexpr int PERM = 1;
    bf16_t* UG; bf16_t* Q; bf16_t* Kb; bf16_t* Vb;
    __device__ __forceinline__ void operator()(const f32x4 (&acc)[2][2][4][2], const Unit& u, int wr, int wc, int fr, int fq) const {
        const int pn = u.c0, sect = pn >> 2;
        const float sc = sect == 1 ? QSCALE : 1.f;
#pragma unroll
        EPI_LOOP_ROWS { const int rt = ai * HALF + wr * 64 + m * 16 + fr; const int row = u.r0 + rt, b = row >> 13, s = row & (SEQ - 1);
#pragma unroll
            for (int bj = 0; bj < 2; ++bj) {
                const int col = (pn & 3) * 256 + bj * HALF + wc * 32 + 8 * fq;
                const u32x4 w = pack8(acc[ai][bj][m][0] * sc, acc[ai][bj][m][1] * sc);
                if (sect == 0) { const int gch = col >> 4, half = (col >> 3) & 1;
                    *(u32x4*)(UG + ((size_t)((gch * 2 + b) * NCHK + 2 + (s >> 5)) * UGK + (s & 31) * 16 + 8 * half)) = w; }
                else if (sect == 1) *(u32x4*)(Q + (size_t)row * 1024 + col) = w;
                else { bf16_t* dst = sect == 2 ? Kb : Vb; *(u32x4*)(dst + ((size_t)b * KVR + 64 + s) * 1024 + col) = w; }
            }
        }
    }
};
struct EpiE {
    static constexpr int PERM = 0;
    float* E;
    __device__ __forceinline__ void operator()(const f32x4 (&acc)[2][2][4][2], const Unit& u, int wr, int wc, int fr, int fq) const {
#pragma unroll
        EPI_LOOP_ROWS { const int rt = ai * HALF + wr * 64 + m * 16 + fr;
#pragma unroll
            for (int n = 0; n < 2; ++n) *(f32x4*)(E + (size_t)(u.r0 + rt) * 128 + wc * 32 + 16 * n + 4 * fq) = acc[ai][0][m][n]; }
    }
};
__device__ __forceinline__ float gelu_tanh(float v) { const float t = 1.5957691216057308f * (v + 0.044715f * v * v * v); return v * fast_sigmoid(t); }
struct EpiY {
    static constexpr int PERM = 1;
    bf16_t* YB;
    __device__ __forceinline__ void operator()(const f32x4 (&acc)[2][2][4][2], const Unit& u, int wr, int wc, int fr, int fq) const {
        const int b = u.r0, g = u.aux;
#pragma unroll
        EPI_LOOP_ROWS { const int rt = ai * HALF + wr * 64 + m * 16 + fr;
#pragma unroll
            for (int bj = 0; bj < 2; ++bj) { const int col = u.c0 * 256 + bj * HALF + wc * 32 + 8 * fq, t = col >> 4, h0 = col & 15;
                f32x4 v0 = acc[ai][bj][m][0], v1 = acc[ai][bj][m][1];
#pragma unroll
                for (int e = 0; e < 4; ++e) { v0[e] = gelu_tanh(v0[e]); v1[e] = gelu_tanh(v1[e]); }
                *(u32x4*)(YB + ((size_t)b * SEQ + 32 * rt + t) * 1024 + g * 16 + h0) = pack8(v0, v1); }
            asm volatile("" ::: "memory"); }
    }
};
struct EpiGlu {
    static constexpr int PERM = 1;
    const bf16_t* YB; const float* bias; bf16_t* YC;
    __device__ __forceinline__ void operator()(const f32x4 (&acc)[2][2][4][2], const Unit& u, int wr, int wc, int fr, int fq) const {
#pragma unroll
        for (int bj = 0; bj < 2; ++bj) { const int col = u.c0 * 256 + bj * HALF + wc * 32 + 8 * fq;
            const f32x4 b0 = *(const f32x4*)(bias + col), b1 = *(const f32x4*)(bias + col + 4);
#pragma unroll
            EPI_LOOP_ROWS { const int row = u.r0 + ai * HALF + wr * 64 + m * 16 + fr;
                const u32x4 yw = *(const u32x4*)(YB + (size_t)row * 1024 + col);
                f32x4 v0 = acc[ai][bj][m][0] + b0, v1 = acc[ai][bj][m][1] + b1;
                v0[0] = bf_lo(yw.x) * fast_sigmoid(v0[0]); v0[1] = bf_hi(yw.x) * fast_sigmoid(v0[1]); v0[2] = bf_lo(yw.y) * fast_sigmoid(v0[2]); v0[3] = bf_hi(yw.y) * fast_sigmoid(v0[3]);
                v1[0] = bf_lo(yw.z) * fast_sigmoid(v1[0]); v1[1] = bf_hi(yw.z) * fast_sigmoid(v1[1]); v1[2] = bf_lo(yw.w) * fast_sigmoid(v1[2]); v1[3] = bf_hi(yw.w) * fast_sigmoid(v1[3]);
                *(u32x4*)(YC + (size_t)row * 2048 + col) = pack8(v0, v1); } }
    }
};
struct EpiOut {
    static constexpr int PERM = 0;
    const bf16_t* XN; float* Z; float* ST;
    __device__ __forceinline__ void operator()(const f32x4 (&acc)[2][2][4][2], const Unit& u, int wr, int wc, int fr, int fq) const {
#pragma unroll
        EPI_LOOP_ROWS { const int row = u.r0 + ai * HALF + wr * 64 + m * 16 + fr; float s = 0.f, q = 0.f;
#pragma unroll
            for (int bj = 0; bj < 2; ++bj)
#pragma unroll
                for (int n = 0; n < 2; ++n) { const int col = u.c0 * 256 + bj * HALF + wc * 32 + 16 * n + 4 * fq;
                    const u32x2 hw = *(const u32x2*)(XN + (size_t)row * 2048 + col);
                    f32x4 z = acc[ai][bj][m][n];
                    z[0] += ALPHA * bf_lo(hw.x); z[1] += ALPHA * bf_hi(hw.x); z[2] += ALPHA * bf_lo(hw.y); z[3] += ALPHA * bf_hi(hw.y);
                    s += (z[0] + z[1]) + (z[2] + z[3]); q += (z[0] * z[0] + z[1] * z[1]) + (z[2] * z[2] + z[3] * z[3]);
                    *(f32x4*)(Z + (size_t)row * 2048 + col) = z; }
            s += __shfl_xor(s, 16); s += __shfl_xor(s, 32); q += __shfl_xor(q, 16); q += __shfl_xor(q, 32);
            if (fq == 0) *(f32x2*)(ST + ((size_t)row * 32 + u.c0 * 4 + wc) * 2) = (f32x2){s, q}; }
    }
};
__device__ __forceinline__ float clamp448(float v) { return __builtin_fminf(__builtin_fmaxf(v, -448.f), 448.f); }
__device__ __forceinline__ u32x2 pack8_fp8(f32x4 v0, f32x4 v1) {
    int lo = 0, hi = 0;
    lo = __builtin_amdgcn_cvt_pk_fp8_f32(clamp448(v0[0]), clamp448(v0[1]), lo, false); lo = __builtin_amdgcn_cvt_pk_fp8_f32(clamp448(v0[2]), clamp448(v0[3]), lo, true);
    hi = __builtin_amdgcn_cvt_pk_fp8_f32(clamp448(v1[0]), clamp448(v1[1]), hi, false); hi = __builtin_amdgcn_cvt_pk_fp8_f32(clamp448(v1[2]), clamp448(v1[3]), hi, true);
    return (u32x2){(unsigned)lo, (unsigned)hi};
}
struct EpiGU {
    static constexpr int PERM = 1;
    unsigned char* HID; unsigned char* HIDS;
    __device__ __forceinline__ void operator()(const f32x4 (&acc)[2][2][4][2], const Unit& u, int wr, int wc, int fr, int fq) const {
        unsigned char* dst = u.aux ? HIDS : HID; constexpr float WI = 1.f / W8SCALE;
#pragma unroll
        EPI_LOOP_ROWS { const int rt = ai * HALF + wr * 64 + m * 16 + fr;
            if (rt < u.valid) { f32x4 h0, h1;
#pragma unroll
                for (int e = 0; e < 4; ++e) { const float g0 = acc[ai][0][m][0][e] * WI, g1 = acc[ai][0][m][1][e] * WI;
                    h0[e] = g0 * fast_sigmoid(g0) * (acc[ai][1][m][0][e] * (WI * H8SCALE)); h1[e] = g1 * fast_sigmoid(g1) * (acc[ai][1][m][1][e] * (WI * H8SCALE)); }
                *(u32x2*)(dst + (size_t)(u.r0 + rt) * EFF + u.c0 * HALF + wc * 32 + 8 * fq) = pack8_fp8(h0, h1); } }
    }
};
struct EpiDown {
    static constexpr int PERM = 2;
    unsigned char* C; unsigned char* CS;
    __device__ __forceinline__ void operator()(const f32x4 (&acc)[2][2][4][2], const Unit& u, int wr, int wc, int fr, int fq) const {
        unsigned char* dst = u.aux ? CS : C; constexpr float SC = C8SCALE / (W8SCALE * H8SCALE);
#pragma unroll
        EPI_LOOP_ROWS { const int rt = ai * HALF + wr * 64 + m * 16 + fr;
            if (rt < u.valid) { const u32x2 lo = pack8_fp8(acc[ai][0][m][0] * SC, acc[ai][0][m][1] * SC), hi = pack8_fp8(acc[ai][1][m][0] * SC, acc[ai][1][m][1] * SC);
                *(u32x4*)(dst + (size_t)(u.r0 + rt) * 2048 + u.c0 * 256 + wc * 64 + 16 * fq) = (u32x4){lo.x, lo.y, hi.x, hi.y}; } }
    }
};
}

namespace att {
constexpr int D = 128, NW = 8, QBLK = 32, KVBLK = 64, QB = NW * QBLK;
constexpr int PQ = 1024, PKV = 1024, PO = 2048;
constexpr int SHM_V = KVBLK * D * 2, SHM_K = KVBLK * D * 2;
constexpr int OFF_WS = 2 * SHM_V + 2 * SHM_K, OFF_CUM = OFF_WS + NW * 64 * 4, LDS_BYTES = OFF_CUM + 2 * 64 * 4;
constexpr float THR2 = 8.f * 1.4426950408889634f;
constexpr unsigned WINF = 0x7fffffffu;
#define KSWZ(row, colB) ((row) * 256 + ((colB) ^ (((row) & 7) << 4)))
#define SBAR() __builtin_amdgcn_sched_barrier(0)
__device__ __forceinline__ int v_st(int k, int c) { const int kk = (k & ~0xC) | ((k & 4) << 1) | ((k & 8) >> 1); return ((kk >> 3) * 4 + (c >> 5)) * 512 + ((kk & 7) * 32 + (c & 31)) * 2; }
__device__ __forceinline__ int v_rd_base(int lane) { return ((lane & 3) << 3) | (((lane >> 2) & 3) << 6) | (((lane >> 4) & 1) << 5) | (((lane >> 5) & 1) << 8); }
constexpr int v_rd_off(int d0, int ks, int half) { return d0 * 512 + ks * 4096 + half * 2048; }
__device__ __forceinline__ int crow(int r, int hi) { return (r & 3) + 8 * (r >> 2) + 4 * hi; }
__device__ __forceinline__ unsigned cvtpk(float lo, float hi) { unsigned r; asm volatile("v_cvt_pk_bf16_f32 %0, %1, %2" : "=v"(r) : "v"(lo), "v"(hi)); return r; }
__device__ __forceinline__ bf16x8 ld8(const bf16_t* p) { return *reinterpret_cast<const bf16x8*>(p); }
__device__ __forceinline__ void mask_tile(f32x16& p0, f32x16& p1, int dq, unsigned W) {
    const float NEG = -__builtin_inff();
#pragma unroll
    for (int r = 0; r < 16; ++r) { const int c = (r & 3) + 8 * (r >> 2);
        if ((unsigned)(dq - c) >= W) p0[r] = NEG;
        if ((unsigned)(dq - c - 32) >= W) p1[r] = NEG; }
}
__device__ __forceinline__ void partialSM(f32x16& p0, f32x16& p1, float& m_reg, float& mn, float& alpha) {
    float pmax = p0[0];
#pragma unroll
    for (int r = 1; r < 16; ++r) pmax = fmaxf(pmax, p0[r]);
#pragma unroll
    for (int r = 0; r < 16; ++r) pmax = fmaxf(pmax, p1[r]);
    { auto rr = __builtin_amdgcn_permlane32_swap(__float_as_uint(pmax), __float_as_uint(pmax), false, false);
      pmax = fmaxf(__uint_as_float(rr[0]), __uint_as_float(rr[1])); }
    if (__builtin_expect(__all((pmax - m_reg) <= THR2), 1)) { mn = m_reg; alpha = 1.f; }
    else { mn = fmaxf(m_reg, pmax); alpha = __builtin_amdgcn_exp2f(m_reg - mn); m_reg = mn; }
#pragma unroll
    for (int r = 0; r < 16; ++r) p0[r] = p0[r] - mn;
#pragma unroll
    for (int r = 0; r < 16; ++r) p1[r] = p1[r] - mn;
#pragma unroll
    for (int r = 0; r < 16; ++r) p0[r] = __builtin_amdgcn_exp2f(p0[r]);
}
__device__ __forceinline__ void finishSM(f32x16& p0, f32x16& p1, float alpha, float& l_reg, bf16x8& pa0, bf16x8& pa1, bf16x8& pa2, bf16x8& pa3) {
#pragma unroll
    for (int r = 0; r < 16; ++r) p1[r] = __builtin_amdgcn_exp2f(p1[r]);
    float ps = 0;
#pragma unroll
    for (int r = 0; r < 16; ++r) ps += p0[r];
#pragma unroll
    for (int r = 0; r < 16; ++r) ps += p1[r];
    { auto rr = __builtin_amdgcn_permlane32_swap(__float_as_uint(ps), __float_as_uint(ps), false, false);
      ps = __uint_as_float(rr[0]) + __uint_as_float(rr[1]); }
    l_reg = l_reg * alpha + ps;
#define PK4(P, B_, OUT) do { unsigned a0 = cvtpk(P[B_+0], P[B_+1]), a1 = cvtpk(P[B_+2], P[B_+3]);                          \
        unsigned b0 = cvtpk(P[B_+4], P[B_+5]), b1 = cvtpk(P[B_+6], P[B_+7]);                                             \
        auto r0 = __builtin_amdgcn_permlane32_swap(a0, b0, false, false); auto r1 = __builtin_amdgcn_permlane32_swap(a1, b1, false, false); \
        u32x4 w = {r0[0], r1[0], r0[1], r1[1]}; OUT = *reinterpret_cast<bf16x8*>(&w); } while (0)
    PK4(p0, 0, pa0); PK4(p0, 8, pa1); PK4(p1, 0, pa2); PK4(p1, 8, pa3);
#undef PK4
}
template <int KB>
__device__ __forceinline__ void qkt(f32x16& p0, f32x16& p1, const LAS char* K_lds, const LAS float* cumL, int r32, int hi, const bf16x8* qr) {
    { int l_ = r32 + 32 * hi; asm volatile("" : "+v"(l_)); r32 = l_ & 31; hi = l_ >> 5; }
    const LAS float* cb = cumL + KB * 64 + 4 * hi;
#pragma unroll
    for (int g = 0; g < 4; ++g) { const f32x4 a = *(const LAS f32x4*)(cb + 8 * g), b = *(const LAS f32x4*)(cb + 32 + 8 * g);
        p0[4 * g] = a[0]; p0[4 * g + 1] = a[1]; p0[4 * g + 2] = a[2]; p0[4 * g + 3] = a[3];
        p1[4 * g] = b[0]; p1[4 * g + 1] = b[1]; p1[4 * g + 2] = b[2]; p1[4 * g + 3] = b[3]; }
    const LAS char* kb[4];
#pragma unroll
    for (int dd = 0; dd < 4; ++dd) kb[dd] = K_lds + KB * SHM_K + KSWZ(r32, (dd * 16 + hi * 8) * 2);
#pragma unroll
    for (int d0 = 0; d0 < 8; ++d0) { const LAS char* a = kb[d0 & 3] + (d0 >> 2) * 128;
        bf16x8 b0 = *reinterpret_cast<const LAS bf16x8*>(a);
        bf16x8 b1 = *reinterpret_cast<const LAS bf16x8*>(a + 32 * 256);
        p0 = __builtin_amdgcn_mfma_f32_32x32x16_bf16(b0, qr[d0], p0, 0, 0, 0);
        p1 = __builtin_amdgcn_mfma_f32_32x32x16_bf16(b1, qr[d0], p1, 0, 0, 0); }
}
template <int VB>
__device__ __forceinline__ void pv_tile(f32x16* o, int vb0, bf16x8 pa0, bf16x8 pa1, bf16x8 pa2, bf16x8 pa3) {
#define TRRD(dst, off) asm volatile("ds_read_b64_tr_b16 %0, %1 offset:%2" : "=&v"(dst) : "v"(vb0), "i"(off) : "memory")
#define PV_D0(d0) do { s16x4 l0, l1, l2, l3, h0, h1, h2, h3; constexpr int b_ = VB * SHM_V + v_rd_off(d0, 0, 0); \
        TRRD(l0, b_); TRRD(h0, b_ + 2048); TRRD(l1, b_ + 4096); TRRD(h1, b_ + 6144); TRRD(l2, b_ + 8192); TRRD(h2, b_ + 10240); TRRD(l3, b_ + 12288); TRRD(h3, b_ + 14336); \
        asm volatile("s_waitcnt lgkmcnt(0)" ::: "memory"); SBAR();   \
        o[d0] = __builtin_amdgcn_mfma_f32_32x32x16_bf16(pa0, (bf16x8){l0[0], l0[1], l0[2], l0[3], h0[0], h0[1], h0[2], h0[3]}, o[d0], 0, 0, 0);   \
        o[d0] = __builtin_amdgcn_mfma_f32_32x32x16_bf16(pa1, (bf16x8){l1[0], l1[1], l1[2], l1[3], h1[0], h1[1], h1[2], h1[3]}, o[d0], 0, 0, 0);   \
        o[d0] = __builtin_amdgcn_mfma_f32_32x32x16_bf16(pa2, (bf16x8){l2[0], l2[1], l2[2], l2[3], h2[0], h2[1], h2[2], h2[3]}, o[d0], 0, 0, 0);   \
        o[d0] = __builtin_amdgcn_mfma_f32_32x32x16_bf16(pa3, (bf16x8){l3[0], l3[1], l3[2], l3[3], h3[0], h3[1], h3[2], h3[3]}, o[d0], 0, 0, 0); } while (0)
    PV_D0(0); PV_D0(1); PV_D0(2); PV_D0(3);
#undef PV_D0
#undef TRRD
}
struct BlockRef { const bf16_t* Q; const bf16_t* K; const bf16_t* V; bf16_t* O; const float* nck; int P0; int j_lo; };
struct Seam { bf16x8 qr[8]; bf16x8 st_v0, st_v1, st_k0, st_k1; };
#define ROWP(p, k0, rr) ((p) + (size_t)((k0) + (rr)) * PKV + sc)
#define VMW() asm volatile("s_waitcnt vmcnt(0)" ::: "memory")
#define VMWN(n) asm volatile("s_waitcnt vmcnt(%0)" :: "i"(n) : "memory")
#define SLOAD_H(BR, k0, CB) do { S.st_v0 = ld8(ROWP((BR).V, k0, sr)); S.st_v1 = ld8(ROWP((BR).V, k0, 32 + sr));              \
                             S.st_k0 = ld8(ROWP((BR).K, k0, sr)); S.st_k1 = ld8(ROWP((BR).K, k0, 32 + sr)); \
                             if (wid == 0) __builtin_amdgcn_global_load_lds((const unsigned*)((BR).nck + (k0) + lane), (LAS unsigned*)(cumL + (CB) * 64), 4, 0, 0); } while (0)
#define SWRITE_HK(bf) do { int t_ = tid; asm volatile("" : "+v"(t_)); const int kws_ = KSWZ(t_ >> 4, (t_ & 15) * 16); \
                           *(LAS bf16x8*)(K_lds + (bf) * SHM_K + kws_) = S.st_k0; *(LAS bf16x8*)(K_lds + (bf) * SHM_K + kws_ + 32 * 256) = S.st_k1; } while (0)
#define SWRITE_HV(bf) do { int t_ = tid; asm volatile("" : "+v"(t_)); const int vs0_ = v_st(t_ >> 4, (t_ & 15) * 8), vs1_ = v_st(32 + (t_ >> 4), (t_ & 15) * 8); \
                           *(LAS bf16x8*)(V_lds + (bf) * SHM_V + vs0_) = S.st_v0; *(LAS bf16x8*)(V_lds + (bf) * SHM_V + vs1_) = S.st_v1; } while (0)
__device__ __forceinline__ void fox_prime(const BlockRef& cur, LAS char* lds, Seam& S) {
    const int tid = threadIdx.x, wid = __builtin_amdgcn_readfirstlane(tid >> 6), lane = tid & 63, r32 = lane & 31, hi = lane >> 5;
    const int sr = tid >> 4, sc = (tid & 15) * 8; LAS char* K_lds = lds + 2 * SHM_V; LAS float* cumL = (LAS float*)(lds + OFF_CUM);
    const int kb0 = cur.j_lo * KVBLK;
#pragma unroll
    for (int d0 = 0; d0 < 8; ++d0) S.qr[d0] = ld8(cur.Q + (size_t)(wid * QBLK + r32) * PQ + d0 * 16 + hi * 8);
    SLOAD_H(cur, kb0, 0); VMW(); SWRITE_HK(0);
    __syncthreads();
}
__device__ __forceinline__ void fox_block(const BlockRef& cur, const BlockRef& nxt, int skv, LAS char* lds, Seam& S) {
    const int tid = threadIdx.x, wid = __builtin_amdgcn_readfirstlane(tid >> 6), lane = tid & 63, r32 = lane & 31, hi = lane >> 5;
    const int j_lo = cur.j_lo;
    int j_hi = (cur.P0 + QB - 1) / KVBLK + 1; if (j_hi > skv / KVBLK) j_hi = skv / KVBLK;
    const int NT = j_hi - j_lo;
    const int kbn = nxt.j_lo * KVBLK;
    const int qlo = cur.P0 + wid * QBLK;
    LAS char* V_lds = lds; LAS char* K_lds = lds + 2 * SHM_V; LAS float* cumL = (LAS float*)(lds + OFF_CUM);
    LAS float* ws = (LAS float*)(lds + OFF_WS) + wid * 64; LAS float* li_l = ws; LAS float* al_l = ws + 32;
    float m_reg = -1e30f, l_reg = 0; f32x16 o[4] = {};
    const int sr = tid >> 4, sc = (tid & 15) * 8;
    const int vb0 = (int)(unsigned)(uintptr_t)V_lds + v_rd_base(lane);
#define RESC(a) do { if (__any((a) < 1.f)) { if (hi == 0) al_l[r32] = (a); asm volatile("s_waitcnt lgkmcnt(0)" ::: "memory");              \
                     _Pragma("unroll") for (int d_ = 0; d_ < 4; ++d_) _Pragma("unroll") for (int r = 0; r < 16; ++r) o[d_][r] *= al_l[crow(r, hi)]; } } while (0)
#define KBASE(t) ((j_lo + (t)) * KVBLK)
#define MASKT(P0_, P1_, t) do { const int kb_ = KBASE(t); if (kb_ + KVBLK - 1 > qlo) { int lc_ = lane; asm volatile("" : "+v"(lc_)); mask_tile(P0_, P1_, qlo + (lc_ & 31) - 4 * (lc_ >> 5) - kb_, WINF); } } while (0)
    constexpr int NQL = 8;
#define SEAM_K0() do { VMWN(NQL); SWRITE_HK(0); SBAR(); } while (0)
    f32x16 pA0, pA1, pB0, pB1; float mnA, mnB, alA, alB; bf16x8 pa0, pa1, pa2, pa3;
    SWRITE_HV(0); SBAR();
    if (NT > 1) { SLOAD_H(cur, KBASE(1), 1); }
    SBAR(); qkt<0>(pA0, pA1, K_lds, cumL, r32, hi, S.qr);
    MASKT(pA0, pA1, 0); partialSM(pA0, pA1, m_reg, mnA, alA);
    if (NT > 1) { VMW(); SWRITE_HV(1); SWRITE_HK(1); }
    __syncthreads();
#define HALF_STEP(PX0, PX1, mnX, alX, PY0, PY1, alY, t, KB, VB, SB) do {                                                      \
        SBAR(); qkt<KB>(PX0, PX1, K_lds, cumL, r32, hi, S.qr);                                                                \
        finishSM(PY0, PY1, alY, l_reg, pa0, pa1, pa2, pa3); SBAR();                                                           \
        if ((t) + 1 < NT) { SLOAD_H(cur, KBASE((t) + 1), SB); SBAR(); }                                                           \
        pv_tile<VB>(o, vb0, pa0, pa1, pa2, pa3); MASKT(PX0, PX1, (t)); partialSM(PX0, PX1, m_reg, mnX, alX);                  \
        __syncthreads();                                                                                                      \
        if ((t) + 1 < NT) { VMW(); SWRITE_HV(SB); SWRITE_HK(SB); }                                       \
        RESC(alX); __syncthreads(); } while (0)
    for (int t = 1; t + 1 < NT; t += 2) {
        HALF_STEP(pB0, pB1, mnB, alB, pA0, pA1, alA, t, 1, 0, 0);
        HALF_STEP(pA0, pA1, mnA, alA, pB0, pB1, alB, t + 1, 0, 1, 1);
    }
    const bool even = (NT & 1) == 0;
    if (even) { SBAR(); qkt<1>(pB0, pB1, K_lds, cumL, r32, hi, S.qr); SBAR(); }
    SLOAD_H(nxt, kbn, 0); SBAR();
    { int lc_ = lane; asm volatile("" : "+v"(lc_)); const bf16_t* qp_ = nxt.Q + (size_t)(wid * QBLK + (lc_ & 31)) * PQ + (lc_ >> 5) * 8;
#pragma unroll
    for (int d0 = 0; d0 < 8; ++d0) S.qr[d0] = ld8(qp_ + d0 * 16); }
    SBAR();
    finishSM(pA0, pA1, alA, l_reg, pa0, pa1, pa2, pa3); SBAR();
    pv_tile<0>(o, vb0, pa0, pa1, pa2, pa3);
    if (even) { MASKT(pB0, pB1, NT - 1); partialSM(pB0, pB1, m_reg, mnB, alB); __syncthreads(); RESC(alB);
        finishSM(pB0, pB1, alB, l_reg, pa0, pa1, pa2, pa3); SBAR(); pv_tile<1>(o, vb0, pa0, pa1, pa2, pa3); }
    SBAR(); SEAM_K0();
    if (hi == 0) li_l[r32] = l_reg; asm volatile("s_waitcnt lgkmcnt(0)" ::: "memory");
    float rli[16];
#pragma unroll
    for (int r = 0; r < 16; ++r) rli[r] = __builtin_amdgcn_rcpf(li_l[crow(r, hi)]);
    { int lc_ = lane; asm volatile("" : "+v"(lc_)); const int r32c = lc_ & 31, hic = lc_ >> 5;
    bf16_t* Ow = cur.O + (size_t)(wid * QBLK + 4 * hic) * PO + r32c;
#pragma unroll
    for (int r = 0; r < 16; ++r) { const int orow = (r & 3) + 8 * (r >> 2);
#pragma unroll
        for (int d0 = 0; d0 < 4; ++d0) { const float v = o[d0][r] * rli[r];
            const float vn = __shfl_xor(v, 1);
            if ((r32c & 1) == 0) *(unsigned*)(Ow + (size_t)orow * PO + d0 * 32) = cvtpk(v, vn); } } }
    __syncthreads();
#undef RESC
#undef KBASE
#undef MASKT
#undef SEAM_K0
#undef HALF_STEP
}
#undef ROWP
#undef VMW
#undef VMWN
#undef SLOAD_H
#undef SWRITE_HK
#undef SWRITE_HV
#undef SBAR
#undef KSWZ
}

typedef GAS unsigned gu32;
#define RLX_AGENT __ATOMIC_RELAXED, __HIP_MEMORY_SCOPE_AGENT
#define XB_TMO      128
#define XB_XCNT(j)  (256  + 64 * (j))
#define XB_XSUB(j)  (1280 + 64 * (j))
#define XB_XGEN(j)  (2304 + 64 * (j))
#define XB_TOP      3328
#define XB_TOPGEN   3392
#define XCD_BAR_WORDS 3456
#define XB_SPIN_CAP (1u << 20)
__device__ __forceinline__ unsigned xb_ld(unsigned* p)              { return __hip_atomic_load(p, __ATOMIC_RELAXED, __HIP_MEMORY_SCOPE_AGENT); }
__device__ __forceinline__ unsigned xb_add(unsigned* p, unsigned v) { return __hip_atomic_fetch_add(p, v, __ATOMIC_RELAXED, __HIP_MEMORY_SCOPE_AGENT); }
__device__ __forceinline__ unsigned xb_xcc_id() { return (unsigned)__builtin_amdgcn_s_getreg((3 << 11) | 20) & 0xFu; }
#define XB_SPIN(cond, bar) do { unsigned _sp = 0; while (cond) { __builtin_amdgcn_s_sleep(1); \
    if ((++_sp & 255u) == 0u) { if (xb_ld(&(bar)[XB_TMO])) break; if (_sp > XB_SPIN_CAP) { atomicAdd(&(bar)[XB_TMO], 1u); break; } } } } while (0)
struct XcdBarrier { unsigned* bar; unsigned x; volatile LAS unsigned* st; };
__device__ __forceinline__ XcdBarrier xcd_barrier_post(unsigned* bar, volatile LAS unsigned* st) {
    XcdBarrier b; b.bar = bar; b.x = xb_xcc_id(); b.st = st;
    if (threadIdx.x == 0) (void)xb_add(&bar[XB_XCNT(b.x)], 1u);
    return b;
}
__device__ __forceinline__ void xcd_barrier_complete(unsigned* bar, unsigned x, unsigned& nloc, unsigned& nx) {
    const unsigned G = gridDim.x * gridDim.y * gridDim.z;
    unsigned sum, cnt, mine, sp = 0u;
    for (;;) {
        sum = 0u; cnt = 0u; mine = 0u;
#pragma unroll
        for (unsigned j = 0; j < 16; ++j) { const unsigned c = xb_ld(&bar[XB_XCNT(j)]); sum += c; cnt += (c > 0u) ? 1u : 0u; mine = (j == x) ? c : mine; }
        if (sum == G) break;
        __builtin_amdgcn_s_sleep(1);
        if ((++sp & 255u) == 0u) { if (xb_ld(&bar[XB_TMO])) break; if (sp > XB_SPIN_CAP) { atomicAdd(&bar[XB_TMO], 1u); break; } }
    }
    nloc = mine > 0u ? mine : 1u; nx = cnt > 0u ? cnt : 1u;
}
__device__ __forceinline__ void xcd_barrier(const XcdBarrier& b) {
    asm volatile("s_waitcnt vmcnt(0)" ::: "memory");
    __syncthreads();
    if (threadIdx.x == 0) {
        unsigned* bar = b.bar;
        __builtin_amdgcn_s_waitcnt(0);
        unsigned nloc = b.st[0], nx = b.st[1];
        if (nloc == 0u) { xcd_barrier_complete(bar, b.x, nloc, nx); b.st[0] = nloc; b.st[1] = nx; }
        const unsigned old = xb_add(&bar[XB_XSUB(b.x)], 1u);
        const unsigned gen = old / nloc;
        if (old + 1u == (gen + 1u) * nloc) {
            __builtin_amdgcn_fence(__ATOMIC_RELEASE, "agent");
            asm volatile("s_waitcnt vmcnt(0)" ::: "memory");
            const unsigned og = xb_add(&bar[XB_TOP], 1u);
            const unsigned tg = og / nx;
            if (og + 1u == (tg + 1u) * nx) xb_add(&bar[XB_TOPGEN], 1u);
            else XB_SPIN(xb_ld(&bar[XB_TOPGEN]) == tg, bar);
            __builtin_amdgcn_fence(__ATOMIC_ACQUIRE, "agent");
            xb_add(&bar[XB_XGEN(b.x)], 1u);
            asm volatile("s_waitcnt vmcnt(0)" ::: "memory");
        } else {
            XB_SPIN(xb_ld(&bar[XB_XGEN(b.x)]) == gen, bar);
            __builtin_amdgcn_fence(__ATOMIC_ACQUIRE, "agent");
            asm volatile("s_waitcnt vmcnt(0)" ::: "memory");
        }
    }
    __syncthreads();
}

constexpr int NWAVES = 8;
constexpr int N_PHASES = 12;
constexpr int N_LAUNCHES = MK_N_LAUNCHES;
static_assert(N_LAUNCHES == 1 || N_LAUNCHES == N_PHASES, "MK_N_LAUNCHES is 1 (one dispatch) or 12 (one dispatch per phase)");
struct Args { const float* in[29]; float* out; unsigned char* ws; int ph_lo, ph_hi; };
struct Frame {
    LAS unsigned char* lds; volatile LAS unsigned* MISC; gu32* ctl; unsigned char* ws;
    int tid, lane, wave, vcu, G;
};

struct TileRef { const float* src; void* dst; int ld_src, ld_dst, f8; };
__device__ __forceinline__ void p0_tile_load(const TileRef& t, f32x4 (&v)[16], int lane) {
    const int c4 = lane & 7, r8 = lane >> 3;
#pragma unroll
    for (int it = 0; it < 16; ++it) v[it] = *(const f32x4*)(t.src + (size_t)(it * 8 + r8) * t.ld_src + 4 * c4);
}
__device__ __forceinline__ void p0_tile_store(const TileRef& t, const f32x4 (&v)[16], LAS float* scr, int lane) {
    const int c4 = lane & 7, r8 = lane >> 3;
#pragma unroll
    for (int it = 0; it < 16; ++it) { const int r = it * 8 + r8;
#pragma unroll
        for (int e = 0; e < 4; ++e) scr[(4 * c4 + e) * 132 + r] = v[it][e]; }
    LDS_WAIT(); asm volatile("" ::: "memory");
    const int kc = lane & 15, n4 = lane >> 4;
#pragma unroll
    for (int it = 0; it < 8; ++it) { const int n = it * 4 + n4;
        const f32x4 a = *(const LAS f32x4*)(scr + n * 132 + 8 * kc), b = *(const LAS f32x4*)(scr + n * 132 + 8 * kc + 4);
        if (t.f8) { int lo = 0, hi = 0;
            lo = __builtin_amdgcn_cvt_pk_fp8_f32(a[0] * W8SCALE, a[1] * W8SCALE, lo, false); lo = __builtin_amdgcn_cvt_pk_fp8_f32(a[2] * W8SCALE, a[3] * W8SCALE, lo, true);
            hi = __builtin_amdgcn_cvt_pk_fp8_f32(b[0] * W8SCALE, b[1] * W8SCALE, hi, false); hi = __builtin_amdgcn_cvt_pk_fp8_f32(b[2] * W8SCALE, b[3] * W8SCALE, hi, true);
            *(u32x2*)((unsigned char*)t.dst + (size_t)n * t.ld_dst + 8 * kc) = (u32x2){(unsigned)lo, (unsigned)hi}; }
        else { u32x4 w; w.x = cvt_pk_bf16(a[0], a[1]); w.y = cvt_pk_bf16(a[2], a[3]); w.z = cvt_pk_bf16(b[0], b[1]); w.w = cvt_pk_bf16(b[2], b[3]);
            *(u32x4*)((bf16_t*)t.dst + (size_t)n * t.ld_dst + 8 * kc) = w; } }
    LDS_WAIT(); asm volatile("" ::: "memory");
}
template <int MODE, int F8>
__device__ __forceinline__ TileRef p0_mat_ref(const float* src, int ldsrc, int K, int N, void* dst, int which, int it) {
    const int nblk = N / 32, kb = it / nblk, nb = it - kb * nblk, k0 = 128 * kb, n0 = 32 * nb;
    const int drow = MODE == 0 ? n0 : ((n0 >> 7) * 256 + which * 128 + (n0 & 127));
    TileRef t; t.src = src + (size_t)k0 * ldsrc + n0; t.ld_src = ldsrc; t.f8 = F8; t.ld_dst = K;
    t.dst = F8 ? (void*)((unsigned char*)dst + (size_t)drow * K + k0) : (void*)((bf16_t*)dst + (size_t)drow * K + k0); return t;
}
__device__ __forceinline__ void p0_prologue(Frame& F, const __attribute__((address_space(4))) Args& a) {
    unsigned char* ws = F.ws;
    const int gw = F.vcu * NWAVES + F.wave, NGW = F.G * NWAVES;
    {
        LAS float* scr = (LAS float*)(F.lds + F.wave * 16896);
        constexpr int I_EXP = 256;
        constexpr int N_EG = NEXP * I_EXP, N_EU = N_EG, N_ED = N_EG;
        constexpr int I_IN = 16 * 128, I_OUT = 16 * 64, I_GLU = 8 * 32, I_R = 16 * 2, I_SG = 16 * 16, I_SU = 16 * 16, I_SD = 4 * 64;
        constexpr int NITEMS = N_EG + N_EU + N_ED + I_IN + I_OUT + I_GLU + I_R + I_SG + I_SU + I_SD;
        unsigned char* Wegu = ws + WS_WEGU; unsigned char* Wed = ws + WS_WED;
#define P0_REF(T, it_) do { int r = (it_); \
            if (r < N_EG) { const int e = r / I_EXP; T = p0_mat_ref<1, 1>(a.in[21] + (size_t)e * 2048 * 512, 512, 2048, 512, Wegu + (size_t)e * 1024 * 2048, 0, r % I_EXP); break; } r -= N_EG; \
            if (r < N_EU) { const int e = r / I_EXP; T = p0_mat_ref<1, 1>(a.in[22] + (size_t)e * 2048 * 512, 512, 2048, 512, Wegu + (size_t)e * 1024 * 2048, 1, r % I_EXP); break; } r -= N_EU; \
            if (r < N_ED) { const int e = r / I_EXP; T = p0_mat_ref<0, 1>(a.in[23] + (size_t)e * 512 * 2048, 2048, 512, 2048, Wed + (size_t)e * 2048 * 512, 0, r % I_EXP); break; } r -= N_ED; \
            if (r < I_IN) { T = p0_mat_ref<0, 0>(a.in[4], 4104, 2048, 4096, (bf16_t*)(ws + WS_WIN), 0, r); break; } r -= I_IN; \
            if (r < I_OUT) { T = p0_mat_ref<0, 0>(a.in[16], 2048, 2048, 2048, (bf16_t*)(ws + WS_WOUT), 0, r); break; } r -= I_OUT; \
            if (r < I_GLU) { T = p0_mat_ref<0, 0>(a.in[14], 1024, 1024, 1024, (bf16_t*)(ws + WS_WGLU), 0, r); break; } r -= I_GLU; \
            if (r < I_R) { T = p0_mat_ref<0, 0>(a.in[19], 64, 2048, 64, (bf16_t*)(ws + WS_WR), 0, r); break; } r -= I_R; \
            if (r < I_SG) { T = p0_mat_ref<1, 1>(a.in[24], 512, 2048, 512, (ws + WS_WSGU), 0, r); break; } r -= I_SG; \
            if (r < I_SU) { T = p0_mat_ref<1, 1>(a.in[25], 512, 2048, 512, (ws + WS_WSGU), 1, r); break; } r -= I_SU; \
            T = p0_mat_ref<0, 1>(a.in[26], 2048, 512, 2048, (ws + WS_WSD), 0, r); } while (0)
        for (int rep_ = 0; rep_ < ((REP_PH) == 20 ? 2 : 1); ++rep_) {
        int it = gw;
        if (it < NITEMS) {
            TileRef tc, tn; f32x4 vc[16], vn[16];
            P0_REF(tc, it); p0_tile_load(tc, vc, F.lane);
            for (;;) {
                const int itn = it + NGW; const bool more = itn < NITEMS;
                if (more) { P0_REF(tn, itn); p0_tile_load(tn, vn, F.lane); }
                p0_tile_store(tc, vc, scr, F.lane);
                if (!more) break;
#pragma unroll
                for (int i = 0; i < 16; ++i) vc[i] = vn[i];
                tc = tn; it = itn;
            }
        }
        }
#undef P0_REF
    }
    __syncthreads();
    if (F.vcu < NGRP) {
        const int g = F.vcu, t = F.tid;
        LAS float* apr = (LAS float*)F.lds;
        LAS float* api = apr + 64 * 33;
        LAS float* bbr = api + 64 * 33;
        LAS float* bbi = bbr + 1024;
        LAS float* cr = bbi + 1024;
        LAS float* ci = cr + 1024;
        LAS float* kg = ci + 1024;
        LAS float* dsk = kg + 8192;
        const float* a_re = a.in[6]; const float* a_im = a.in[7]; const float* log_dt = a.in[8];
        const float* b_re = a.in[9]; const float* b_im = a.in[10]; const float* c_re = a.in[11]; const float* c_im = a.in[12]; const float* dsk_g = a.in[13];
        { const float dt = expf(log_dt[g]);
          for (int idx = t; idx < 64 * 33; idx += 512) { const int p = idx / 33, tau = idx - p * 33; const float ar = a_re[g * 64 + p], ai = a_im[g * 64 + p];
              const float m = expf((float)tau * dt * ar); float s, c; sincosf((float)tau * dt * ai, &s, &c); apr[idx] = m * c; api[idx] = m * s; } }
        for (int idx = t; idx < 1024; idx += 512) { cr[idx] = c_re[g * 1024 + idx]; ci[idx] = c_im[g * 1024 + idx]; }
        if (t < 16) dsk[t] = dsk_g[g * 16 + t];
        __syncthreads();
        for (int idx = t; idx < 1024; idx += 512) { const int p = idx >> 4; const float ar = a_re[g * 64 + p], ai = a_im[g * 64 + p];
            const float abr = apr[p * 33 + 1] - 1.f, abi = api[p * 33 + 1], den = ar * ar + ai * ai;
            const float cre = (abr * ar + abi * ai) / den, cim = (abi * ar - abr * ai) / den;
            const float br = b_re[g * 1024 + idx], bi = b_im[g * 1024 + idx]; bbr[idx] = cre * br - cim * bi; bbi[idx] = cre * bi + cim * br; }
        __syncthreads();
        { const int tau = t >> 4, hp = t & 15;
          float acc[16];
#pragma unroll
          for (int h = 0; h < 16; ++h) acc[h] = 0.f;
          for (int p = 0; p < 64; ++p) { const float c_r = cr[hp * 64 + p], c_i = ci[hp * 64 + p], pr = apr[p * 33 + tau], pi = api[p * 33 + tau];
              const float gr = c_r * pr - c_i * pi, gi = c_r * pi + c_i * pr;
#pragma unroll
              for (int h4 = 0; h4 < 4; ++h4) { const f32x4 br4 = *(const LAS f32x4*)(bbr + p * 16 + 4 * h4), bi4 = *(const LAS f32x4*)(bbi + p * 16 + 4 * h4);
#pragma unroll
                  for (int e = 0; e < 4; ++e) acc[4 * h4 + e] += gr * br4[e] - gi * bi4[e]; } }
#pragma unroll
          for (int h = 0; h < 16; ++h) kg[tau * 256 + hp * 16 + h] = acc[h] + ((tau == 0 && hp == h) ? dsk[h] : 0.f); }
        __syncthreads();
        bf16_t* OPY = (bf16_t*)(ws + WS_OPY) + (size_t)g * 512 * UGK;
        for (int it = t; it < 512 * 80; it += 512) { const int n = it / 80, ch = it - n * 80, tt = n >> 4, hp = n & 15; float v[8];
            if (ch < 64) { const int j = ch >> 1, h0 = (ch & 1) * 8;
#pragma unroll
                for (int e = 0; e < 8; ++e) v[e] = (tt >= j) ? kg[(tt - j) * 256 + hp * 16 + h0 + e] : 0.f; }
            else { const int q = ch - 64;
#pragma unroll
                for (int e2 = 0; e2 < 4; ++e2) { const int p = q * 4 + e2; const float c_r = cr[hp * 64 + p], c_i = ci[hp * 64 + p], pr = apr[p * 33 + tt + 1], pi = api[p * 33 + tt + 1];
                    v[2 * e2] = c_r * pr - c_i * pi; v[2 * e2 + 1] = -(c_r * pi + c_i * pr); } }
            u32x4 w; w.x = cvt_pk_bf16(v[0], v[1]); w.y = cvt_pk_bf16(v[2], v[3]); w.z = cvt_pk_bf16(v[4], v[5]); w.w = cvt_pk_bf16(v[6], v[7]);
            *(u32x4*)(OPY + (size_t)n * UGK + ch * 8) = w; }
        bf16_t* OPE = (bf16_t*)(ws + WS_OPE) + (size_t)g * 256 * 512;
        for (int it = t; it < 256 * 64; it += 512) { const int n = it >> 6, ch = it & 63; float v[8];
            if (n < 128) { const int p = n >> 1, ri = n & 1, j = ch >> 1, h0 = (ch & 1) * 8; const float pr = apr[p * 33 + 31 - j], pi = api[p * 33 + 31 - j];
#pragma unroll
                for (int e = 0; e < 8; ++e) { const float br = bbr[p * 16 + h0 + e], bi = bbi[p * 16 + h0 + e]; v[e] = ri == 0 ? (pr * br - pi * bi) : (pr * bi + pi * br); } }
            else {
#pragma unroll
                for (int e = 0; e < 8; ++e) v[e] = 0.f; }
            u32x4 w; w.x = cvt_pk_bf16(v[0], v[1]); w.y = cvt_pk_bf16(v[2], v[3]); w.z = cvt_pk_bf16(v[4], v[5]); w.w = cvt_pk_bf16(v[6], v[7]);
            *(u32x4*)(OPE + (size_t)n * 512 + ch * 8) = w; }
    }
    __syncthreads();
    {
        const int gt = F.vcu * 512 + F.tid, NGT = F.G * 512; const u32x4 z4 = {0u, 0u, 0u, 0u};
        for (int i = gt; i < 2 * 2 * 48 * 128; i += NGT) { const int ch = i & 127, r = (i >> 7) % 48, b = ((i >> 7) / 48) & 1, kv = (i >> 7) / 96;
            bf16_t* base = (bf16_t*)(ws + (kv ? WS_V : WS_K)); *(u32x4*)(base + ((size_t)b * KVR + r) * 1024 + ch * 8) = z4; }
        for (int i = gt; i < 128 * 32; i += NGT) { const int ch = i & 31, gb = i >> 5;
            *(u32x4*)((bf16_t*)(ws + WS_UG) + ((size_t)gb * NCHK + 1) * UGK + ch * 8) = z4; }
        for (int i = gt; i < 16 * 48; i += NGT) { const int r = i % 48, bh = i / 48; ((float*)(ws + WS_LOGF))[(size_t)bh * KVR + r] = 0.f; }
    }
    {
        LAS float* wf = (LAS float*)F.lds;
        for (int i = F.tid; i < 8 * 2048; i += 512) { const int h = i & 7, k = i >> 3; wf[h * 2048 + k] = a.in[4][(size_t)k * 4104 + 4096 + h]; }
        __syncthreads();
        const float* x = a.in[0]; const float* meta = a.in[1]; const float* lg = a.in[2]; const float* lb = a.in[3]; const float* bfg = a.in[5];
        bf16_t* XN = (bf16_t*)(ws + WS_XN); float* logf_ = (float*)(ws + WS_LOGF);
        for (int row = gw; row < MX + NMETA; row += NGW) {
            const float* src = row < MX ? x + (size_t)row * DM : meta + (size_t)(row - MX) * DM;
            f32x4 v[8]; float s = 0.f;
#pragma unroll
            for (int j = 0; j < 8; ++j) { v[j] = ((const f32x4*)src)[j * 64 + F.lane]; s += (v[j][0] + v[j][1]) + (v[j][2] + v[j][3]); }
            const float mean = wave_sum(s) * (1.f / DM); float s2 = 0.f;
#pragma unroll
            for (int j = 0; j < 8; ++j) { v[j] = v[j] - mean; s2 += (v[j][0] * v[j][0] + v[j][1] * v[j][1]) + (v[j][2] * v[j][2] + v[j][3] * v[j][3]); }
            const float rstd = 1.f / sqrtf(wave_sum(s2) * (1.f / DM) + LN_EPS);
            float fl[8];
#pragma unroll
            for (int h = 0; h < 8; ++h) fl[h] = 0.f;
#pragma unroll
            for (int j = 0; j < 8; ++j) { const f32x4 g4 = ((const f32x4*)lg)[j * 64 + F.lane], b4 = ((const f32x4*)lb)[j * 64 + F.lane];
                v[j] = v[j] * rstd * g4 + b4;
                *(u32x2*)(XN + (size_t)row * DM + j * 256 + F.lane * 4) = (u32x2){cvt_pk_bf16(v[j][0], v[j][1]), cvt_pk_bf16(v[j][2], v[j][3])};
#pragma unroll
                for (int h = 0; h < 8; ++h) { const f32x4 w4 = *(const LAS f32x4*)(wf + h * 2048 + j * 256 + F.lane * 4); fl[h] += (v[j][0] * w4[0] + v[j][1] * w4[1]) + (v[j][2] * w4[2] + v[j][3] * w4[3]); } }
#pragma unroll
            for (int h = 0; h < 8; ++h) fl[h] = wave_sum(fl[h]);
            if (F.lane < 8) { const int h = F.lane;
                float val = h == 0 ? fl[0] : h == 1 ? fl[1] : h == 2 ? fl[2] : h == 3 ? fl[3] : h == 4 ? fl[4] : h == 5 ? fl[5] : h == 6 ? fl[6] : fl[7];
                val += bfg[h];
                const float lf = fminf(val, 0.f) - log1pf(expf(-fabsf(val)));
                if (row < MX) { const int b = row >> 13, sx = row & (SEQ - 1); logf_[(size_t)(b * 8 + h) * KVR + 64 + sx] = lf; }
                else { const int i = row - MX; logf_[(size_t)(0 * 8 + h) * KVR + 48 + i] = lf; logf_[(size_t)(1 * 8 + h) * KVR + 48 + i] = lf; } }
        }
    }
    {
        __syncthreads();
        LAS float* hm = (LAS float*)F.lds;
        const float* meta = a.in[1]; const float* lg = a.in[2]; const float* lb = a.in[3]; const float* w_in = a.in[4];
#pragma unroll 1
        for (int rr = 0; rr < 2; ++rr) { const int row = F.wave * 2 + rr; const float* src = meta + (size_t)row * DM;
            f32x4 v[8]; float s = 0.f;
#pragma unroll
            for (int j = 0; j < 8; ++j) { v[j] = ((const f32x4*)src)[j * 64 + F.lane]; s += (v[j][0] + v[j][1]) + (v[j][2] + v[j][3]); }
            const float mean = wave_sum(s) * (1.f / DM); float s2 = 0.f;
#pragma unroll
            for (int j = 0; j < 8; ++j) { v[j] = v[j] - mean; s2 += (v[j][0] * v[j][0] + v[j][1] * v[j][1]) + (v[j][2] * v[j][2] + v[j][3] * v[j][3]); }
            const float rstd = 1.f / sqrtf(wave_sum(s2) * (1.f / DM) + LN_EPS);
#pragma unroll
            for (int j = 0; j < 8; ++j) { const f32x4 g4 = ((const f32x4*)lg)[j * 64 + F.lane], b4 = ((const f32x4*)lb)[j * 64 + F.lane];
                *(LAS f32x4*)(hm + row * 2048 + j * 256 + F.lane * 4) = v[j] * rstd * g4 + b4; } }
        __syncthreads();
        for (int c = F.vcu; c < 256; c += F.G) {
            const int col0 = 16 * c, sect = col0 >> 10; if (sect == 1) continue;
            const int r = F.tid >> 5, ks = F.tid & 31;
            f32x4 a0 = {0.f, 0.f, 0.f, 0.f}, a1 = a0, a2 = a0, a3 = a0;
#pragma unroll 4
            for (int i = 0; i < 64; ++i) { const int k = ks + 32 * i; const float h = hm[r * 2048 + k]; const f32x4* wp = (const f32x4*)(w_in + (size_t)k * 4104 + col0);
                a0 += h * wp[0]; a1 += h * wp[1]; a2 += h * wp[2]; a3 += h * wp[3]; }
#pragma unroll
            for (int o = 1; o < 32; o <<= 1) {
#pragma unroll
                for (int e = 0; e < 4; ++e) { a0[e] += __shfl_xor(a0[e], o); a1[e] += __shfl_xor(a1[e], o); a2[e] += __shfl_xor(a2[e], o); a3[e] += __shfl_xor(a3[e], o); } }
            if (ks == 0) { const int colsec = col0 & 1023;
                const u32x4 w0 = {cvt_pk_bf16(a0[0], a0[1]), cvt_pk_bf16(a0[2], a0[3]), cvt_pk_bf16(a1[0], a1[1]), cvt_pk_bf16(a1[2], a1[3])};
                const u32x4 w1 = {cvt_pk_bf16(a2[0], a2[1]), cvt_pk_bf16(a2[2], a2[3]), cvt_pk_bf16(a3[0], a3[1]), cvt_pk_bf16(a3[2], a3[3])};
#pragma unroll
                for (int b = 0; b < 2; ++b) { bf16_t* dst;
                    if (sect == 0) dst = (bf16_t*)(ws + WS_UG) + ((size_t)(((colsec >> 4) * 2 + b) * NCHK + 1)) * UGK + (16 + r) * 16;
                    else dst = (bf16_t*)(ws + (sect == 2 ? WS_K : WS_V)) + ((size_t)b * KVR + 48 + r) * 1024 + colsec;
                    *(u32x4*)dst = w0; *(u32x4*)(dst + 8) = w1; } }
        }
    }
}

__device__ __forceinline__ void p1_cumsum(Frame& F, int seq) {
    const float* lf = (const float*)(F.ws + WS_LOGF) + (size_t)seq * KVR; float* cum = (float*)(F.ws + WS_CUM) + (size_t)seq * KVR;
    LAS float* part = (LAS float*)F.lds;
    constexpr int PER = 17; const int i0 = F.tid * PER; float s = 0.f;
    for (int k = 0; k < PER; ++k) { const int i = i0 + k; if (i < KVR) s += lf[i]; }
    part[F.tid] = s; __syncthreads();
    float pre = 0.f; for (int j = 0; j < F.tid; ++j) pre += part[j];
    for (int k = 0; k < PER; ++k) { const int i = i0 + k; if (i < KVR) { pre += lf[i]; cum[i] = (i < 48) ? -__builtin_inff() : -pre * LOG2E; } }
    __syncthreads();
}

__device__ __forceinline__ void moe_tables(Frame& F) {
    LAS int* tb = (LAS int*)(F.lds + TB_OFF);
    if (F.tid < NEXP) tb[130 + F.tid] = (int)__hip_atomic_load(F.ctl + CW_CNT + 64 * F.tid, RLX_AGENT);
    __syncthreads();
    if (F.tid == 0) { int tp = 0, cp = 0; for (int e = 0; e < NEXP; ++e) { tb[e] = tp; tb[65 + e] = cp; const int c = tb[130 + e]; tp += (c + 255) >> 8; cp += c; } tb[64] = tp; tb[129] = cp; }
    __syncthreads();
}

template <unsigned MASK>
__global__ void __launch_bounds__(NWAVES * 64, 2) hymba_fwd(Args args_) {
    extern __shared__ __attribute__((aligned(16))) unsigned char lds[];
    (void)args_;
    const __attribute__((address_space(4))) Args& args = *(const __attribute__((address_space(4))) Args*)__builtin_amdgcn_kernarg_segment_ptr();
    Frame F;
    F.lds = (LAS unsigned char*)lds;
    F.MISC = (volatile LAS unsigned*)(F.lds + MISC_OFF);
    F.tid = threadIdx.x; F.lane = F.tid & 63; F.wave = __builtin_amdgcn_readfirstlane(F.tid >> 6);
    F.G = gridDim.x; { const int bx = blockIdx.x; F.vcu = (F.G % 8 == 0) ? (bx % 8) * (F.G / 8) + bx / 8 : bx; }
    unsigned char* ws = args.ws; F.ws = ws;
    F.ctl = (gu32*)(ws + WS_CTL);
    for (int u = F.tid; u < (LDS_BYTES - LDSCTL_OFF) / 4; u += NWAVES * 64) ((LAS unsigned*)(F.lds + LDSCTL_OFF))[u] = 0u;
    __syncthreads();
    XcdBarrier bar; bar.bar = (unsigned*)(F.ctl + CW_BAR); bar.x = 0; bar.st = nullptr;
    if (N_LAUNCHES == 1) bar = xcd_barrier_post((unsigned*)(F.ctl + CW_BAR), F.MISC + 8);
#define GRID_BAR() do { if (N_LAUNCHES == 1) xcd_barrier(bar); } while (0)
    const int lo = args.ph_lo, hi = args.ph_hi;
#define IN(k) (((MASK >> (k)) & 1u) && lo <= (k) && (k) < hi)
#define BOTH(k) (IN(k) && IN((k) + 1))
#define REPS(k) for (int rep_ = 0; rep_ < ((REP_PH) == (k) ? 2 : 1); ++rep_)
    const int gw = F.vcu * NWAVES + F.wave, NGW = F.G * NWAVES;
    const int bx = (int)blockIdx.x;

    if (IN(0)) { REPS(0) { p0_prologue(F, args); __syncthreads(); } if (BOTH(0)) GRID_BAR(); }

    if (IN(1)) {
        if (F.vcu < 16) p1_cumsum(F, F.vcu);
        pg8::DenseOrder S; S.init(ws + WS_XN, ws + WS_WIN, DM, DM, MX, 4096, F.G, bx);
        pg8::EpiInProj E{(bf16_t*)(ws + WS_UG), (bf16_t*)(ws + WS_Q), (bf16_t*)(ws + WS_K), (bf16_t*)(ws + WS_V)};
        REPS(1) pg8::gemm_phase<pg8::EpiInProj, pg8::DenseOrder, true>(F.lds, pg8::GemmK{DM, DM, DM}, S, E);
        if (BOTH(1)) GRID_BAR();
    }

    if (IN(2)) {
        REPS(2)
        for (int L = bx; L < 256; L += F.G) {
            const int g = L >> 2, b = (L >> 1) & 1, pn = L & 1, gb = g * 2 + b;
            { pg8::OneUnit S; S.u.A = (const char*)(ws + WS_UG) + ((size_t)(gb * NCHK + 1)) * UGK * 2; S.u.B = (const char*)(ws + WS_OPE) + (size_t)g * 256 * 512 * 2; S.u.rows = nullptr;
              S.u.r0 = gb * 256; S.u.c0 = 0; S.u.valid = 256; S.u.aux = g; S.rowbytes = UGK * 2;
              pg8::EpiE E{(float*)(ws + WS_E)};
              for (int r2_ = 0; r2_ < ((REP_PH) == 21 ? 2 : 1); ++r2_) pg8::gemm_phase<pg8::EpiE, pg8::OneUnit, false>(F.lds, pg8::GemmK{512, UGK, 512}, S, E); }
            VM_WAIT(); __syncthreads();
            for (int r2_ = 0; r2_ < ((REP_PH) == 22 ? 2 : 1); ++r2_)
            if (F.wave == 0) {
                __builtin_amdgcn_fence(__ATOMIC_ACQUIRE, "agent");
                const int p = F.lane;
                const float dt = expf(args.in[8][g]), ar = args.in[6][g * 64 + p], ai = args.in[7][g * 64 + p];
                const float mag = expf(32.f * dt * ar); float sn, cs; sincosf(32.f * dt * ai, &sn, &cs);
                const float a_r = mag * cs, a_i = mag * sn;
                const float* Eb = (const float*)(ws + WS_E) + (size_t)gb * 256 * 128 + 2 * p;
                bf16_t* Ub = (bf16_t*)(ws + WS_UG) + (size_t)gb * NCHK * UGK + 512 + 2 * p;
                float sr = 0.f, si = 0.f;
#pragma unroll 1
                for (int r0 = 0; r0 < 256; r0 += 32) { f32x2 ev[32];
#pragma unroll
                    for (int i = 0; i < 32; ++i) ev[i] = *(const f32x2*)(Eb + (size_t)(r0 + i) * 128);
#pragma unroll
                    for (int i = 0; i < 32; ++i) { const float nr = a_r * sr - a_i * si + ev[i][0], ni = a_r * si + a_i * sr + ev[i][1]; sr = nr; si = ni;
                        *(unsigned*)(Ub + (size_t)(r0 + i + 2) * UGK) = cvt_pk_bf16(sr, si); } }
            } else {
                const bf16_t* Qb = (const bf16_t*)(ws + WS_Q); const bf16_t* Kb = (const bf16_t*)(ws + WS_K);
                for (int it = (L * 7 + F.wave - 1); it < 1024 + 1032; it += 256 * 7) {
                    const bool isq = it < 1024; const int row0 = (isq ? it : it - 1024) * 16;
                    const bf16_t* base = (isq ? Qb : Kb) + (size_t)row0 * 1024 + F.lane * 8;
                    float mx0 = 0.f, mx1 = 0.f;
#pragma unroll 4
                    for (int r = 0; r < 16; ++r) {
#pragma unroll
                        for (int half = 0; half < 2; ++half) { const u32x4 w = *(const u32x4*)(base + (size_t)r * 1024 + half * 512);
                            float ss = bf_lo(w.x) * bf_lo(w.x) + bf_hi(w.x) * bf_hi(w.x) + bf_lo(w.y) * bf_lo(w.y) + bf_hi(w.y) * bf_hi(w.y) + bf_lo(w.z) * bf_lo(w.z) + bf_hi(w.z) * bf_hi(w.z) + bf_lo(w.w) * bf_lo(w.w) + bf_hi(w.w) * bf_hi(w.w);
                            ss += __shfl_xor(ss, 1); ss += __shfl_xor(ss, 2); ss += __shfl_xor(ss, 4); ss += __shfl_xor(ss, 8);
                            if (half == 0) mx0 = fmaxf(mx0, ss); else mx1 = fmaxf(mx1, ss); } }
                    if ((F.lane & 15) == 0) { const int g4 = F.lane >> 4;
                        if (isq) { const int bb = row0 >> 13, qb = (row0 & (SEQ - 1)) >> 8;
                            __hip_atomic_fetch_max(F.ctl + CW_QMAX + ((bb * 8 + g4) * 32 + qb), __float_as_uint(mx0), RLX_AGENT);
                            __hip_atomic_fetch_max(F.ctl + CW_QMAX + ((bb * 8 + 4 + g4) * 32 + qb), __float_as_uint(mx1), RLX_AGENT); }
                        else { const int bb = row0 / KVR;
                            __hip_atomic_fetch_max(F.ctl + CW_KMAX + (bb * 8 + g4), __float_as_uint(mx0), RLX_AGENT);
                            __hip_atomic_fetch_max(F.ctl + CW_KMAX + (bb * 8 + 4 + g4), __float_as_uint(mx1), RLX_AGENT); } }
                }
            }
            VM_WAIT(); __syncthreads();
            if (F.tid == 0) { __builtin_amdgcn_fence(__ATOMIC_ACQUIRE, "agent"); VM_WAIT(); }
            __syncthreads();
            { pg8::OneUnit S; S.u.A = (const char*)(ws + WS_UG) + ((size_t)(gb * NCHK + 2)) * UGK * 2; S.u.B = (const char*)(ws + WS_OPY) + ((size_t)g * 512 + pn * 256) * UGK * 2; S.u.rows = nullptr;
              S.u.r0 = b; S.u.c0 = pn; S.u.valid = 256; S.u.aux = g; S.rowbytes = UGK * 2;
              pg8::EpiY E{(bf16_t*)(ws + WS_YB)};
              for (int r2_ = 0; r2_ < ((REP_PH) == 23 ? 2 : 1); ++r2_) pg8::gemm_phase<pg8::EpiY, pg8::OneUnit, false>(F.lds, pg8::GemmK{UGK, UGK, UGK}, S, E); }
        }
        if (BOTH(2)) GRID_BAR();
    }

    if (IN(5)) {
        pg8::DenseOrder S; S.init(ws + WS_YB, ws + WS_WGLU, 1024, 1024, MX, 1024, F.G, bx);
        pg8::EpiGlu E{(const bf16_t*)(ws + WS_YB), args.in[15], (bf16_t*)(ws + WS_YC)};
        REPS(5) pg8::gemm_phase<pg8::EpiGlu, pg8::DenseOrder, true>(F.lds, pg8::GemmK{1024, 1024, 1024}, S, E);
    }

    if (IN(6)) {
        const bf16_t* Qb = (const bf16_t*)(ws + WS_Q); const bf16_t* Kb = (const bf16_t*)(ws + WS_K); const bf16_t* Vb = (const bf16_t*)(ws + WS_V);
        bf16_t* YC = (bf16_t*)(ws + WS_YC); const float* nck = (const float*)(ws + WS_CUM);
        LAS char* al = (LAS char*)F.lds;
        LAS unsigned* skey = (LAS unsigned*)(F.lds + 71680);
        att::Seam S;
#define MKREF(R, key_) do { const int id_ = (int)((key_) & 511u), bh_ = id_ >> 5, qb_ = id_ & 31, b_ = bh_ >> 3, h_ = bh_ & 7; (R).Q = Qb + ((size_t)b_ * SEQ + (size_t)qb_ * 256) * 1024 + h_ * 128; \
        (R).K = Kb + (size_t)b_ * KVR * 1024 + h_ * 128; (R).V = Vb + (size_t)b_ * KVR * 1024 + h_ * 128; (R).O = YC + ((size_t)b_ * SEQ + (size_t)qb_ * 256) * 2048 + 1024 + h_ * 128; \
        (R).nck = nck + (size_t)bh_ * KVR; (R).P0 = 64 + qb_ * 256; (R).j_lo = (int)(((key_) >> 10) & 1023u); } while (0)
        REPS(6) {
        { const int id = F.tid, bh = id >> 5, qb = id & 31, P0 = 64 + qb * 256; const float* nk = nck + (size_t)bh * KVR;
          const float q2 = __uint_as_float(__hip_atomic_load(F.ctl + CW_QMAX + id, RLX_AGENT)), k2 = __uint_as_float(__hip_atomic_load(F.ctl + CW_KMAX + bh, RLX_AGENT));
          const float thr = nk[P0] - T_SKIP - 2.f * sqrtf(q2 * k2) * 1.001f;
          int lo_ = 0, hi_ = 4 * qb + 1;
          while (lo_ < hi_) { const int mid = (lo_ + hi_) >> 1; if (nk[64 * mid + 63] < thr) lo_ = mid + 1; else hi_ = mid; }
          skey[id] = ((unsigned)(4 * qb + 5 - lo_) << 20) | ((unsigned)lo_ << 10) | (unsigned)id; }
        for (int k = 2; k <= 512; k <<= 1)
            for (int j = k >> 1; j > 0; j >>= 1) { __syncthreads(); const int ixj = F.tid ^ j;
                if (ixj > F.tid) { const unsigned a = skey[F.tid], b = skey[ixj]; const bool up = (F.tid & k) == 0;
                    if (up ? (a < b) : (a > b)) { skey[F.tid] = b; skey[ixj] = a; } } }
        __syncthreads();
        int pi = F.vcu;
        if (pi < 256) {
            int pass = 0; att::BlockRef cur, nxt;
            { const unsigned key = (unsigned)__builtin_amdgcn_readfirstlane((int)skey[511 - pi]); MKREF(cur, key); }
            att::fox_prime(cur, al, S);
            for (;;) {
                const bool more_pass = pass == 0, more_item = pi + F.G < 256, last = !more_pass && !more_item;
                int pin = pi, passn = pass + 1;
                if (!more_pass) { passn = 0; pin = more_item ? pi + F.G : pi; }
                if (last) nxt = cur; else { const unsigned key = (unsigned)__builtin_amdgcn_readfirstlane((int)skey[passn ? pin : 511 - pin]); MKREF(nxt, key); }
                att::fox_block(cur, nxt, KVR, al, S);
                if (last) break;
                cur = nxt; pass = passn; pi = pin;
            }
        }
        __syncthreads();
        }
#undef MKREF
        if (BOTH(6)) GRID_BAR();
    }

    if (IN(7)) {
        pg8::DenseOrder S; S.init(ws + WS_YC, ws + WS_WOUT, 2048, 2048, MX, 2048, F.G, bx);
        pg8::EpiOut E{(const bf16_t*)(ws + WS_XN), (float*)(ws + WS_Z), (float*)(ws + WS_ST)};
        REPS(7) pg8::gemm_phase<pg8::EpiOut, pg8::DenseOrder, true>(F.lds, pg8::GemmK{2048, 2048, 2048}, S, E);
        if (BOTH(7)) GRID_BAR();
    }

    if (IN(8)) {
        const float* Z = (const float*)(ws + WS_Z); const float* ST = (const float*)(ws + WS_ST); bf16_t* H1 = (bf16_t*)(ws + WS_XN); unsigned char* H1F8 = ws + WS_H1F8;
        const bf16_t* WR = (const bf16_t*)(ws + WS_WR); const float* lg_ = args.in[17]; const float* lb_ = args.in[18]; const float* rbias = args.in[20];
        int* IDX = (int*)(ws + WS_IDX); float* GWt = (float*)(ws + WS_GW); int* RK = (int*)(ws + WS_RK); int* TOK = (int*)(ws + WS_TOK);
        LAS float* lgs = (LAS float*)(F.lds + F.wave * 8960);
        const LAS float* lga = (const LAS float*)(F.lds + (F.wave & ~1) * 8960); const LAS float* lgb = (const LAS float*)(F.lds + (F.wave | 1) * 8960);
        LAS float* gat = lgs + 1088; LAS int* inf = (LAS int*)(lgs + 1088 + 512); LAS float* csl = lgs + 1088 + 1024;
        const int r16 = F.lane & 15, kq = F.lane >> 4, half = F.wave & 1;
        const float my_bias = rbias[F.lane];
        for (int bb = F.vcu; bb < MX / 64; bb += F.G) {
            const int batch = bb * 4 + (F.wave >> 1), row = batch * 16 + r16;
            float s = 0.f, q = 0.f;
#pragma unroll
            for (int i = 0; i < 4; ++i) { const f32x4 t4 = *(const f32x4*)(ST + (size_t)row * 64 + kq * 16 + i * 4); s += t4[0] + t4[2]; q += t4[1] + t4[3]; }
            s += __shfl_xor(s, 16); s += __shfl_xor(s, 32); q += __shfl_xor(q, 16); q += __shfl_xor(q, 32);
            const float mean = s * (1.f / DM), var = fmaxf(q * (1.f / DM) - mean * mean, 0.f), rstd = 1.f / sqrtf(var + LN_EPS);
            f32x4 acc[4];
#pragma unroll
            for (int nb = 0; nb < 4; ++nb) acc[nb] = (f32x4){0.f, 0.f, 0.f, 0.f};
#pragma unroll 8
            for (int kk = 0; kk < 32; ++kk) { const int k0 = (half * 32 + kk) * 32 + kq * 8;
                const f32x4 z0 = *(const f32x4*)(Z + (size_t)row * DM + k0), z1 = *(const f32x4*)(Z + (size_t)row * DM + k0 + 4);
                const f32x4 g0 = *(const f32x4*)(lg_ + k0), g1 = *(const f32x4*)(lg_ + k0 + 4), b0 = *(const f32x4*)(lb_ + k0), b1 = *(const f32x4*)(lb_ + k0 + 4);
                const f32x4 y0 = (z0 - mean) * rstd * g0 + b0, y1 = (z1 - mean) * rstd * g1 + b1;
                const u32x4 w = pg8::pack8(y0, y1);
                *(u32x4*)(H1 + (size_t)row * DM + k0) = w;
                *(u32x2*)(H1F8 + (size_t)row * DM + k0) = pg8::pack8_fp8(y0, y1);
                const bf16x8 af = __builtin_bit_cast(bf16x8, w);
#pragma unroll
                for (int nb = 0; nb < 4; ++nb) { const bf16x8 bfm = *(const bf16x8*)(WR + (size_t)(nb * 16 + r16) * DM + k0);
                    acc[nb] = __builtin_amdgcn_mfma_f32_16x16x32_bf16(af, bfm, acc[nb], 0, 0, 0); } }
#pragma unroll
            for (int nb = 0; nb < 4; ++nb)
#pragma unroll
                for (int rg = 0; rg < 4; ++rg) lgs[(kq * 4 + rg) * 65 + nb * 16 + r16] = acc[nb][rg];
            __syncthreads();
            int mycount = 0; const int mygrp = F.lane >> 3;
#pragma unroll 1
            for (int rr = 0; rr < 8; ++rr) { const int r = half * 8 + rr;
                const float score = fast_sigmoid(lga[r * 65 + F.lane] + lgb[r * 65 + F.lane]);
                const float sel = score + my_bias;
                float m1 = sel; m1 = fmaxf(m1, __shfl_xor(m1, 1)); m1 = fmaxf(m1, __shfl_xor(m1, 2)); m1 = fmaxf(m1, __shfl_xor(m1, 4));
                int i1 = (sel == m1) ? F.lane : 1000; i1 = min(i1, __shfl_xor(i1, 1)); i1 = min(i1, __shfl_xor(i1, 2)); i1 = min(i1, __shfl_xor(i1, 4));
                float m2 = (F.lane == i1) ? -__builtin_inff() : sel; m2 = fmaxf(m2, __shfl_xor(m2, 1)); m2 = fmaxf(m2, __shfl_xor(m2, 2)); m2 = fmaxf(m2, __shfl_xor(m2, 4));
                const float gs = m1 + m2;
                int gcount = 0;
#pragma unroll
                for (int j = 0; j < 8; ++j) { const float gj = __int_as_float(__builtin_amdgcn_readlane(__float_as_int(gs), 8 * j)); gcount += (gj > gs || (gj == gs && j < mygrp)) ? 1 : 0; }
                const bool cand = gcount < 4;
                const float cs = cand ? sel : -__builtin_inff();
                int rank = 0;
                csl[F.lane] = cs; LDS_WAIT(); asm volatile("" ::: "memory");
#pragma unroll
                for (int j4 = 0; j4 < 16; ++j4) { const f32x4 c4 = *(const LAS f32x4*)(csl + 4 * j4);
#pragma unroll
                    for (int e = 0; e < 4; ++e) rank += (c4[e] > cs || (c4[e] == cs && (4 * j4 + e) < F.lane)) ? 1 : 0; }
                asm volatile("" ::: "memory");
                const bool chosen = cand && rank < TOPK;
                const float tot = wave_sum(chosen ? score : 0.f);
                gat[rr * 64 + F.lane] = score / tot * ROUTED_SCALE; inf[rr * 64 + F.lane] = chosen ? (rank | (mycount << 4)) : -1; mycount += chosen ? 1 : 0; }
            unsigned base = 0u;
            if (mycount) base = __hip_atomic_fetch_add(F.ctl + CW_CNT + 64 * F.lane, (unsigned)mycount, RLX_AGENT);
#pragma unroll 2
            for (int rr = 0; rr < 8; ++rr) { const int info = inf[rr * 64 + F.lane]; const float gate = gat[rr * 64 + F.lane];
                if (info >= 0) { const int trow = batch * 16 + half * 8 + rr, rank = info & 15; const unsigned pos = base + (unsigned)(info >> 4);
                    TOK[(size_t)F.lane * MX + pos] = trow;
                    IDX[(size_t)trow * 8 + rank] = F.lane; GWt[(size_t)trow * 8 + rank] = gate; RK[(size_t)trow * 8 + rank] = (int)pos; } }
            __syncthreads();
        }
        if (BOTH(8)) GRID_BAR();
    }

    if (IN(9)) {
        moe_tables(F);
        const LAS int* tb = (const LAS int*)(F.lds + TB_OFF);
        pg8::MoeOrder S; S.tb = tb; S.TT = tb[64]; S.NCT = 4; S.nsh = 64 * 4; S.nwg = S.TT * 4 + S.nsh; S.G = F.G; S.c = bx; S.lda = DM; S.ldb = DM;
        S.Aexp = (const char*)(ws + WS_H1F8); S.tok = (const int*)(ws + WS_TOK); S.Bexp = (const char*)(ws + WS_WEGU); S.bstride = (size_t)1024 * 2048;
        S.Ash = (const char*)(ws + WS_H1F8); S.Bsh = (const char*)(ws + WS_WSGU); S.gather = true;
        pg8::EpiGU E{ws + WS_HID, ws + WS_HIDS};
        REPS(9) pg8::gemm_phase<pg8::EpiGU, pg8::MoeOrder, true, true>(F.lds, pg8::GemmK{DM, DM, DM}, S, E);
        if (BOTH(9)) GRID_BAR();
    }

    if (IN(10)) {
        moe_tables(F);
        const LAS int* tb = (const LAS int*)(F.lds + TB_OFF);
        pg8::MoeOrder S; S.tb = tb; S.TT = tb[64]; S.NCT = 8; S.nsh = 64 * 8; S.nwg = S.TT * 8 + S.nsh; S.G = F.G; S.c = bx; S.lda = EFF; S.ldb = EFF;
        S.Aexp = (const char*)(ws + WS_HID); S.tok = nullptr; S.Bexp = (const char*)(ws + WS_WED); S.bstride = (size_t)2048 * 512;
        S.Ash = (const char*)(ws + WS_HIDS); S.Bsh = (const char*)(ws + WS_WSD); S.gather = false;
        pg8::EpiDown E{ws + WS_C, ws + WS_CS};
        { const int sg = F.vcu & 3;
          if (0 && sg) { const unsigned long long t0 = __builtin_amdgcn_s_memrealtime(); while (__builtin_amdgcn_s_memrealtime() - t0 < (unsigned long long)(sg * 500)) __builtin_amdgcn_s_sleep(8); } }
        REPS(10) pg8::gemm_phase<pg8::EpiDown, pg8::MoeOrder, true, true>(F.lds, pg8::GemmK{EFF, EFF, EFF}, S, E);
        if (BOTH(10)) GRID_BAR();
    }

    if (IN(11)) {
        moe_tables(F);
        const LAS int* tb = (const LAS int*)(F.lds + TB_OFF);
        const bf16_t* H1 = (const bf16_t*)(ws + WS_XN); const unsigned char* CS = ws + WS_CS; const unsigned char* C = ws + WS_C;
        const int* IDX = (const int*)(ws + WS_IDX); const float* GWt = (const float*)(ws + WS_GW); const int* RK = (const int*)(ws + WS_RK);
        const float* lg_ = args.in[27]; const float* lb_ = args.in[28]; float* out = args.out;
        REPS(11)
        for (int row = gw; row < MX; row += NGW) {
            const i32x4 e0 = *(const i32x4*)(IDX + (size_t)row * 8), e1 = *(const i32x4*)(IDX + (size_t)row * 8 + 4);
            const i32x4 r0 = *(const i32x4*)(RK + (size_t)row * 8), r1 = *(const i32x4*)(RK + (size_t)row * 8 + 4);
            const f32x4 w0 = *(const f32x4*)(GWt + (size_t)row * 8), w1 = *(const f32x4*)(GWt + (size_t)row * 8 + 4);
            int slot[8]; float wk[8];
            slot[0] = tb[65 + e0[0]] + r0[0]; slot[1] = tb[65 + e0[1]] + r0[1]; slot[2] = tb[65 + e0[2]] + r0[2]; slot[3] = tb[65 + e0[3]] + r0[3];
            slot[4] = tb[65 + e1[0]] + r1[0]; slot[5] = tb[65 + e1[1]] + r1[1]; slot[6] = tb[65 + e1[2]] + r1[2]; slot[7] = tb[65 + e1[3]] + r1[3];
            constexpr float CI = 1.f / C8SCALE;
            wk[0] = w0[0] * CI; wk[1] = w0[1] * CI; wk[2] = w0[2] * CI; wk[3] = w0[3] * CI; wk[4] = w1[0] * CI; wk[5] = w1[1] * CI; wk[6] = w1[2] * CI; wk[7] = w1[3] * CI;
            float acc[4][8];
#pragma unroll
            for (int j = 0; j < 4; ++j) { int lo_ = (j * 64 + F.lane) * 8; asm volatile("" : "+v"(lo_)); const size_t off = (size_t)row * DM + (size_t)lo_;
                const u32x4 hw = *(const u32x4*)(H1 + off); const u32x2 sw = *(const u32x2*)(CS + off);
                u32x2 cw[8];
#pragma unroll
                for (int k = 0; k < 8; ++k) cw[k] = *(const u32x2*)(C + (size_t)slot[k] * DM + (size_t)lo_);
                { const f32x2 s0 = __builtin_amdgcn_cvt_pk_f32_fp8((int)sw.x, false), s1 = __builtin_amdgcn_cvt_pk_f32_fp8((int)sw.x, true), s2 = __builtin_amdgcn_cvt_pk_f32_fp8((int)sw.y, false), s3 = __builtin_amdgcn_cvt_pk_f32_fp8((int)sw.y, true);
                  acc[j][0] = ALPHA * bf_lo(hw.x) + CI * s0[0]; acc[j][1] = ALPHA * bf_hi(hw.x) + CI * s0[1]; acc[j][2] = ALPHA * bf_lo(hw.y) + CI * s1[0]; acc[j][3] = ALPHA * bf_hi(hw.y) + CI * s1[1];
                  acc[j][4] = ALPHA * bf_lo(hw.z) + CI * s2[0]; acc[j][5] = ALPHA * bf_hi(hw.z) + CI * s2[1]; acc[j][6] = ALPHA * bf_lo(hw.w) + CI * s3[0]; acc[j][7] = ALPHA * bf_hi(hw.w) + CI * s3[1]; }
#pragma unroll
                for (int k = 0; k < 8; ++k) { const f32x2 c0 = __builtin_amdgcn_cvt_pk_f32_fp8((int)cw[k].x, false), c1 = __builtin_amdgcn_cvt_pk_f32_fp8((int)cw[k].x, true), c2 = __builtin_amdgcn_cvt_pk_f32_fp8((int)cw[k].y, false), c3 = __builtin_amdgcn_cvt_pk_f32_fp8((int)cw[k].y, true);
                    acc[j][0] += wk[k] * c0[0]; acc[j][1] += wk[k] * c0[1]; acc[j][2] += wk[k] * c1[0]; acc[j][3] += wk[k] * c1[1];
                    acc[j][4] += wk[k] * c2[0]; acc[j][5] += wk[k] * c2[1]; acc[j][6] += wk[k] * c3[0]; acc[j][7] += wk[k] * c3[1]; }
                asm volatile("" ::: "memory"); }
            float s = 0.f;
#pragma unroll
            for (int j = 0; j < 4; ++j)
#pragma unroll
                for (int e = 0; e < 8; ++e) s += acc[j][e];
            const float mean = wave_sum(s) * (1.f / DM); float s2 = 0.f;
#pragma unroll
            for (int j = 0; j < 4; ++j)
#pragma unroll
                for (int e = 0; e < 8; ++e) { acc[j][e] -= mean; s2 += acc[j][e] * acc[j][e]; }
            const float rstd = 1.f / sqrtf(wave_sum(s2) * (1.f / DM) + LN_EPS);
#pragma unroll
            for (int j = 0; j < 4; ++j) { int c0 = (j * 64 + F.lane) * 8; asm volatile("" : "+v"(c0));
                const f32x4 g0 = *(const f32x4*)(lg_ + c0), g1 = *(const f32x4*)(lg_ + c0 + 4), b0 = *(const f32x4*)(lb_ + c0), b1 = *(const f32x4*)(lb_ + c0 + 4);
                f32x4 o0, o1;
#pragma unroll
                for (int e = 0; e < 4; ++e) { o0[e] = acc[j][e] * rstd * g0[e] + b0[e]; o1[e] = acc[j][4 + e] * rstd * g1[e] + b1[e]; }
                *(f32x4*)(out + (size_t)row * DM + c0) = o0; *(f32x4*)(out + (size_t)row * DM + c0 + 4) = o1; }
        }
    }
#undef IN
#undef BOTH
#undef GRID_BAR
}

#ifndef PH_MASK
#define PH_MASK 0xFFFu
#endif
typedef void (*kern_t)(Args);
template <unsigned MASK> static bool prep_kernel(kern_t& k) {
    k = hymba_fwd<MASK>;
    if (hipFuncSetAttribute((const void*)hymba_fwd<MASK>, hipFuncAttributeMaxDynamicSharedMemorySize, LDS_BYTES) != hipSuccess) { fprintf(stderr, "kernel_launch: hipFuncSetAttribute failed (mask %x)\n", MASK); return false; }
    return true;
}
extern "C" void kernel_launch(void* const* d_in, const int* in_sizes, int n_in, void* d_out, int out_size, void* d_ws, size_t ws_size, hipStream_t stream) {
    static int grid = 0; static kern_t kerns[N_PHASES];
    if (grid == 0) {
        if (n_in != 29 || in_sizes[0] != MX * DM || out_size != MX * DM || ws_size < WS_END) {
            fprintf(stderr, "kernel_launch: unexpected shapes (n_in %d, in0 %d, out %d, ws %zu; need ws >= %zu); nothing launched\n", n_in, n_in > 0 ? in_sizes[0] : -1, out_size, ws_size, (size_t)WS_END); grid = -1; return; }
        int dev = 0, cus = 0;
        if (hipGetDevice(&dev) != hipSuccess || hipDeviceGetAttribute(&cus, hipDeviceAttributeMultiprocessorCount, dev) != hipSuccess) { fprintf(stderr, "kernel_launch: device query failed\n"); grid = -1; return; }
        bool ok = true;
        if constexpr (N_LAUNCHES == 1) ok = prep_kernel<PH_MASK>(kerns[0]);
        else { ok = ok && prep_kernel<0x001u>(kerns[0]) && prep_kernel<0x002u>(kerns[1]) && prep_kernel<0x004u>(kerns[2]) && prep_kernel<0x008u>(kerns[3]) && prep_kernel<0x010u>(kerns[4]) && prep_kernel<0x020u>(kerns[5])
                       && prep_kernel<0x040u>(kerns[6]) && prep_kernel<0x080u>(kerns[7]) && prep_kernel<0x100u>(kerns[8]) && prep_kernel<0x200u>(kerns[9]) && prep_kernel<0x400u>(kerns[10]) && prep_kernel<0x800u>(kerns[11]); }
        if (!ok) { grid = -1; return; }
        (void)hipGetLastError();
        grid = cus;
    }
    if (grid < 0) return;
    if (hipMemsetAsync((char*)d_ws + WS_CTL, 0, CTL_ZERO_BYTES, stream) != hipSuccess) { fprintf(stderr, "kernel_launch: memset failed\n"); return; }
    Args a{};
    for (int i = 0; i < 29; ++i) a.in[i] = (const float*)d_in[i];
    a.out = (float*)d_out; a.ws = (unsigned char*)d_ws;
    for (int li = 0; li < N_LAUNCHES; ++li) {
        if (N_LAUNCHES != 1 && !((PH_MASK >> li) & 1u)) continue;
        a.ph_lo = (N_LAUNCHES == 1) ? 0 : li; a.ph_hi = (N_LAUNCHES == 1) ? N_PHASES : li + 1;
        hipLaunchKernelGGL(kerns[li], dim3(grid), dim3(NWAVES * 64), LDS_BYTES, stream, a);
        const hipError_t le = hipPeekAtLastError();
        if (le != hipSuccess) { fprintf(stderr, "kernel_launch: launch %d failed: %s\n", li, hipGetErrorName(le)); break; }
    }
}
```
